# Optimizing an MI355X kernel written in HIP

```python
import jax, jax.numpy as jnp
from jax import lax
import numpy as np

D_MODEL = 2048
BATCH = 32
SEQ = 256
DEPTH = 2
DEC_BATCH = 2
DEC_SEQ = 4096
PAST_LEN = 512

GRID_W = 64
HEAD_DIM = 128
D_ATTN = D_MODEL // 2
N_Q_HEADS = D_ATTN // HEAD_DIM
N_KV_HEADS = max(1, N_Q_HEADS // 4)
Q_PER_KV = N_Q_HEADS // N_KV_HEADS
WINDOW = 128
ATTN_BLOCK = 128
ATTN_SCALE = HEAD_DIM ** -0.5
ROPE_BASE = 10000.0
MASK_VALUE = -1e30
D_REC = D_MODEL // 4
REC_DK = 128
REC_DV = 128
N_REC_HEADS = D_REC // REC_DV
D_REC_K = N_REC_HEADS * REC_DK
REC_CHUNK = 32
CONV_CH = D_MODEL // 4
CONV_WIDTH = 31
D_MIX = D_ATTN + D_REC + CONV_CH
D_FF = 256 * ((8 * D_MODEL // 3 + 255) // 256)
N_MOD = 9
EPS = 1e-6
GATE_FLOOR = 1e-30
IN_SIZES = (D_ATTN, N_KV_HEADS * HEAD_DIM, N_KV_HEADS * HEAD_DIM, D_REC_K, D_REC_K, D_REC_K, D_REC, D_REC, CONV_CH, CONV_CH)
IN_COLS = sum(IN_SIZES)
IN_SPLITS = tuple(int(s) for s in np.cumsum(IN_SIZES)[:-1])

kernel_name = 'hybrid_diffusion_parallel_heads_step'

F32 = jnp.float32


def rms_norm(x, g):
    xf = x.astype(F32)
    y = xf * lax.rsqrt(jnp.mean(xf * xf, axis=-1, keepdims=True) + EPS)
    return (y * g.astype(F32)).astype(x.dtype)


def layer_norm(x, g, b):
    xf = x.astype(F32)
    mu = jnp.mean(xf, axis=-1, keepdims=True)
    var = jnp.mean(jnp.square(xf - mu), axis=-1, keepdims=True)
    y = (xf - mu) * lax.rsqrt(var + EPS)
    return (y * g.astype(F32) + b.astype(F32)).astype(x.dtype)


def swiglu(h, w_in, w_out):
    a, b = jnp.split(h @ w_in, 2, axis=-1)
    return (jax.nn.silu(a) * b) @ w_out


def axial_rope(x):
    n = x.shape[-2]
    rows = n // GRID_W
    row = jnp.repeat(jnp.arange(rows), GRID_W)
    col = jnp.arange(rows * GRID_W) % GRID_W
    quarter = HEAD_DIM // 4
    half = HEAD_DIM // 2
    inv_freq = ROPE_BASE ** (-jnp.arange(quarter, dtype=F32) / quarter)
    xf = x.astype(F32)

    def rotate(xh, pos):
        ang = pos.astype(F32)[:, None] * inv_freq
        cos, sin = jnp.cos(ang), jnp.sin(ang)
        x1, x2 = xh[..., :quarter], xh[..., quarter:]
        return jnp.concatenate([x1 * cos - x2 * sin, x1 * sin + x2 * cos], axis=-1)

    out = jnp.concatenate([rotate(xf[..., :half], row), rotate(xf[..., half:], col)], axis=-1)
    return out.astype(x.dtype)


def sink_attend(s, v, sink):
    sk = sink.astype(F32)[None, :, :, None, None]
    m = jnp.maximum(jnp.max(s, axis=-1, keepdims=True), sk)
    p = jnp.exp(s - m)
    den = jnp.sum(p, axis=-1, keepdims=True) + jnp.exp(sk - m)
    return jnp.einsum('bkgqs,bksd->bkgqd', p, v) / den


def context_attention(q, k, v, sink):
    B, KV, G, T, HD = q.shape
    nb = T // ATTN_BLOCK
    kf, vf = k.astype(F32), v.astype(F32)
    qb = q.astype(F32).reshape(B, KV, G, nb, ATTN_BLOCK, HD).transpose(3, 0, 1, 2, 4, 5)

    def block(qi):
        s = jnp.einsum('bkgqd,bksd->bkgqs', qi, kf) * ATTN_SCALE
        return sink_attend(s, vf, sink)

    o = lax.map(block, qb)
    return o.transpose(1, 2, 3, 0, 4, 5).reshape(B, KV, G, T, HD)


def latent_attention(q, k, v, k_ctx, v_ctx, sink):
    B, KV, G, N, HD = q.shape
    nb = N // ATTN_BLOCK
    span = 3 * ATTN_BLOCK
    pad = ((0, 0), (0, 0), (ATTN_BLOCK, ATTN_BLOCK), (0, 0))
    kp = jnp.pad(k.astype(F32), pad)
    vp = jnp.pad(v.astype(F32), pad)
    kc, vc = k_ctx.astype(F32), v_ctx.astype(F32)
    qb = q.astype(F32).reshape(B, KV, G, nb, ATTN_BLOCK, HD).transpose(3, 0, 1, 2, 4, 5)

    def block(args):
        i, qi = args
        start = i * ATTN_BLOCK
        ki = lax.dynamic_slice_in_dim(kp, start, span, axis=2)
        vi = lax.dynamic_slice_in_dim(vp, start, span, axis=2)
        qpos = start + jnp.arange(ATTN_BLOCK)
        kpos = start - ATTN_BLOCK + jnp.arange(span)
        valid = (jnp.abs(qpos[:, None] - kpos[None, :]) <= WINDOW) & (kpos >= 0) & (kpos < N)
        s_loc = jnp.where(valid, jnp.einsum('bkgqd,bksd->bkgqs', qi, ki) * ATTN_SCALE, MASK_VALUE)
        s_ctx = jnp.einsum('bkgqd,bksd->bkgqs', qi, kc) * ATTN_SCALE
        return sink_attend(jnp.concatenate([s_loc, s_ctx], axis=-1), jnp.concatenate([vi, vc], axis=2), sink)

    o = lax.map(block, (jnp.arange(nb), qb))
    return o.transpose(1, 2, 3, 0, 4, 5).reshape(B, KV, G, N, HD)


def forget_gate(z, lb):
    z = z.astype(F32)
    lb = lb.astype(F32)
    f = lb + (1.0 - lb) * jax.nn.sigmoid(z)
    log_f = jnp.log(jnp.maximum(f, GATE_FLOOR))
    k = (1.0 - lb) * jax.nn.sigmoid(-z)
    return k, log_f


def hgrn_scan(q, k, v, log_f, s0):
    B, H, T, DK = q.shape
    nc = T // REC_CHUNK
    causal = jnp.tril(jnp.ones((REC_CHUNK, REC_CHUNK), dtype=bool))[:, :, None]

    def to_chunks(a):
        return a.reshape(B, H, nc, REC_CHUNK, a.shape[-1]).transpose(2, 0, 1, 3, 4)

    def step(S, inp):
        qc, kc, vc, lc = inp
        cum = jnp.cumsum(lc, axis=-2)
        o_inter = jnp.einsum('bhtd,bhde->bhte', qc * jnp.exp(cum), S)
        diff = cum[:, :, :, None, :] - cum[:, :, None, :, :]
        decay = jnp.where(causal, jnp.exp(jnp.where(causal, diff, 0.0)), 0.0)
        a = jnp.einsum('bhtd,bhsd,bhtsd->bhts', qc, kc, decay)
        o = o_inter + jnp.einsum('bhts,bhse->bhte', a, vc)
        last = cum[:, :, -1:, :]
        S_new = jnp.exp(last[:, :, 0, :])[..., None] * S + jnp.einsum('bhsd,bhse->bhde', kc * jnp.exp(last - cum), vc)
        return S_new, o

    S, o = lax.scan(step, s0, (to_chunks(q), to_chunks(k), to_chunks(v), to_chunks(log_f)))
    return o.transpose(1, 2, 0, 3, 4).reshape(B, H, T, v.shape[-1]), S


def rec_bidir(q, k_f, k_b, lf_f, lf_b, v, s0_f, s0_b):
    o_f, s_f = hgrn_scan(q, k_f, v, lf_f, s0_f)
    rev = lambda a: jnp.flip(a, axis=2)
    o_b, s_b = hgrn_scan(rev(q), rev(k_b), rev(v), rev(lf_b), s0_b)
    return o_f + rev(o_b), s_f, s_b


def conv_module(a, b, w, bias, ln_g, ln_b):
    h = a * jax.nn.sigmoid(b)
    half = CONV_WIDTH // 2
    h = lax.conv_general_dilated(h, w[:, None, :].astype(h.dtype), window_strides=(1,), padding=[(half, half)],
                                 dimension_numbers=('NWC', 'WIO', 'NWC'), feature_group_count=CONV_CH)
    h = layer_norm(h + bias, ln_g, ln_b)
    return jax.nn.silu(h)


def mixer(h, P, l, lb_l, ctx):
    B, T, _ = h.shape
    dt = h.dtype
    zq, zk, zv, rq, rf_f, rf_b, ri, rg, ca, cb = jnp.split(h @ P['w_in'][l], IN_SPLITS, axis=-1)
    q = rms_norm(zq.reshape(B, T, N_KV_HEADS, Q_PER_KV, HEAD_DIM), P['q_norm_g'][l]).transpose(0, 2, 3, 1, 4)
    k = rms_norm(zk.reshape(B, T, N_KV_HEADS, HEAD_DIM), P['k_norm_g'][l]).transpose(0, 2, 1, 3)
    v = zv.reshape(B, T, N_KV_HEADS, HEAD_DIM).transpose(0, 2, 1, 3)
    sink = P['attn_sink'][l].reshape(N_KV_HEADS, Q_PER_KV)
    heads = lambda a, d: a.reshape(B, T, N_REC_HEADS, d).transpose(0, 2, 1, 3).astype(F32)
    lb = lb_l.reshape(2, N_REC_HEADS, 1, REC_DK)
    qr = heads(rq, REC_DK)
    vr = heads(ri, REC_DV)
    kf, lf_f = forget_gate(heads(rf_f, REC_DK), lb[0])
    kb, lf_b = forget_gate(heads(rf_b, REC_DK), lb[1])
    if ctx is None:
        attn = context_attention(q, k, v, sink)
        zero = jnp.zeros((B, N_REC_HEADS, REC_DK, REC_DV), F32)
        rec, s_f, s_b = rec_bidir(qr, kf, kb, lf_f, lf_b, vr, zero, zero)
        new_ctx = (k, v, jnp.stack([s_f, s_b], axis=1).astype(dt))
    else:
        k_ctx, v_ctx, s_ctx = ctx
        attn = latent_attention(axial_rope(q), axial_rope(k), v, k_ctx, v_ctx, sink)
        rec, _, _ = rec_bidir(qr, kf, kb, lf_f, lf_b, vr, s_ctx[:, 0].astype(F32), s_ctx[:, 1].astype(F32))
        new_ctx = None
    attn = attn.transpose(0, 3, 1, 2, 4).reshape(B, T, D_ATTN).astype(dt)
    rec = rms_norm(rec.transpose(0, 2, 1, 3), P['rec_norm_g'][l]).reshape(B, T, D_REC).astype(dt) * jax.nn.silu(rg)
    conv = conv_module(ca, cb, P['conv_w'][l], P['conv_b'][l], P['conv_ln_g'][l], P['conv_ln_b'][l])
    out = jnp.concatenate([attn, rec, conv], axis=-1) @ P['w_out'][l]
    return out, new_ctx


def trunk_layer(x, cond, P, l, lb_l, ctx):
    mod = (jax.nn.silu(cond) @ P['w_ada'][l] + P['b_ada'][l])[:, None, :]
    sh1, sc1, g1, sh2, sc2, g2, sh3, sc3, g3 = jnp.split(mod, N_MOD, axis=-1)
    h = rms_norm(x, P['norm_g'][l, 0]) * (1 + sc1) + sh1
    x = x + 0.5 * g1 * swiglu(h, P['w_ffn_in'][l, 0], P['w_ffn_out'][l, 0])
    h = rms_norm(x, P['norm_g'][l, 1]) * (1 + sc2) + sh2
    mix, new_ctx = mixer(h, P, l, lb_l, ctx)
    x = x + g2 * mix
    h = rms_norm(x, P['norm_g'][l, 2]) * (1 + sc3) + sh3
    x = x + 0.5 * g3 * swiglu(h, P['w_ffn_in'][l, 1], P['w_ffn_out'][l, 1])
    return x, new_ctx


def setup_inputs(seed: int = 0) -> dict:
    key = jax.random.key(seed)
    ks = jax.random.split(key, 24)
    nrm = lambda k, shape, s: jax.random.normal(k, shape, F32) * s
    return {
        'x_prompt': nrm(ks[0], (BATCH, SEQ, D_MODEL), 1.0),
        'x_sample': nrm(ks[1], (DEC_BATCH, DEC_SEQ, D_MODEL), 1.0),
        'cache_k': nrm(ks[2], (DEC_BATCH, DEPTH, N_KV_HEADS, PAST_LEN, HEAD_DIM), 1.0),
        'cache_v': nrm(ks[3], (DEC_BATCH, DEPTH, N_KV_HEADS, PAST_LEN, HEAD_DIM), 1.0),
        'state_rec': nrm(ks[4], (DEC_BATCH, DEPTH, 2, N_REC_HEADS, REC_DK, REC_DV), 0.5),
        'c': nrm(ks[5], (DEC_BATCH, D_MODEL), 1.0),
        'c_ctx': nrm(ks[6], (D_MODEL,), 1.0),
        'w_ada': nrm(ks[7], (DEPTH, D_MODEL, N_MOD * D_MODEL), 0.5 * D_MODEL ** -0.5),
        'b_ada': nrm(ks[8], (DEPTH, N_MOD * D_MODEL), 0.02),
        'norm_g': 1.0 + nrm(ks[9], (DEPTH, 3, D_MODEL), 0.05),
        'w_ffn_in': nrm(ks[10], (DEPTH, 2, D_MODEL, 2 * D_FF), D_MODEL ** -0.5),
        'w_ffn_out': nrm(ks[11], (DEPTH, 2, D_FF, D_MODEL), D_FF ** -0.5),
        'w_in': nrm(ks[12], (DEPTH, D_MODEL, IN_COLS), D_MODEL ** -0.5),
        'w_out': nrm(ks[13], (DEPTH, D_MIX, D_MODEL), D_MIX ** -0.5),
        'q_norm_g': 1.0 + nrm(ks[14], (DEPTH, HEAD_DIM), 0.05),
        'k_norm_g': 1.0 + nrm(ks[15], (DEPTH, HEAD_DIM), 0.05),
        'attn_sink': nrm(ks[16], (DEPTH, N_Q_HEADS), 0.5),
        'rec_lb_logits': nrm(ks[17], (DEPTH, 2, D_REC_K), 0.5),
        'rec_norm_g': 1.0 + nrm(ks[18], (DEPTH, N_REC_HEADS, REC_DV), 0.05),
        'conv_w': nrm(ks[19], (DEPTH, CONV_WIDTH, CONV_CH), CONV_WIDTH ** -0.5),
        'conv_b': nrm(ks[20], (DEPTH, CONV_CH), 0.02),
        'conv_ln_g': 1.0 + nrm(ks[21], (DEPTH, CONV_CH), 0.05),
        'conv_ln_b': nrm(ks[22], (DEPTH, CONV_CH), 0.02),
    }


def reference(x_prompt, x_sample, cache_k, cache_v, state_rec, c, c_ctx, w_ada, b_ada, norm_g, w_ffn_in, w_ffn_out,
              w_in, w_out, q_norm_g, k_norm_g, attn_sink, rec_lb_logits, rec_norm_g, conv_w, conv_b, conv_ln_g, conv_ln_b):
    P = {'w_ada': w_ada, 'b_ada': b_ada, 'norm_g': norm_g, 'w_ffn_in': w_ffn_in, 'w_ffn_out': w_ffn_out,
         'w_in': w_in, 'w_out': w_out, 'q_norm_g': q_norm_g, 'k_norm_g': k_norm_g, 'attn_sink': attn_sink,
         'rec_norm_g': rec_norm_g, 'conv_w': conv_w, 'conv_b': conv_b, 'conv_ln_g': conv_ln_g, 'conv_ln_b': conv_ln_b}
    p_lb = jax.nn.softmax(rec_lb_logits.astype(F32), axis=0)
    lb_all = jnp.cumsum(p_lb, axis=0) - p_lb[:1]

    h = x_prompt
    ks, vs, ss = [], [], []
    for l in range(DEPTH):
        h, (k_l, v_l, s_l) = trunk_layer(h, c_ctx[None, :], P, l, lb_all[l], None)
        ks.append(k_l)
        vs.append(v_l)
        ss.append(s_l)
    y_prompt = h
    new_cache_k = jnp.stack(ks, axis=1)
    new_cache_v = jnp.stack(vs, axis=1)
    new_state_rec = jnp.stack(ss, axis=1)

    h = x_sample
    for l in range(DEPTH):
        h, _ = trunk_layer(h, c, P, l, lb_all[l], (cache_k[:, l], cache_v[:, l], state_rec[:, l]))
    y_sample = h
    return (y_prompt, y_sample, new_cache_k, new_cache_v, new_state_rec)
```

```cpp
#include <hip/hip_runtime.h>
#include <cstdio>
#include <cstdint>
#ifndef MK_N_LAUNCHES
#define MK_N_LAUNCHES 0
#endif
namespace pg8 {
#define PG8_LAS __attribute__((address_space(3)))
typedef unsigned short bf16_t;
typedef short bf16x8 __attribute__((ext_vector_type(8)));
typedef float f32x4 __attribute__((ext_vector_type(4)));
typedef unsigned u32x4 __attribute__((ext_vector_type(4)));
constexpr int BM = 256, BK = 64, HALF = 128, HTB = HALF * BK * 2  , STAGE_BYTES = 8 * HTB, NXCD = 8, WGM = 8;

__host__ __device__ __forceinline__ int lds_byte(int r, int c) { const int st = (r >> 4) * 2 + (c >> 5), rr = r & 15, cc = c & 31, ob = rr * 64 + cc * 2; return st * 1024 + (ob ^ (((ob >> 9) & 1) << 5)); }
__host__ __device__ __forceinline__ void stage_rc(int b, int& R, int& C) { const int st = b / 1024, sb = b % 1024, swz = sb ^ (((sb >> 9) & 1) << 5); R = (st >> 1) * 16 + swz / 64; C = (st & 1) * 32 + (swz % 64) / 2; }
__host__ __device__ __forceinline__ int perm32(int rho) { const int n = rho >> 4, i = rho & 15; return 8 * (i >> 2) + 4 * n + (i & 3); }

struct Unit { int pm, pn; };
struct Gemm { const bf16_t* A; const bf16_t* Bt; int M, N, K; };

struct StaticOrder {
    int nM, nN, nwg, G, c;
    __host__ __device__ void init(int M, int N, int G_, int c_) { nM = M / BM; nN = N / BM; nwg = nM * nN; G = G_; c = c_; }
    __host__ __device__ bool next(int i, Unit& u) const {
        const long L = (long)i * G + c; if (L >= nwg) return false;
        int wgid = (int)L; { const int q = nwg / NXCD, r = nwg % NXCD, xcd = wgid % NXCD, off = wgid / NXCD; wgid = (xcd < r ? xcd * (q + 1) : r * (q + 1) + (xcd - r) * q) + off; }
        const int nig = WGM * nN, gid = wgid / nig, fm = gid * WGM, gsz = (nM - fm) < WGM ? (nM - fm) : WGM;
        u.pm = fm + ((wgid % nig) % gsz); u.pn = (wgid % nig) / gsz; return true;
    }
    __device__ __forceinline__ void a_ready(const Unit&) const {}
    __device__ __forceinline__ void done(const Unit&) const {}
};
__device__ __forceinline__ unsigned cvt_pk_bf16(float lo, float hi) { unsigned r; asm volatile("v_cvt_pk_bf16_f32 %0, %1, %2" : "=v"(r) : "v"(lo), "v"(hi)); return r; }
template <class Epi, class Sched, bool ALIGN_EPI = false, bool SP2 = false>
__device__ __forceinline__ void gemm_phase(PG8_LAS unsigned char* lds, const Gemm g, const Sched& S, const Epi& E) {
    const int tid = threadIdx.x, wid = __builtin_amdgcn_readfirstlane(tid >> 6), lane = tid & 63, wr = wid >> 2, wc = wid & 3, fr = lane & 15, fq = lane >> 4;
    const int K = g.K, nt = K / BK;
    unsigned voffA[2], voffB[2];
#pragma unroll
    for (int i = 0; i < 2; ++i) { int R, C; stage_rc(tid * 16 + i * 8192, R, C); const int Rb = Epi::PERM ? ((R & ~31) + perm32(R & 31)) : R;
        voffA[i] = (unsigned)(R * K + C) * 2u; voffB[i] = (unsigned)(Rb * K + C) * 2u; }
    const size_t kstep = (size_t)(BK * 2);
    const size_t hstep = (size_t)HALF * K * 2;
    const size_t tstep = 2 * hstep;
    const unsigned ldsw = (unsigned)wid * 1024u;
    const int aoff = lds_byte(wr * 64 + fr, fq * 8), boff = lds_byte(wc * 32 + fr, fq * 8);
#define PG8_SA(b, h) (((b) * 2 + (h)) * HTB)
#define PG8_SB(b, h) ((4 + (b) * 2 + (h)) * HTB)
#define PG8_STAGE(bufoff, gbase, voff) do { _Pragma("unroll") for (int _i = 0; _i < 2; ++_i) \
        __builtin_amdgcn_global_load_lds((const unsigned*)((const char*)(gbase) + (voff)[_i]), (PG8_LAS unsigned*)(lds + (bufoff) + ldsw + _i * 8192), 16, 0, 0); } while (0)
#define PG8_LDA(dst, b, h) do { _Pragma("unroll") for (int m = 0; m < 4; ++m) _Pragma("unroll") for (int k = 0; k < 2; ++k) dst[m][k] = *(const PG8_LAS bf16x8*)(lds + PG8_SA(b, h) + aoff + m * 2048 + k * 1024); } while (0)
#define PG8_LDB(dst, b, h) do { _Pragma("unroll") for (int n = 0; n < 2; ++n) _Pragma("unroll") for (int k = 0; k < 2; ++k) dst[n][k] = *(const PG8_LAS bf16x8*)(lds + PG8_SB(b, h) + boff + n * 2048 + k * 1024); } while (0)
#define PG8_MMA(ai, bj, At, Bt) do { __builtin_amdgcn_s_setprio(1); _Pragma("unroll") for (int m = 0; m < 4; ++m) _Pragma("unroll") for (int n = 0; n < 2; ++n) _Pragma("unroll") for (int k = 0; k < 2; ++k) \
        acc[ai][bj][m][n] = __builtin_amdgcn_mfma_f32_16x16x32_bf16(Bt[n][k], At[m][k], acc[ai][bj][m][n], 0, 0, 0); __builtin_amdgcn_s_setprio(0); } while (0)
#define PG8_WAIT_V(n) asm volatile("s_waitcnt vmcnt(" #n ")" ::: "memory")
#define PG8_WAIT_L(n) asm volatile("s_waitcnt lgkmcnt(" #n ")" ::: "memory")
#define PG8_BAR __builtin_amdgcn_s_barrier()
#define PG8_SCHED __builtin_amdgcn_sched_barrier(0)
    Unit cur, nxt; int ui = 0;
    if (!S.next(0, cur)) return;
    f32x4 acc[2][2][4][2];
#pragma unroll
    for (int a = 0; a < 2; ++a)
#pragma unroll
        for (int b = 0; b < 2; ++b)
#pragma unroll
            for (int m = 0; m < 4; ++m)
#pragma unroll
                for (int n = 0; n < 2; ++n) acc[a][b][m][n] = (f32x4){0.f, 0.f, 0.f, 0.f};
    bf16x8 At[4][2], B0[2][2], B1[2][2];
    const char* cA = (const char*)g.A + (size_t)cur.pm * tstep; const char* cB = (const char*)g.Bt + (size_t)cur.pn * tstep;
    S.a_ready(cur);
    if constexpr (SP2) {
        PG8_STAGE(PG8_SB(0, 0), cB, voffB); PG8_STAGE(PG8_SB(0, 1), cB + hstep, voffB); PG8_STAGE(PG8_SA(0, 0), cA, voffA); PG8_STAGE(PG8_SA(0, 1), cA + hstep, voffA);
        if (wr == 1) PG8_BAR;
        PG8_WAIT_V(2); PG8_BAR;
        PG8_STAGE(PG8_SB(1, 0), cB + kstep, voffB); PG8_STAGE(PG8_SA(1, 0), cA + kstep, voffA); PG8_STAGE(PG8_SB(1, 1), cB + hstep + kstep, voffB);
        PG8_WAIT_V(6); PG8_BAR;
    } else {
        PG8_STAGE(PG8_SB(0, 0), cB, voffB); PG8_STAGE(PG8_SA(0, 0), cA, voffA); PG8_STAGE(PG8_SB(0, 1), cB + hstep, voffB); PG8_STAGE(PG8_SA(0, 1), cA + hstep, voffA);
        if (wr == 1) PG8_BAR;
        PG8_WAIT_V(4); PG8_BAR;
        PG8_STAGE(PG8_SB(1, 0), cB + kstep, voffB); PG8_STAGE(PG8_SA(1, 0), cA + kstep, voffA); PG8_STAGE(PG8_SB(1, 1), cB + hstep + kstep, voffB);
        PG8_WAIT_V(6); PG8_BAR;
    }
    for (;;) {
        const bool has_next = S.next(ui + 1, nxt);
        const char* nA = has_next ? (const char*)g.A + (size_t)nxt.pm * tstep : cA; const char* nB = has_next ? (const char*)g.Bt + (size_t)nxt.pn * tstep : cB;
        for (int t = 0; t < nt; t += 2) {
            const bool last = (t == nt - 2);
            const char* a1 = cA + (size_t)(t + 1) * kstep;
            const char* a2 = last ? nA : cA + (size_t)(t + 2) * kstep; const char* b2 = last ? nB : cB + (size_t)(t + 2) * kstep;
            const char* a3 = a2 + kstep; const char* b3 = b2 + kstep;
            if (last && has_next) S.a_ready(nxt);
            if constexpr (SP2) {
            PG8_LDB(B0, 0, 0); PG8_LDB(B1, 0, 1); PG8_SCHED; PG8_LDA(At, 0, 0); PG8_STAGE(PG8_SA(1, 1), a1 + hstep, voffA);
            PG8_WAIT_V(8); PG8_WAIT_L(0); PG8_BAR; PG8_MMA(0, 0, At, B0); PG8_MMA(0, 1, At, B1); PG8_BAR; PG8_SCHED;
            PG8_LDA(At, 0, 1); PG8_STAGE(PG8_SB(0, 0), b2, voffB); PG8_STAGE(PG8_SB(0, 1), b2 + hstep, voffB); PG8_STAGE(PG8_SA(0, 0), a2, voffA);
            PG8_WAIT_V(8); PG8_WAIT_L(0); PG8_BAR; PG8_MMA(1, 0, At, B0); PG8_MMA(1, 1, At, B1); PG8_BAR; PG8_SCHED;
            PG8_LDB(B0, 1, 0); PG8_LDB(B1, 1, 1); PG8_SCHED; PG8_LDA(At, 1, 0); PG8_STAGE(PG8_SA(0, 1), a2 + hstep, voffA);
            PG8_WAIT_V(8); PG8_WAIT_L(0); PG8_BAR; PG8_MMA(0, 0, At, B0); PG8_MMA(0, 1, At, B1); PG8_BAR; PG8_SCHED;
            PG8_LDA(At, 1, 1); PG8_STAGE(PG8_SB(1, 0), b3, voffB); PG8_STAGE(PG8_SB(1, 1), b3 + hstep, voffB); PG8_STAGE(PG8_SA(1, 0), a3, voffA);
            PG8_WAIT_V(8); PG8_WAIT_L(0); PG8_BAR; PG8_MMA(1, 0, At, B0); PG8_MMA(1, 1, At, B1); PG8_BAR; PG8_SCHED;
            } else {
            PG8_LDB(B0, 0, 0); PG8_SCHED; PG8_LDA(At, 0, 0); PG8_STAGE(PG8_SA(1, 1), a1 + hstep, voffA);
            PG8_WAIT_L(8); PG8_BAR; PG8_WAIT_L(0); PG8_MMA(0, 0, At, B0); PG8_BAR; PG8_SCHED;
            PG8_LDB(B1, 0, 1); PG8_STAGE(PG8_SB(0, 0), b2, voffB);
            PG8_BAR; PG8_WAIT_L(0); PG8_MMA(0, 1, At, B1); PG8_BAR;
            PG8_LDA(At, 0, 1); PG8_STAGE(PG8_SA(0, 0), a2, voffA);
            PG8_BAR; PG8_WAIT_L(0); PG8_MMA(1, 0, At, B0); PG8_BAR; PG8_SCHED;
            PG8_STAGE(PG8_SB(0, 1), b2 + hstep, voffB);
            PG8_WAIT_V(6); PG8_BAR; PG8_MMA(1, 1, At, B1); PG8_BAR;
            PG8_LDB(B0, 1, 0); PG8_SCHED; PG8_LDA(At, 1, 0); PG8_STAGE(PG8_SA(0, 1), a2 + hstep, voffA);
            PG8_WAIT_L(8); PG8_BAR; PG8_WAIT_L(0); PG8_MMA(0, 0, At, B0); PG8_BAR; PG8_SCHED;
            PG8_LDB(B1, 1, 1); PG8_STAGE(PG8_SB(1, 0), b3, voffB);
            PG8_BAR; PG8_WAIT_L(0); PG8_MMA(0, 1, At, B1); PG8_BAR;
            PG8_LDA(At, 1, 1); PG8_STAGE(PG8_SA(1, 0), a3, voffA);
            PG8_BAR; PG8_WAIT_L(0); PG8_MMA(1, 0, At, B0); PG8_BAR; PG8_SCHED;
            PG8_STAGE(PG8_SB(1, 1), b3 + hstep, voffB);
            PG8_WAIT_V(6); PG8_BAR; PG8_MMA(1, 1, At, B1); PG8_BAR;
            }
        }
        if constexpr (ALIGN_EPI) { if (wr == 0) PG8_BAR; }
        if constexpr (!Epi::AFTER_DRAIN) { E(acc, cur, wr, wc, fr, fq); S.done(cur); }
        if (!has_next) break;
#pragma unroll
        for (int a = 0; a < 2; ++a)
#pragma unroll
            for (int b = 0; b < 2; ++b)
#pragma unroll
                for (int m = 0; m < 4; ++m)
#pragma unroll
                    for (int n = 0; n < 2; ++n) acc[a][b][m][n] = (f32x4){0.f, 0.f, 0.f, 0.f};
        cur = nxt; cA = nA; cB = nB; ++ui;
        if constexpr (ALIGN_EPI) { if (wr == 1) PG8_BAR; }
    }
    PG8_WAIT_V(0);
    if constexpr (!ALIGN_EPI) { if (wr == 0) PG8_BAR; }
    PG8_BAR;
    if constexpr (Epi::AFTER_DRAIN) { E.fused(acc, cur, wr, wc, fr, fq, lds, wid, lane); S.done(cur); }
#undef PG8_SA
#undef PG8_SB
#undef PG8_STAGE
#undef PG8_LDA
#undef PG8_LDB
#undef PG8_MMA
#undef PG8_WAIT_V
#undef PG8_WAIT_L
#undef PG8_BAR
#undef PG8_SCHED
}
}

constexpr int DM = 2048, NTOK = 16384, NCTX = 8192, CTX_T = 256, LAT_T = 4096, PAST = 512;
constexpr int DFF = 5632, NFF2 = 11264, INC = 5120, MODW = 18432;
constexpr int ZQ = 0, ZK = 1024, ZV = 1280, ZRQ = 1536, ZRF = 2048, ZRB = 2560, ZRI = 3072, ZRG = 3584, ZCA = 4096, ZCB = 4608;
constexpr float EPS = 1e-6f;
constexpr size_t OUT_Y = 0, OUT_CK = 33554432, OUT_CV = 37748736, OUT_ST = 41943040, OUT_TOTAL = 50331648;
constexpr size_t MiB = 1u << 20;
constexpr size_t WS_CTL = 0, WS_MOD = 1 * MiB, CTL_ZERO_BYTES = 2 * MiB;
constexpr size_t WS_WFI = 2 * MiB;
constexpr size_t WS_WFO = 178 * MiB;
constexpr size_t WS_WIN = 266 * MiB;
constexpr size_t WS_WOUT = 306 * MiB;
constexpr size_t WS_H = 322 * MiB;
constexpr size_t WS_MIX = 386 * MiB;
constexpr size_t WS_Z = 450 * MiB;
constexpr size_t WS_US = 770 * MiB;
constexpr size_t WS_DEC = 1026 * MiB;
constexpr size_t WS_Q = 1028 * MiB;
constexpr size_t WS_K = 1060 * MiB;
constexpr size_t WS_V = 1068 * MiB;
constexpr size_t WS_CK = 1076 * MiB;
constexpr size_t WS_CV = 1077 * MiB;
constexpr size_t WS_END = 1078 * MiB;
constexpr int CW_BAR = 4096;
constexpr int RING_BYTES = 131072, LDSCTL_OFF = RING_BYTES, LDS_BYTES = 147456;

#define GAS __attribute__((address_space(1)))
#define LAS __attribute__((address_space(3)))
typedef unsigned short bf16;
typedef unsigned v4u __attribute__((ext_vector_type(4)));
typedef unsigned v2u __attribute__((ext_vector_type(2)));
typedef float f32x4 __attribute__((ext_vector_type(4)));
typedef float f32x2 __attribute__((ext_vector_type(2)));
typedef short bf16x8 __attribute__((ext_vector_type(8)));
#define LDS_WAIT() asm volatile("s_waitcnt lgkmcnt(0)" ::: "memory")
#define VM_WAIT() asm volatile("s_waitcnt vmcnt(0)" ::: "memory")
__device__ __forceinline__ unsigned pk2(float lo, float hi) { return pg8::cvt_pk_bf16(lo, hi); }
__device__ __forceinline__ unsigned short f2bf(float f) { return (unsigned short)(pg8::cvt_pk_bf16(f, 0.f) & 0xffffu); }
__device__ __forceinline__ float sigm(float x) { return __builtin_amdgcn_rcpf(1.f + __expf(-x)); }
__device__ __forceinline__ float siluf(float x) { return x * __builtin_amdgcn_rcpf(1.f + __expf(-x)); }
__device__ __forceinline__ float wave_sum(float v) {
#pragma unroll
    for (int o = 1; o < 64; o <<= 1) v += __shfl_xor(v, o);
    return v;
}

namespace pg8 {
struct EpiF32 {
    static constexpr bool PERM = false, AFTER_DRAIN = false;
    float* C; int ldc;
    __device__ __forceinline__ void operator()(const f32x4 (&acc)[2][2][4][2], const Unit& u, int wr, int wc, int fr, int fq) const {
        const int row0 = u.pm * BM + wr * 64 + fr, col0 = u.pn * BM + wc * 32 + 4 * fq;
#pragma unroll
        for (int ai = 0; ai < 2; ++ai)
#pragma unroll
            for (int m = 0; m < 4; ++m) { float* rowp = C + (size_t)(row0 + ai * HALF + m * 16) * ldc + col0;
#pragma unroll
                for (int bj = 0; bj < 2; ++bj)
#pragma unroll
                    for (int n = 0; n < 2; ++n) *(f32x4*)(rowp + bj * HALF + n * 16) = acc[ai][bj][m][n]; }
    }
};
struct EpiSwiGLU {
    static constexpr bool PERM = true, AFTER_DRAIN = false;
    bf16_t* O; int ldc;
    __device__ __forceinline__ void operator()(const f32x4 (&acc)[2][2][4][2], const Unit& u, int wr, int wc, int fr, int fq) const {
        const int row0 = u.pm * BM + wr * 64 + fr, col0 = u.pn * HALF + wc * 32 + 8 * fq;
#pragma unroll
        for (int ai = 0; ai < 2; ++ai)
#pragma unroll
            for (int m = 0; m < 4; ++m) { bf16_t* rowp = O + (size_t)(row0 + ai * HALF + m * 16) * ldc + col0;
                float v[8];
#pragma unroll
                for (int n = 0; n < 2; ++n)
#pragma unroll
                    for (int j = 0; j < 4; ++j) { const float a = acc[ai][0][m][n][j], b = acc[ai][1][m][n][j];
                        v[n * 4 + j] = a * __builtin_amdgcn_rcpf(1.f + __expf(-a)) * b; }
                u32x4 w; w.x = cvt_pk_bf16(v[0], v[1]); w.y = cvt_pk_bf16(v[2], v[3]); w.z = cvt_pk_bf16(v[4], v[5]); w.w = cvt_pk_bf16(v[6], v[7]);
                *(u32x4*)rowp = w; }
    }
};
struct EpiResid {
    static constexpr bool PERM = false, AFTER_DRAIN = false;
    float* X; const float* gm; const float* gb; float scale;
    __device__ __forceinline__ void operator()(const f32x4 (&acc)[2][2][4][2], const Unit& u, int wr, int wc, int fr, int fq) const {
        const int row0 = u.pm * BM + wr * 64 + fr, col0 = u.pn * BM + wc * 32 + 4 * fq;
        const int cond = u.pm < 32 ? 0 : 1 + ((u.pm - 32) >> 4);
        const float* g0 = gm + (size_t)cond * 2 * 18432;
        f32x4 gv[2][2];
#pragma unroll
        for (int bj = 0; bj < 2; ++bj)
#pragma unroll
            for (int n = 0; n < 2; ++n) gv[bj][n] = (*(const f32x4*)(g0 + col0 + bj * HALF + n * 16) + *(const f32x4*)(gb + col0 + bj * HALF + n * 16)) * scale;
#pragma unroll
        for (int ai = 0; ai < 2; ++ai)
#pragma unroll
            for (int m = 0; m < 4; ++m) { float* rowp = X + (size_t)(row0 + ai * HALF + m * 16) * 2048 + col0;
#pragma unroll
                for (int bj = 0; bj < 2; ++bj)
#pragma unroll
                    for (int n = 0; n < 2; ++n) { f32x4* p = (f32x4*)(rowp + bj * HALF + n * 16); *p = *p + gv[bj][n] * acc[ai][bj][m][n]; }
                asm volatile("" ::: "memory"); }
    }
};
}
#define XB_TMO      128
#define XB_XCNT(j)  (256  + 64 * (j))
#define XB_XSUB(j)  (1280 + 64 * (j))
#define XB_XGEN(j)  (2304 + 64 * (j))
#define XB_TOP      3328
#define XB_TOPGEN   3392
#define XCD_BAR_WORDS 3456
#define XB_SPIN_CAP (1u << 18)

__device__ __forceinline__ unsigned xb_ld(unsigned* p)              { return __hip_atomic_load(p, __ATOMIC_RELAXED, __HIP_MEMORY_SCOPE_AGENT); }
__device__ __forceinline__ unsigned xb_add(unsigned* p, unsigned v) { return __hip_atomic_fetch_add(p, v, __ATOMIC_RELAXED, __HIP_MEMORY_SCOPE_AGENT); }
__device__ __forceinline__ unsigned xb_xcc_id() { return (unsigned)__builtin_amdgcn_s_getreg((3 << 11) | 20) & 0xFu; }
#define XB_SPIN(cond, bar) do { unsigned _sp = 0; while (cond) { __builtin_amdgcn_s_sleep(1); \
    if ((++_sp & 255u) == 0u) { if (xb_ld(&(bar)[XB_TMO])) break; if (_sp > XB_SPIN_CAP) { atomicAdd(&(bar)[XB_TMO], 1u); break; } } } } while (0)

struct XcdBarrier {
    unsigned* bar; unsigned x;
    volatile LAS unsigned* st;
};

__device__ __forceinline__ XcdBarrier xcd_barrier_post(unsigned* bar, volatile LAS unsigned* st) {
    XcdBarrier b; b.bar = bar; b.x = xb_xcc_id(); b.st = st;
    if (threadIdx.x == 0) (void)xb_add(&bar[XB_XCNT(b.x)], 1u);
    return b;
}
__device__ __forceinline__ void xcd_barrier_complete(unsigned* bar, unsigned x, unsigned& nloc, unsigned& nx) {
    const unsigned G = gridDim.x * gridDim.y * gridDim.z;
    unsigned sum, cnt, mine, sp = 0u;
    for (;;) {
        sum = 0u; cnt = 0u; mine = 0u;
#pragma unroll
        for (unsigned j = 0; j < 16; ++j) { const unsigned c = xb_ld(&bar[XB_XCNT(j)]); sum += c; cnt += (c > 0u) ? 1u : 0u; mine = (j == x) ? c : mine; }
        if (sum == G) break;
        __builtin_amdgcn_s_sleep(1);
        if ((++sp & 255u) == 0u) { if (xb_ld(&bar[XB_TMO])) break; if (sp > XB_SPIN_CAP) { atomicAdd(&bar[XB_TMO], 1u); break; } }
    }
    nloc = mine > 0u ? mine : 1u; nx = cnt > 0u ? cnt : 1u;
}

__device__ __forceinline__ void xcd_barrier(const XcdBarrier& b) {
    asm volatile("s_waitcnt vmcnt(0)" ::: "memory");
    __syncthreads();
    if (threadIdx.x == 0) {
        unsigned* bar = b.bar;
        __builtin_amdgcn_s_waitcnt(0);
        unsigned nloc = b.st[0], nx = b.st[1];
        if (nloc == 0u) { xcd_barrier_complete(bar, b.x, nloc, nx); b.st[0] = nloc; b.st[1] = nx; }
        const unsigned old = xb_add(&bar[XB_XSUB(b.x)], 1u);
        const unsigned gen = old / nloc;
        if (old + 1u == (gen + 1u) * nloc) {
            __builtin_amdgcn_fence(__ATOMIC_RELEASE, "agent");
            asm volatile("s_waitcnt vmcnt(0)" ::: "memory");
            const unsigned og = xb_add(&bar[XB_TOP], 1u);
            const unsigned tg = og / nx;
            if (og + 1u == (tg + 1u) * nx) xb_add(&bar[XB_TOPGEN], 1u);
            else XB_SPIN(xb_ld(&bar[XB_TOPGEN]) == tg, bar);
            __builtin_amdgcn_fence(__ATOMIC_ACQUIRE, "agent");
            xb_add(&bar[XB_XGEN(b.x)], 1u);
            asm volatile("s_waitcnt vmcnt(0)" ::: "memory");
        } else {
            XB_SPIN(xb_ld(&bar[XB_XGEN(b.x)]) == gen, bar);
            __builtin_amdgcn_fence(__ATOMIC_ACQUIRE, "agent");
            asm volatile("s_waitcnt vmcnt(0)" ::: "memory");
        }
    }
    __syncthreads();
}

namespace att {
constexpr int D = 128, NW = 8, QBLK = 32, KVBLK = 64;
constexpr float SCALE = 0.088388347648318440f;
constexpr float THR = 8.f;
#ifndef ATT_SDEPTH
#define ATT_SDEPTH 1
#endif
constexpr int SDEPTH = ATT_SDEPTH;
constexpr int LDQ = 1024, LDK = 256, LDO = 2048;
constexpr size_t SHM_V = KVBLK * D * 2, SHM_K = KVBLK * D * 2, SHM_ATTN = 2 * SHM_V + 2 * SHM_K + NW * 64 * 4;
using s16x4  = __attribute__((ext_vector_type(4))) short;
using f32x16 = __attribute__((ext_vector_type(16))) float;
#define KSWZ(row, colB) ((row) * 256 + ((colB) ^ (((row) & 7) << 4)))
#define SBAR() __builtin_amdgcn_sched_barrier(0)
__device__ __forceinline__ int crow(int r, int hi) { return (r & 3) + 8 * (r >> 2) + 4 * hi; }
__device__ __forceinline__ unsigned cvtpk(float lo, float hi) { unsigned r; asm volatile("v_cvt_pk_bf16_f32 %0, %1, %2" : "=v"(r) : "v"(lo), "v"(hi)); return r; }

__device__ __forceinline__ void partialSM(f32x16& p0, f32x16& p1, float& m_reg, float& mn, float& alpha) {
  constexpr float C = SCALE * 1.4426950408889634f;
  float pmax = p0[0]; for (int r = 1; r < 16; ++r) pmax = fmaxf(pmax, p0[r]); for (int r = 0; r < 16; ++r) pmax = fmaxf(pmax, p1[r]);
  { auto rr = __builtin_amdgcn_permlane32_swap(__float_as_uint(pmax), __float_as_uint(pmax), false, false);
    pmax = fmaxf(__uint_as_float(rr[0]), __uint_as_float(rr[1])); }
  if (__builtin_expect(__all(pmax - m_reg <= THR / SCALE), 1)) { mn = m_reg; alpha = 1.f; }
  else { mn = fmaxf(m_reg, pmax); alpha = __builtin_amdgcn_exp2f((m_reg - mn) * C); m_reg = mn; }
  float mnC = -mn * C;
  for (int r = 0; r < 16; ++r) p0[r] = fmaf(p0[r], C, mnC); for (int r = 0; r < 16; ++r) p1[r] = fmaf(p1[r], C, mnC);
  for (int r = 0; r < 16; ++r) p0[r] = __builtin_amdgcn_exp2f(p0[r]);
}
__device__ __forceinline__ void finishSM(f32x16& p0, f32x16& p1, float alpha, float& l_reg, bf16x8& pa0, bf16x8& pa1, bf16x8& pa2, bf16x8& pa3) {
  for (int r = 0; r < 16; ++r) p1[r] = __builtin_amdgcn_exp2f(p1[r]);
  float ps = 0; for (int r = 0; r < 16; ++r) ps += p0[r]; for (int r = 0; r < 16; ++r) ps += p1[r];
  { auto rr = __builtin_amdgcn_permlane32_swap(__float_as_uint(ps), __float_as_uint(ps), false, false);
    ps = __uint_as_float(rr[0]) + __uint_as_float(rr[1]); }
  l_reg = l_reg * alpha + ps;
#define PK4(P, BASE, OUT) do { unsigned a0 = cvtpk(P[BASE + 0], P[BASE + 1]), a1 = cvtpk(P[BASE + 2], P[BASE + 3]);   \
    unsigned b0 = cvtpk(P[BASE + 4], P[BASE + 5]), b1 = cvtpk(P[BASE + 6], P[BASE + 7]);                              \
    auto r0 = __builtin_amdgcn_permlane32_swap(a0, b0, false, false); auto r1 = __builtin_amdgcn_permlane32_swap(a1, b1, false, false); \
    v4u w = {r0[0], r1[0], r0[1], r1[1]}; OUT = *reinterpret_cast<bf16x8*>(&w); } while (0)
  PK4(p0, 0, pa0); PK4(p0, 8, pa1); PK4(p1, 0, pa2); PK4(p1, 8, pa3);
#undef PK4
}
__device__ __forceinline__ void qkt(f32x16& p0, f32x16& p1, const bf16* Ks, const bf16x8* qr, int r32, int hi) {
  p0 = f32x16{}; p1 = f32x16{};
  for (int d0 = 0; d0 < 8; ++d0) { int cb = (d0 * 16 + hi * 8) * 2;
    bf16x8 b0 = *reinterpret_cast<const bf16x8*>((const char*)Ks + KSWZ(r32, cb));
    bf16x8 b1 = *reinterpret_cast<const bf16x8*>((const char*)Ks + KSWZ(32 + r32, cb));
    p0 = __builtin_amdgcn_mfma_f32_32x32x16_bf16(b0, qr[d0], p0, 0, 0, 0);
    p1 = __builtin_amdgcn_mfma_f32_32x32x16_bf16(b1, qr[d0], p1, 0, 0, 0); }
}
__device__ __forceinline__ int v_st(int k, int c) { const int kk = (k & ~0xC) | ((k & 4) << 1) | ((k & 8) >> 1); return ((kk >> 3) * 4 + (c >> 5)) * 512 + ((kk & 7) * 32 + (c & 31)) * 2; }
__device__ __forceinline__ int v_rd_base(int lane) { return ((lane & 3) << 3) | (((lane >> 2) & 3) << 6) | (((lane >> 4) & 1) << 5) | (((lane >> 5) & 1) << 8); }
constexpr int v_rd_off(int d0, int ks, int half) { return d0 * 512 + ks * 4096 + half * 2048; }
template <int OFF> __device__ __forceinline__ s16x4 tr_read(int vb) {
  s16x4 r; asm volatile("ds_read_b64_tr_b16 %0, %1 offset:%2" : "=&v"(r) : "v"(vb), "i"(OFF) : "memory"); return r;
}
template <int D0> __device__ __forceinline__ void pv_one(f32x16& od, int vb, bf16x8 pa0, bf16x8 pa1, bf16x8 pa2, bf16x8 pa3) {
  const s16x4 l0 = tr_read<v_rd_off(D0, 0, 0)>(vb), h0 = tr_read<v_rd_off(D0, 0, 1)>(vb), l1 = tr_read<v_rd_off(D0, 1, 0)>(vb), h1 = tr_read<v_rd_off(D0, 1, 1)>(vb);
  const s16x4 l2 = tr_read<v_rd_off(D0, 2, 0)>(vb), h2 = tr_read<v_rd_off(D0, 2, 1)>(vb), l3 = tr_read<v_rd_off(D0, 3, 0)>(vb), h3 = tr_read<v_rd_off(D0, 3, 1)>(vb);
  asm volatile("s_waitcnt lgkmcnt(0)" ::: "memory"); SBAR();
#define PK(L, H) (bf16x8){L[0], L[1], L[2], L[3], H[0], H[1], H[2], H[3]}
  od = __builtin_amdgcn_mfma_f32_32x32x16_bf16(pa0, PK(l0, h0), od, 0, 0, 0);
  od = __builtin_amdgcn_mfma_f32_32x32x16_bf16(pa1, PK(l1, h1), od, 0, 0, 0);
  od = __builtin_amdgcn_mfma_f32_32x32x16_bf16(pa2, PK(l2, h2), od, 0, 0, 0);
  od = __builtin_amdgcn_mfma_f32_32x32x16_bf16(pa3, PK(l3, h3), od, 0, 0, 0);
#undef PK
}
__device__ __forceinline__ void pv_d0(f32x16* o, int vb, bf16x8 pa0, bf16x8 pa1, bf16x8 pa2, bf16x8 pa3) {
  pv_one<0>(o[0], vb, pa0, pa1, pa2, pa3); pv_one<1>(o[1], vb, pa0, pa1, pa2, pa3); pv_one<2>(o[2], vb, pa0, pa1, pa2, pa3); pv_one<3>(o[3], vb, pa0, pa1, pa2, pa3);
}
struct KVSrc { const bf16* Kl; const bf16* Vl; const bf16* Kc; const bf16* Vc; int nloc, kstart, nrows; };

__device__ __forceinline__ void attn_body(const bf16* __restrict__ Qb, const KVSrc src, bf16* __restrict__ Ob, int NT, float sink_raw, int qpos0, char* lds) {
  const int tid = threadIdx.x, wid = tid >> 6, lane = tid & 63, r32 = lane & 31, hi = lane >> 5;
  bf16* V_lds = (bf16*)lds; bf16* K_lds = (bf16*)(lds + 2 * SHM_V);
  float* ws = (float*)(lds + 2 * SHM_V + 2 * SHM_K) + wid * 64; float* li_l = ws; float* al_l = ws + 32;
  float m_reg = sink_raw, l_reg = 1.f; f32x16 o[4] = {}; bf16x8 qr[8];
  const bf16* Qw = Qb + (long)(wid * QBLK + r32) * LDQ + hi * 8;
#pragma unroll
  for (int d0 = 0; d0 < 8; ++d0) qr[d0] = *reinterpret_cast<const bf16x8*>(Qw + d0 * 16);
  const int sr = tid >> 4, sc = (tid & 15) * 8, vst0 = v_st(sr, sc), vst1 = v_st(32 + sr, sc);
  const int vb0 = (int)(uintptr_t)V_lds + v_rd_base(lane);
  const int qpos = qpos0 + wid * QBLK + r32;
  struct { bf16x8 vs0, vs1, ks0, ks1; } sr_[SDEPTH];
#define SLOAD(i, t) do { const bf16 *kp_, *vp_; int r0_, r1_; const int t_ = (t);                                                      \
    if (t_ < src.nloc) { const int k0_ = src.kstart + t_ * KVBLK; r0_ = k0_ + sr; r1_ = k0_ + 32 + sr;                                   \
      r0_ = r0_ < 0 ? 0 : (r0_ >= src.nrows ? src.nrows - 1 : r0_); r1_ = r1_ < 0 ? 0 : (r1_ >= src.nrows ? src.nrows - 1 : r1_); kp_ = src.Kl; vp_ = src.Vl; } \
    else { const int k0_ = (t_ - src.nloc) * KVBLK; r0_ = k0_ + sr; r1_ = k0_ + 32 + sr; kp_ = src.Kc; vp_ = src.Vc; }                  \
    sr_[i].vs0 = *reinterpret_cast<const bf16x8*>(vp_ + (long)r0_ * LDK + sc); sr_[i].vs1 = *reinterpret_cast<const bf16x8*>(vp_ + (long)r1_ * LDK + sc); \
    sr_[i].ks0 = *reinterpret_cast<const bf16x8*>(kp_ + (long)r0_ * LDK + sc); sr_[i].ks1 = *reinterpret_cast<const bf16x8*>(kp_ + (long)r1_ * LDK + sc); } while (0)
#define SWRITE(b, i) do { *(bf16x8*)((char*)V_lds + (b) * SHM_V + vst0) = sr_[i].vs0;          \
    *(bf16x8*)((char*)V_lds + (b) * SHM_V + vst1) = sr_[i].vs1; int kc = sc * 2;               \
    *(bf16x8*)((char*)K_lds + (b) * SHM_K + KSWZ(sr, kc)) = sr_[i].ks0;                       \
    *(bf16x8*)((char*)K_lds + (b) * SHM_K + KSWZ(32 + sr, kc)) = sr_[i].ks1; } while (0)
#define SWAIT() do { if constexpr (SDEPTH == 2) asm volatile("s_waitcnt vmcnt(4)" ::: "memory"); else asm volatile("s_waitcnt vmcnt(0)" ::: "memory"); } while (0)
#define RESC(a) do { if (__any((a) < 1.f)) { if (hi == 0) al_l[r32] = (a); asm volatile("s_waitcnt lgkmcnt(0)" ::: "memory"); \
    for (int d = 0; d < 4; ++d) for (int r = 0; r < 16; ++r) o[d][r] *= al_l[crow(r, hi)]; } } while (0)
#define MASK(P0, P1, t) do { const int t_ = (t); if (t_ < src.nloc) { const int kb_ = src.kstart + t_ * KVBLK;                           \
    _Pragma("unroll") for (int r = 0; r < 16; ++r) { const int k0_ = kb_ + crow(r, hi), k1_ = k0_ + 32;                                  \
      const int d0_ = qpos - k0_, d1_ = qpos - k1_;                                                                                     \
      const bool v0_ = (k0_ >= 0) && (k0_ < src.nrows) && (d0_ <= 128) && (d0_ >= -128);                                                 \
      const bool v1_ = (k1_ >= 0) && (k1_ < src.nrows) && (d1_ <= 128) && (d1_ >= -128);                                                 \
      P0[r] = v0_ ? P0[r] : -1e30f; P1[r] = v1_ ? P1[r] : -1e30f; } } } while (0)
  f32x16 pA0, pA1, pB0, pB1; float mnA, mnB, alA, alB; bf16x8 pa0, pa1, pa2, pa3;
  constexpr int SE = 0, SO = SDEPTH - 1;
  SLOAD(SE, 0); asm volatile("s_waitcnt vmcnt(0)" ::: "memory"); SWRITE(0, SE); __syncthreads();
  qkt(pA0, pA1, K_lds, qr, r32, hi); MASK(pA0, pA1, 0); partialSM(pA0, pA1, m_reg, mnA, alA);
  SLOAD(SO, 1); if constexpr (SDEPTH == 2) { if (2 < NT) SLOAD(SE, 2); }
  SWAIT(); SWRITE(1, SO); __syncthreads();
  for (int j = 1; j + 1 < NT; j += 2) {
    SBAR(); qkt(pB0, pB1, (bf16*)((char*)K_lds + SHM_K), qr, r32, hi);
    finishSM(pA0, pA1, alA, l_reg, pa0, pa1, pa2, pa3); SBAR();
    SLOAD(SO, j + SDEPTH); SBAR();
    pv_d0(o, vb0, pa0, pa1, pa2, pa3); MASK(pB0, pB1, j); partialSM(pB0, pB1, m_reg, mnB, alB);
    __syncthreads(); SWAIT(); SWRITE(0, SE);
    RESC(alB); __syncthreads();
    SBAR(); qkt(pA0, pA1, K_lds, qr, r32, hi);
    finishSM(pB0, pB1, alB, l_reg, pa0, pa1, pa2, pa3); SBAR();
    if (SDEPTH == 1 || j + 3 < NT) SLOAD(SE, j + 1 + SDEPTH); SBAR();
    pv_d0(o, vb0 + (int)SHM_V, pa0, pa1, pa2, pa3); MASK(pA0, pA1, j + 1); partialSM(pA0, pA1, m_reg, mnA, alA);
    __syncthreads(); SWAIT(); SWRITE(1, SO);
    RESC(alA); __syncthreads();
  }
  SBAR(); qkt(pB0, pB1, (bf16*)((char*)K_lds + SHM_K), qr, r32, hi);
  finishSM(pA0, pA1, alA, l_reg, pa0, pa1, pa2, pa3); SBAR();
  pv_d0(o, vb0, pa0, pa1, pa2, pa3); MASK(pB0, pB1, NT - 1); partialSM(pB0, pB1, m_reg, mnB, alB);
  __syncthreads(); RESC(alB);
  finishSM(pB0, pB1, alB, l_reg, pa0, pa1, pa2, pa3); SBAR();
  pv_d0(o, vb0 + (int)SHM_V, pa0, pa1, pa2, pa3);
  if (hi == 0) li_l[r32] = l_reg; asm volatile("s_waitcnt lgkmcnt(0)" ::: "memory");
  float rli[16];
#pragma unroll
  for (int r = 0; r < 16; ++r) rli[r] = __builtin_amdgcn_rcpf(li_l[crow(r, hi)]);
  bf16* Ow = Ob + (long)(wid * QBLK) * LDO;
#pragma unroll
  for (int r = 0; r < 16; ++r) { int orow = crow(r, hi);
    for (int d0 = 0; d0 < 4; ++d0) Ow[(long)orow * LDO + d0 * 32 + r32] = f2bf(o[d0][r] * rli[r]); }
  __syncthreads();
#undef SLOAD
#undef SWRITE
#undef SWAIT
#undef RESC
#undef MASK
}
}

struct Args { const float* in[23]; float* out; unsigned char* ws; int ph_lo, ph_hi; };
enum { I_XP = 0, I_XS, I_CK, I_CV, I_ST, I_C, I_CCTX, I_WADA, I_BADA, I_NG, I_WFI, I_WFO, I_WIN, I_WOUT, I_QG, I_KG, I_SINK, I_LB, I_RG, I_CW, I_CB, I_CLG, I_CLB };

__device__ __forceinline__ void transpose_item(const float* W, int K, int N, bf16* WT, LAS float* scr, int item, int lane, bool interleave) {
    const int nblk = N / 32, kb = item / nblk, nb = item % nblk, k0 = 64 * kb, n0 = 32 * nb;
    int dn0 = n0;
    if (interleave) { const int hh = n0 >= DFF ? 1 : 0, m = n0 - hh * DFF; dn0 = 256 * (m >> 7) + 128 * hh + (m & 127); }
#pragma unroll 8
    for (int i = 0; i < 32; ++i) { const int kk = 2 * i + (lane >> 5); scr[kk * 33 + (lane & 31)] = W[(size_t)(k0 + kk) * N + n0 + (lane & 31)]; }
    LDS_WAIT(); asm volatile("" ::: "memory");
    const int c = lane & 7;
#pragma unroll
    for (int j = 0; j < 4; ++j) { const int n = (lane >> 3) + 8 * j; const LAS float* s = scr + (8 * c) * 33 + n;
        v4u o; o.x = pk2(s[0 * 33], s[1 * 33]); o.y = pk2(s[2 * 33], s[3 * 33]); o.z = pk2(s[4 * 33], s[5 * 33]); o.w = pk2(s[6 * 33], s[7 * 33]);
        *(v4u*)(WT + (size_t)(dn0 + n) * K + k0 + 8 * c) = o; }
    LDS_WAIT(); asm volatile("" ::: "memory");
}

__device__ __forceinline__ void phase_p0(const Args& a, LAS unsigned char* lds, int vcu, int G) {
    const int tid = threadIdx.x, lane = tid & 63, wave = tid >> 6;
    unsigned char* ws = a.ws;
    {
        LAS float* scr = (LAS float*)(lds + wave * 16384);
        const int gw = vcu * 8 + wave, NGW = G * 8;
        constexpr int I_FI = 32 * 352, I_FO = 88 * 64, I_IN = 32 * 160, I_OUT = 32 * 64, I_LAYER = 2 * I_FI + 2 * I_FO + I_IN + I_OUT;
        for (int it = gw; it < 2 * I_LAYER; it += NGW) {
            const int l = it / I_LAYER; int r = it % I_LAYER;
            if (r < 2 * I_FI) { const int s = r / I_FI; r -= s * I_FI;
                transpose_item(a.in[I_WFI] + (size_t)(l * 2 + s) * DM * NFF2, DM, NFF2, (bf16*)(ws + WS_WFI) + (size_t)(l * 2 + s) * NFF2 * DM, scr, r, lane, true); continue; }
            r -= 2 * I_FI;
            if (r < 2 * I_FO) { const int s = r / I_FO; r -= s * I_FO;
                transpose_item(a.in[I_WFO] + (size_t)(l * 2 + s) * DFF * DM, DFF, DM, (bf16*)(ws + WS_WFO) + (size_t)(l * 2 + s) * DM * DFF, scr, r, lane, false); continue; }
            r -= 2 * I_FO;
            if (r < I_IN) { transpose_item(a.in[I_WIN] + (size_t)l * DM * INC, DM, INC, (bf16*)(ws + WS_WIN) + (size_t)l * INC * DM, scr, r, lane, false); continue; }
            r -= I_IN;
            transpose_item(a.in[I_WOUT] + (size_t)l * DM * DM, DM, DM, (bf16*)(ws + WS_WOUT) + (size_t)l * DM * DM, scr, r, lane, false);
        }
    }
    __syncthreads();
    {
        LAS float* scs = (LAS float*)lds;
        for (int i = tid; i < 3 * DM; i += 512) { const int cond = i / DM, k = i % DM; const float v = cond == 0 ? a.in[I_CCTX][k] : a.in[I_C][(cond - 1) * DM + k]; scs[i] = siluf(v); }
        __syncthreads();
        float* mod = (float*)(ws + WS_MOD);
        const int NIT = 18 * 128, it0 = (int)(((long)vcu * NIT) / G), it1 = (int)(((long)(vcu + 1) * NIT) / G);
        int cur = -1; float acc[3][4];
#pragma unroll
        for (int c = 0; c < 3; ++c)
#pragma unroll
            for (int j = 0; j < 4; ++j) acc[c][j] = 0.f;
        for (int it = it0; it <= it1; ++it) {
            const int lc = it < it1 ? it / 128 : -2;
            if (lc != cur) {
                if (cur >= 0) { const int l = cur / 9, cr = cur % 9;
#pragma unroll
                    for (int c = 0; c < 3; ++c)
#pragma unroll
                        for (int j = 0; j < 4; ++j) { atomicAdd(mod + (size_t)(c * 2 + l) * MODW + cr * 2048 + 4 * tid + j, acc[c][j]); acc[c][j] = 0.f; } }
                cur = lc;
            }
            if (it == it1) break;
            const int l = lc / 9, cr = lc % 9, ks = it % 128;
            const float* Wp = a.in[I_WADA] + ((size_t)l * DM + ks * 16) * MODW + cr * 2048 + 4 * tid;
#pragma unroll
            for (int kk = 0; kk < 16; ++kk) { const f32x4 w = *(const f32x4*)(Wp + (size_t)kk * MODW); const int k = ks * 16 + kk;
                const float s0 = scs[k], s1 = scs[DM + k], s2 = scs[2 * DM + k];
#pragma unroll
                for (int j = 0; j < 4; ++j) { acc[0][j] += s0 * w[j]; acc[1][j] += s1 * w[j]; acc[2][j] += s2 * w[j]; } }
        }
    }
    {
        const int gt = vcu * 512 + tid, NGT = G * 512;
        for (int i = gt; i < 2 * 65536; i += NGT) { const int which = i >> 16, g8 = i & 65535;
            const int dg = g8 & 15, pos = (g8 >> 4) & 511, kvh = (g8 >> 13) & 1, bl = g8 >> 14;
            const float* src = a.in[which ? I_CV : I_CK] + (size_t)g8 * 8;
            const f32x4 x0 = *(const f32x4*)src, x1 = *(const f32x4*)(src + 4);
            v4u o; o.x = pk2(x0[0], x0[1]); o.y = pk2(x0[2], x0[3]); o.z = pk2(x1[0], x1[1]); o.w = pk2(x1[2], x1[3]);
            *(v4u*)((bf16*)(ws + (which ? WS_CV : WS_CK)) + ((size_t)bl * 512 + pos) * 256 + kvh * 128 + dg * 8) = o; }
        f32x4* X4 = (f32x4*)a.out; const f32x4* P4 = (const f32x4*)a.in[I_XP]; const f32x4* S4 = (const f32x4*)a.in[I_XS];
        constexpr int HALF4 = NCTX * DM / 4;
        for (int i = gt; i < HALF4; i += NGT) { X4[i] = P4[i]; X4[HALF4 + i] = S4[i]; }
    }
}

__device__ __forceinline__ void phase_norm(const Args& a, int l, int s, int vcu, int G) {
    const int tid = threadIdx.x, lane = tid & 63, wave = tid >> 6;
    const float* X = a.out; bf16* H = (bf16*)(a.ws + WS_H);
    const float* mod = (const float*)(a.ws + WS_MOD); const float* bada = a.in[I_BADA] + (size_t)l * MODW;
    const float* ng = a.in[I_NG] + (size_t)(l * 3 + s) * DM;
    for (int row = vcu * 8 + wave; row < NTOK; row += G * 8) {
        const int cond = row < NCTX ? 0 : 1 + ((row - NCTX) >> 12);
        const float* m0 = mod + (size_t)(cond * 2 + l) * MODW;
        const f32x4* xr = (const f32x4*)(X + (size_t)row * DM) + lane;
        f32x4 v[8]; float ss = 0.f;
#pragma unroll
        for (int j = 0; j < 8; ++j) { v[j] = xr[64 * j]; ss += (v[j].x * v[j].x + v[j].y * v[j].y) + (v[j].z * v[j].z + v[j].w * v[j].w); }
        const float rstd = 1.0f / sqrtf(wave_sum(ss) * (1.f / DM) + EPS);
        v2u* o8 = (v2u*)(H + (size_t)row * DM) + lane;
#pragma unroll
        for (int j = 0; j < 8; ++j) { const int col = 4 * lane + 256 * j;
            const f32x4 g = *(const f32x4*)(ng + col);
            const f32x4 sh = *(const f32x4*)(m0 + (3 * s) * DM + col) + *(const f32x4*)(bada + (3 * s) * DM + col);
            const f32x4 sc = *(const f32x4*)(m0 + (3 * s + 1) * DM + col) + *(const f32x4*)(bada + (3 * s + 1) * DM + col);
            const f32x4 h = v[j] * rstd * g * (sc + 1.0f) + sh;
            v2u w; w.x = pk2(h.x, h.y); w.y = pk2(h.z, h.w); o8[64 * j] = w; }
    }
}

__device__ __forceinline__ float lb_val(const Args& a, int l, int dir, int ch) {
    if (l == 0) return 0.f;
    const float a0 = a.in[I_LB][dir * 512 + ch], a1 = a.in[I_LB][1024 + dir * 512 + ch];
    return 1.f / (1.f + expf(a0 - a1));
}
__device__ __forceinline__ void gate_fn(float z, float lb, float& k, float& lf) {
    const float sg = 1.f / (1.f + expf(-z)), sn = 1.f / (1.f + expf(z));
    const float f = lb + (1.f - lb) * sg;
    lf = logf(fmaxf(f, 1e-30f)); k = (1.f - lb) * sn;
}

__device__ __forceinline__ void phase_prep(const Args& a, int l, int vcu, int G) {
    const int tid = threadIdx.x, lane = tid & 63, wave = tid >> 6;
    const float* Z = (const float*)(a.ws + WS_Z);
    bf16* Qb = (bf16*)(a.ws + WS_Q); bf16* Kb = (bf16*)(a.ws + WS_K); bf16* Vb = (bf16*)(a.ws + WS_V);
    const int hf = lane >> 5, j = lane & 31, e1 = 64 * hf + j, e2 = e1 + 32;
    const float invf = exp2f(-(float)j * (13.287712379549449f / 32.f));
    const float qg1 = a.in[I_QG][l * 128 + e1], qg2 = a.in[I_QG][l * 128 + e2], kg1 = a.in[I_KG][l * 128 + e1], kg2 = a.in[I_KG][l * 128 + e2];
    for (int row = vcu * 8 + wave; row < NTOK; row += G * 8) {
        const float* z = Z + (size_t)row * INC;
        const bool lat = row >= NCTX;
        float cs = 1.f, sn = 0.f;
        if (lat) { const int p = (row - NCTX) & 4095; const int pos = hf ? (p & 63) : (p >> 6); const float ang = (float)pos * invf; cs = cosf(ang); sn = sinf(ang); }
#pragma unroll
        for (int hd = 0; hd < 10; ++hd) {
            const int base = hd < 8 ? ZQ + hd * 128 : ZK + (hd - 8) * 128;
            const float x1 = z[base + e1], x2 = z[base + e2];
            const float rstd = 1.0f / sqrtf(wave_sum(x1 * x1 + x2 * x2) * (1.f / 128.f) + EPS);
            float y1 = x1 * rstd * (hd < 8 ? qg1 : kg1), y2 = x2 * rstd * (hd < 8 ? qg2 : kg2);
            if (!lat && hd >= 8) { const int b = row >> 8, pos = row & 255; float* ck = a.out + OUT_CK + ((((size_t)b * 2 + l) * 2 + (hd - 8)) * 256 + pos) * 128; ck[e1] = y1; ck[e2] = y2; }
            if (lat) { const float r1 = y1 * cs - y2 * sn, r2 = y1 * sn + y2 * cs; y1 = r1; y2 = r2; }
            if (hd < 8) { bf16* q = Qb + (size_t)row * 1024 + hd * 128; q[e1] = f2bf(y1); q[e2] = f2bf(y2); }
            else { bf16* k = Kb + (size_t)row * 256 + (hd - 8) * 128; k[e1] = f2bf(y1); k[e2] = f2bf(y2); }
        }
        const f32x4 v = *(const f32x4*)(z + ZV + 4 * lane);
        v2u w; w.x = pk2(v.x, v.y); w.y = pk2(v.z, v.w); *((v2u*)(Vb + (size_t)row * 256) + lane) = w;
        if (!lat) { const int b = row >> 8, pos = row & 255, kvh = lane >> 5; *(f32x4*)(a.out + OUT_CV + ((((size_t)b * 2 + l) * 2 + kvh) * 256 + pos) * 128 + ((4 * lane) & 127)) = v; }
    }
}

__device__ __forceinline__ void phase_hgrn_a(const Args& a, LAS unsigned char* lds, int l, int vcu, int G) {
    const int tid = threadIdx.x, lane = tid & 63, wave = tid >> 6, fr = lane & 15, fq = lane >> 4;
    const float* Z = (const float*)(a.ws + WS_Z);
    float* US = (float*)(a.ws + WS_US); float* DEC = (float*)(a.ws + WS_DEC);
    LAS unsigned char* KT = lds;
    LAS unsigned char* VT = lds + 20480;
    for (int item = vcu; item < 2048; item += G) {
        const int gb = item >> 2, head = item & 3, row0 = gb * 32;
        if (tid < 256) {
            const int dir = tid >> 7, d = tid & 127;
            const int zcol = (dir ? ZRB : ZRF) + head * 128 + d;
            const float lb = lb_val(a, l, dir, head * 128 + d);
            float kk[32], cum[32]; float run = 0.f;
#pragma unroll
            for (int i = 0; i < 32; ++i) { const int p = dir ? 31 - i : i; float k, lf; gate_fn(Z[(size_t)(row0 + p) * INC + zcol], lb, k, lf); run += lf; kk[i] = k; cum[i] = run; }
#pragma unroll
            for (int i = 0; i < 32; i += 2) { const float va = kk[i] * expf(run - cum[i]), vb = kk[i + 1] * expf(run - cum[i + 1]);
                const int p = dir ? 30 - i : i;
                *(LAS unsigned*)(KT + (dir * 128 + d) * 80 + p * 2) = pk2(dir ? vb : va, dir ? va : vb); }
            DEC[((size_t)(dir * 512 + gb) * 4 + head) * 128 + d] = expf(run);
        } else {
            const int t2 = tid - 256, e = t2 & 127, ph = t2 >> 7;
#pragma unroll
            for (int i = 0; i < 16; i += 2) { const int p = ph * 16 + i;
                const float v0 = Z[(size_t)(row0 + p) * INC + ZRI + head * 128 + e], v1 = Z[(size_t)(row0 + p + 1) * INC + ZRI + head * 128 + e];
                *(LAS unsigned*)(VT + e * 80 + p * 2) = pk2(v0, v1); }
        }
        __syncthreads();
#pragma unroll
        for (int dir = 0; dir < 2; ++dir) {
            const bf16x8 af = *(const LAS bf16x8*)(KT + (dir * 128 + wave * 16 + fr) * 80 + fq * 16);
            float* Ub = US + ((size_t)(dir * 512 + gb) * 4 + head) * 16384;
#pragma unroll
            for (int et = 0; et < 8; ++et) {
                const bf16x8 bfv = *(const LAS bf16x8*)(VT + (et * 16 + fr) * 80 + fq * 16);
                f32x4 acc = {0.f, 0.f, 0.f, 0.f};
                acc = __builtin_amdgcn_mfma_f32_16x16x32_bf16(af, bfv, acc, 0, 0, 0);
#pragma unroll
                for (int i = 0; i < 4; ++i) Ub[(wave * 16 + 4 * fq + i) * 128 + et * 16 + fr] = acc[i];
            }
        }
        __syncthreads();
    }
}

__device__ __forceinline__ void phase_conv(const Args& a, LAS unsigned char* lds, int l, int vcu, int G) {
    const int tid = threadIdx.x, lane = tid & 63, wave = tid >> 6, ch = tid;
    const float* Z = (const float*)(a.ws + WS_Z); bf16* MIX = (bf16*)(a.ws + WS_MIX);
    LAS float* red = (LAS float*)lds;
    float w[31];
#pragma unroll
    for (int j = 0; j < 31; ++j) w[j] = a.in[I_CW][(size_t)(l * 31 + j) * 512 + ch];
    const float bias = a.in[I_CB][l * 512 + ch], lg = a.in[I_CLG][l * 512 + ch], lbb = a.in[I_CLB][l * 512 + ch];
    for (int gb = vcu; gb < 512; gb += G) {
        const int row0 = gb * 32;
        int s0, T; if (row0 < NCTX) { s0 = row0 & ~255; T = 256; } else { s0 = NCTX + ((row0 - NCTX) & ~4095); T = 4096; }
        float h[62];
#pragma unroll
        for (int i = 0; i < 62; ++i) { const int r = row0 - 15 + i; float v = 0.f;
            if (r >= s0 && r < s0 + T) { const float ca = Z[(size_t)r * INC + ZCA + ch], cb = Z[(size_t)r * INC + ZCB + ch]; v = ca * sigm(cb); }
            h[i] = v; }
        float o[32];
#pragma unroll
        for (int p = 0; p < 32; ++p) { float acc = bias;
#pragma unroll
            for (int j = 0; j < 31; ++j) acc += w[j] * h[p + j];
            o[p] = acc; }
#pragma unroll
        for (int p = 0; p < 32; ++p) { const float s1 = wave_sum(o[p]), s2 = wave_sum(o[p] * o[p]); if (lane == 0) { red[(wave * 32 + p) * 2] = s1; red[(wave * 32 + p) * 2 + 1] = s2; } }
        __syncthreads();
#pragma unroll
        for (int p = 0; p < 32; ++p) { float s1 = 0.f, s2 = 0.f;
#pragma unroll
            for (int wv = 0; wv < 8; ++wv) { s1 += red[(wv * 32 + p) * 2]; s2 += red[(wv * 32 + p) * 2 + 1]; }
            const float mu = s1 * (1.f / 512.f), var = fmaxf(s2 * (1.f / 512.f) - mu * mu, 0.f);
            const float y = (o[p] - mu) * (1.0f / sqrtf(var + EPS)) * lg + lbb;
            MIX[(size_t)(row0 + p) * DM + 1536 + ch] = f2bf(siluf(y)); }
        __syncthreads();
    }
}

__device__ __forceinline__ void phase_attn(const Args& a, unsigned char* lds_generic, int l, int vcu, int G) {
    const bf16* Qb = (const bf16*)(a.ws + WS_Q); const bf16* Kb = (const bf16*)(a.ws + WS_K); const bf16* Vb = (const bf16*)(a.ws + WS_V);
    bf16* MIX = (bf16*)(a.ws + WS_MIX);
    for (int item = vcu; item < 512; item += G) {
        if (item < 256) {
            const int b = item >> 3, h = item & 7, kvh = h >> 2; const size_t r0 = (size_t)b * 256;
            att::KVSrc src; src.Kl = nullptr; src.Vl = nullptr; src.Kc = Kb + r0 * 256 + kvh * 128; src.Vc = Vb + r0 * 256 + kvh * 128; src.nloc = 0; src.kstart = 0; src.nrows = 1;
            att::attn_body(Qb + r0 * 1024 + h * 128, src, MIX + r0 * DM + h * 128, 4, a.in[I_SINK][l * 8 + h] * (1.0f / att::SCALE), 0, (char*)lds_generic);
        } else {
            const int it = item - 256, b2 = it >> 7, h = (it >> 4) & 7, qi = it & 15, kvh = h >> 2; const size_t rb = (size_t)NCTX + (size_t)b2 * 4096;
            att::KVSrc src; src.Kl = Kb + rb * 256 + kvh * 128; src.Vl = Vb + rb * 256 + kvh * 128;
            src.Kc = (const bf16*)(a.ws + WS_CK) + ((size_t)(b2 * 2 + l) * 512) * 256 + kvh * 128; src.Vc = (const bf16*)(a.ws + WS_CV) + ((size_t)(b2 * 2 + l) * 512) * 256 + kvh * 128;
            src.nloc = 8; src.kstart = 256 * qi - 128; src.nrows = 4096;
            att::attn_body(Qb + (rb + 256 * qi) * 1024 + h * 128, src, MIX + (rb + 256 * qi) * DM + h * 128, 16, a.in[I_SINK][l * 8 + h] * (1.0f / att::SCALE), 256 * qi, (char*)lds_generic);
        }
    }
}

__device__ __forceinline__ void phase_hgrn_b(const Args& a, int l, int vcu, int G) {
    const int tid = threadIdx.x;
    float* US = (float*)(a.ws + WS_US); const float* DEC = (const float*)(a.ws + WS_DEC);
    for (int item = vcu; item < 256; item += G) {
        const int b = item >> 3, head = (item >> 1) & 3, dir = item & 1;
        f32x4 S[8];
#pragma unroll
        for (int j = 0; j < 8; ++j) S[j] = (f32x4){0.f, 0.f, 0.f, 0.f};
        for (int i = 0; i < 8; ++i) { const int cc = dir ? 7 - i : i, gb = b * 8 + cc;
            f32x4* U4 = (f32x4*)(US + ((size_t)(dir * 512 + gb) * 4 + head) * 16384); const float* dc = DEC + ((size_t)(dir * 512 + gb) * 4 + head) * 128;
#pragma unroll
            for (int j = 0; j < 8; ++j) { const int i4 = tid + 512 * j; const f32x4 u = U4[i4]; const float dd = dc[i4 >> 5]; U4[i4] = S[j]; S[j] = S[j] * dd + u; } }
        f32x4* O4 = (f32x4*)(a.out + OUT_ST + ((((size_t)b * 2 + l) * 2 + dir) * 4 + head) * 16384);
#pragma unroll
        for (int j = 0; j < 8; ++j) O4[tid + 512 * j] = S[j];
    }
    for (int item = vcu; item < 256; item += G) {
        const int combo = item >> 4, part = item & 15, b2 = combo >> 3, dir = (combo >> 2) & 1, head = combo & 3;
        const int flat = part * 1024 + tid * 2, d = flat >> 7;
        f32x2 S = *(const f32x2*)(a.in[I_ST] + ((((size_t)b2 * 2 + l) * 2 + dir) * 4 + head) * 16384 + flat);
        const int gb0 = 256 + b2 * 128;
#pragma unroll 8
        for (int i = 0; i < 128; ++i) { const int cc = dir ? 127 - i : i, gb = gb0 + cc;
            f32x2* U2 = (f32x2*)(US + ((size_t)(dir * 512 + gb) * 4 + head) * 16384 + flat);
            const float dd = DEC[((size_t)(dir * 512 + gb) * 4 + head) * 128 + d];
            const f32x2 u = *U2; *U2 = S; S = S * dd + u; }
    }
}

__device__ __forceinline__ void phase_hgrn_c(const Args& a, LAS unsigned char* lds, int l, int vcu, int G) {
    const int tid = threadIdx.x, lane = tid & 63, wave = tid >> 6, fr = lane & 15, fq = lane >> 4;
    const float* Z = (const float*)(a.ws + WS_Z); const float* US = (const float*)(a.ws + WS_US); bf16* MIX = (bf16*)(a.ws + WS_MIX);
    constexpr int QP = 272;
    constexpr int O_QX = 0, O_KX = 17408, O_VT = 34816, O_ST = 45056, O_AM = 110592, O_ER = 115712, O_RED = 116736;
    LAS unsigned char* QX = lds + O_QX;
    LAS unsigned char* KX = lds + O_KX;
    LAS unsigned char* VT = lds + O_VT;
    LAS unsigned char* ST = lds + O_ST;
    LAS unsigned char* AM = lds + O_AM;
    LAS float* ER = (LAS float*)(lds + O_ER);
    LAS float* RED = (LAS float*)(lds + O_RED);
    for (int item = vcu; item < 2048; item += G) {
        const int gb = item >> 2, head = item & 3, row0 = gb * 32;
        if (tid < 256) {
            const int dir = tid >> 7, d = tid & 127;
            const int zcol = (dir ? ZRB : ZRF) + head * 128 + d;
            const float lb = lb_val(a, l, dir, head * 128 + d);
            float kk[32], cum[32]; float run = 0.f;
#pragma unroll
            for (int i = 0; i < 32; ++i) { const int p = dir ? 31 - i : i; float k, lf; gate_fn(Z[(size_t)(row0 + p) * INC + zcol], lb, k, lf); run += lf; kk[i] = k; cum[i] = run; }
            const float ref = cum[15];
#pragma unroll
            for (int i = 0; i < 32; ++i) { const int p = dir ? 31 - i : i; const float q = Z[(size_t)(row0 + p) * INC + ZRQ + head * 128 + d];
                *(LAS bf16*)(QX + (dir * 32 + p) * QP + d * 2) = f2bf(q * expf(cum[i] - ref));
                *(LAS bf16*)(KX + (dir * 32 + p) * QP + d * 2) = f2bf(kk[i] * expf(ref - cum[i])); }
            ER[dir * 128 + d] = expf(ref);
        } else {
            const int t2 = tid - 256, e = t2 & 127, ph = t2 >> 7;
#pragma unroll
            for (int i = 0; i < 16; i += 2) { const int p = ph * 16 + i;
                const float v0 = Z[(size_t)(row0 + p) * INC + ZRI + head * 128 + e], v1 = Z[(size_t)(row0 + p + 1) * INC + ZRI + head * 128 + e];
                *(LAS unsigned*)(VT + e * 80 + p * 2) = pk2(v0, v1); }
        }
        __syncthreads();
#pragma unroll
        for (int dir = 0; dir < 2; ++dir) {
            const float* Sg = US + ((size_t)(dir * 512 + gb) * 4 + head) * 16384;
#pragma unroll 4
            for (int it = 0; it < 16; ++it) { const int pi = wave * 16 + it, eb = pi & 7, c = pi >> 3, e = eb * 16 + fr, d0 = 8 * c + 2 * fq;
                const float s0 = Sg[d0 * 128 + e] * ER[dir * 128 + d0], s1 = Sg[(d0 + 1) * 128 + e] * ER[dir * 128 + d0 + 1];
                *(LAS unsigned*)(ST + dir * 32768 + e * 256 + ((c ^ (e & 15)) * 16) + fq * 4) = pk2(s0, s1); }
        }
        {
            const int dir = wave >> 2, mt = (wave >> 1) & 1, nt = wave & 1;
            f32x4 acc = {0.f, 0.f, 0.f, 0.f};
#pragma unroll
            for (int kt = 0; kt < 4; ++kt) {
                const bf16x8 af = *(const LAS bf16x8*)(QX + (dir * 32 + mt * 16 + fr) * QP + kt * 64 + fq * 16);
                const bf16x8 bfv = *(const LAS bf16x8*)(KX + (dir * 32 + nt * 16 + fr) * QP + kt * 64 + fq * 16);
                acc = __builtin_amdgcn_mfma_f32_16x16x32_bf16(af, bfv, acc, 0, 0, 0); }
#pragma unroll
            for (int i = 0; i < 4; ++i) { const int p = mt * 16 + 4 * fq + i, pp = nt * 16 + fr; const bool keep = dir ? (pp >= p) : (pp <= p);
                *(LAS bf16*)(AM + (dir * 32 + p) * 80 + pp * 2) = f2bf(keep ? acc[i] : 0.f); }
        }
        __syncthreads();
        f32x4 o[2];
#pragma unroll
        for (int mt = 0; mt < 2; ++mt) { o[mt] = (f32x4){0.f, 0.f, 0.f, 0.f};
#pragma unroll
            for (int dir = 0; dir < 2; ++dir) {
#pragma unroll
                for (int kt = 0; kt < 4; ++kt) {
                    const bf16x8 af = *(const LAS bf16x8*)(QX + (dir * 32 + mt * 16 + fr) * QP + kt * 64 + fq * 16);
                    const bf16x8 bfv = *(const LAS bf16x8*)(ST + dir * 32768 + (wave * 16 + fr) * 256 + (((4 * kt + fq) ^ fr) * 16));
                    o[mt] = __builtin_amdgcn_mfma_f32_16x16x32_bf16(af, bfv, o[mt], 0, 0, 0); }
                const bf16x8 af = *(const LAS bf16x8*)(AM + (dir * 32 + mt * 16 + fr) * 80 + fq * 16);
                const bf16x8 bfv = *(const LAS bf16x8*)(VT + (wave * 16 + fr) * 80 + fq * 16);
                o[mt] = __builtin_amdgcn_mfma_f32_16x16x32_bf16(af, bfv, o[mt], 0, 0, 0);
            } }
#pragma unroll
        for (int mt = 0; mt < 2; ++mt)
#pragma unroll
            for (int i = 0; i < 4; ++i) { float ss = o[mt][i] * o[mt][i]; ss += __shfl_xor(ss, 1); ss += __shfl_xor(ss, 2); ss += __shfl_xor(ss, 4); ss += __shfl_xor(ss, 8);
                if (fr == 0) RED[wave * 32 + mt * 16 + 4 * fq + i] = ss; }
        __syncthreads();
        const int e = wave * 16 + fr; const float gn = a.in[I_RG][(size_t)(l * 4 + head) * 128 + e];
#pragma unroll
        for (int mt = 0; mt < 2; ++mt)
#pragma unroll
            for (int i = 0; i < 4; ++i) { const int p = mt * 16 + 4 * fq + i; float ss = 0.f;
#pragma unroll
                for (int wv = 0; wv < 8; ++wv) ss += RED[wv * 32 + p];
                const float rstd = 1.0f / sqrtf(ss * (1.f / 128.f) + EPS);
                const float rg = Z[(size_t)(row0 + p) * INC + ZRG + head * 128 + e];
                MIX[(size_t)(row0 + p) * DM + 1024 + head * 128 + e] = f2bf(o[mt][i] * rstd * gn * siluf(rg)); }
        __syncthreads();
    }
}

constexpr int N_PHASES = 25;
enum { K_ALL = 0, K_P0, K_NORM, K_FFI, K_FFO, K_WIN, K_MIXA, K_MIXB, K_MIXC, K_WOUT };
template <int KIND>
__global__ void __launch_bounds__(512, 2) mega_fwd(Args args) {
    extern __shared__ __attribute__((aligned(16))) unsigned char lds_raw[];
    LAS unsigned char* lds = (LAS unsigned char*)lds_raw;
    const int tid = threadIdx.x;
    const int G = gridDim.x; const int bx = blockIdx.x; const int vcu = (G % 8 == 0) ? (bx % 8) * (G / 8) + bx / 8 : bx;
    for (int u = tid; u < (LDS_BYTES - LDSCTL_OFF) / 4; u += 512) ((LAS unsigned*)(lds + LDSCTL_OFF))[u] = 0u;
    __syncthreads();
    const int lo = args.ph_lo, hi = args.ph_hi;
    XcdBarrier bar; bar.bar = (unsigned*)(args.ws + WS_CTL) + CW_BAR; bar.x = 0; bar.st = nullptr;
    if (hi - lo > 1) bar = xcd_barrier_post((unsigned*)(args.ws + WS_CTL) + CW_BAR, (volatile LAS unsigned*)(lds + LDSCTL_OFF + 64));
#define IN(k) (lo <= (k) && (k) < hi)
#define HAS(kind) (KIND == K_ALL || KIND == (kind))
#define SEAM(k) do { if (IN(k) && IN((k) + 1)) xcd_barrier(bar); } while (0)
    unsigned char* ws = args.ws;
    float* X = args.out;
    const float* mod = (const float*)(ws + WS_MOD);

    if (HAS(K_P0) && IN(0)) { phase_p0(args, lds, vcu, G); SEAM(0); }

    for (int l = 0; l < 2; ++l) {
        const int pb = 1 + 12 * l;
        const float* bada = args.in[I_BADA] + (size_t)l * MODW;
        if (HAS(K_NORM) && IN(pb + 0)) { phase_norm(args, l, 0, vcu, G); SEAM(pb + 0); }
        if (HAS(K_FFI) && IN(pb + 1)) {
            pg8::Gemm g{(const bf16*)(ws + WS_H), (const bf16*)(ws + WS_WFI) + (size_t)(l * 2 + 0) * NFF2 * DM, NTOK, NFF2, DM}; pg8::StaticOrder S; S.init(NTOK, NFF2, G, bx);
            pg8::EpiSwiGLU E{(bf16*)(ws + WS_Z), DFF};
            pg8::gemm_phase<pg8::EpiSwiGLU, pg8::StaticOrder, true, true>(lds, g, S, E);
            SEAM(pb + 1);
        }
        if (HAS(K_FFO) && IN(pb + 2)) {
            pg8::Gemm g{(const bf16*)(ws + WS_Z), (const bf16*)(ws + WS_WFO) + (size_t)(l * 2 + 0) * DM * DFF, NTOK, DM, DFF}; pg8::StaticOrder S; S.init(NTOK, DM, G, bx);
            pg8::EpiResid E{X, mod + (size_t)l * MODW + 2 * DM, bada + 2 * DM, 0.5f};
            pg8::gemm_phase<pg8::EpiResid, pg8::StaticOrder, true, true>(lds, g, S, E);
            SEAM(pb + 2);
        }
        if (HAS(K_NORM) && IN(pb + 3)) { phase_norm(args, l, 1, vcu, G); SEAM(pb + 3); }
        if (HAS(K_WIN) && IN(pb + 4)) {
            pg8::Gemm g{(const bf16*)(ws + WS_H), (const bf16*)(ws + WS_WIN) + (size_t)l * INC * DM, NTOK, INC, DM}; pg8::StaticOrder S; S.init(NTOK, INC, G, bx);
            pg8::EpiF32 E{(float*)(ws + WS_Z), INC};
            pg8::gemm_phase<pg8::EpiF32, pg8::StaticOrder, true, true>(lds, g, S, E);
            SEAM(pb + 4);
        }
        if (HAS(K_MIXA) && IN(pb + 5)) {
#ifndef NO_PREP
            phase_prep(args, l, vcu, G);
#endif
#ifndef NO_HGRNA
            phase_hgrn_a(args, lds, l, vcu, G);
#endif
#ifndef NO_CONV
            phase_conv(args, lds, l, vcu, G);
#endif
            SEAM(pb + 5); }
        if (HAS(K_MIXB) && IN(pb + 6)) {
#ifndef NO_ATTN
            phase_attn(args, lds_raw, l, vcu, G);
#endif
#ifndef NO_HGRNB
            phase_hgrn_b(args, l, vcu, G);
#endif
            SEAM(pb + 6); }
        if (HAS(K_MIXC) && IN(pb + 7)) { phase_hgrn_c(args, lds, l, vcu, G); SEAM(pb + 7); }
        if (HAS(K_WOUT) && IN(pb + 8)) {
            pg8::Gemm g{(const bf16*)(ws + WS_MIX), (const bf16*)(ws + WS_WOUT) + (size_t)l * DM * DM, NTOK, DM, DM}; pg8::StaticOrder S; S.init(NTOK, DM, G, bx);
            pg8::EpiResid E{X, mod + (size_t)l * MODW + 5 * DM, bada + 5 * DM, 1.0f};
            pg8::gemm_phase<pg8::EpiResid, pg8::StaticOrder, true, true>(lds, g, S, E);
            SEAM(pb + 8);
        }
        if (HAS(K_NORM) && IN(pb + 9)) { phase_norm(args, l, 2, vcu, G); SEAM(pb + 9); }
        if (HAS(K_FFI) && IN(pb + 10)) {
            pg8::Gemm g{(const bf16*)(ws + WS_H), (const bf16*)(ws + WS_WFI) + (size_t)(l * 2 + 1) * NFF2 * DM, NTOK, NFF2, DM}; pg8::StaticOrder S; S.init(NTOK, NFF2, G, bx);
            pg8::EpiSwiGLU E{(bf16*)(ws + WS_Z), DFF};
            pg8::gemm_phase<pg8::EpiSwiGLU, pg8::StaticOrder, true, true>(lds, g, S, E);
            SEAM(pb + 10);
        }
        if (HAS(K_FFO) && IN(pb + 11)) {
            pg8::Gemm g{(const bf16*)(ws + WS_Z), (const bf16*)(ws + WS_WFO) + (size_t)(l * 2 + 1) * DM * DFF, NTOK, DM, DFF}; pg8::StaticOrder S; S.init(NTOK, DM, G, bx);
            pg8::EpiResid E{X, mod + (size_t)l * MODW + 8 * DM, bada + 8 * DM, 0.5f};
            pg8::gemm_phase<pg8::EpiResid, pg8::StaticOrder, true, true>(lds, g, S, E);
            SEAM(pb + 11);
        }
    }
#undef IN
#undef HAS
#undef SEAM
}

extern "C" void kernel_launch(void* const* d_in, const int* in_sizes, int n_in, void* d_out, int out_size, void* d_ws, size_t ws_size, hipStream_t stream) {
    static int grid = 0;
    if (grid == 0) {
        if (n_in != 23 || (size_t)out_size != OUT_TOTAL || ws_size < WS_END) { fprintf(stderr, "kernel_launch: shape mismatch: n_in %d out %d ws %zu (need >= %zu); nothing launched\n", n_in, out_size, ws_size, (size_t)WS_END); grid = -1; return; }
        int dev = 0, cus = 0, per_cu = 0;
        if (hipGetDevice(&dev) != hipSuccess || hipDeviceGetAttribute(&cus, hipDeviceAttributeMultiprocessorCount, dev) != hipSuccess) { grid = -1; return; }
#if MK_N_LAUNCHES == 1
        const void* fns[1] = {(const void*)mega_fwd<K_ALL>};
#else
        const void* fns[9] = {(const void*)mega_fwd<K_P0>, (const void*)mega_fwd<K_NORM>, (const void*)mega_fwd<K_FFI>, (const void*)mega_fwd<K_FFO>, (const void*)mega_fwd<K_WIN>,
                              (const void*)mega_fwd<K_MIXA>, (const void*)mega_fwd<K_MIXB>, (const void*)mega_fwd<K_MIXC>, (const void*)mega_fwd<K_WOUT>};
#endif
        for (const void* f : fns) {
            if (hipFuncSetAttribute(f, hipFuncAttributeMaxDynamicSharedMemorySize, LDS_BYTES) != hipSuccess) { fprintf(stderr, "kernel_launch: hipFuncSetAttribute failed\n"); grid = -1; return; }
            if (hipOccupancyMaxActiveBlocksPerMultiprocessor(&per_cu, f, 512, LDS_BYTES) != hipSuccess || per_cu < 1) { fprintf(stderr, "kernel_launch: occupancy query says %d\n", per_cu); }
        }
        (void)hipGetLastError();
        grid = cus;
    }
    if (grid < 0) return;
    (void)hipMemsetAsync((char*)d_ws + WS_CTL, 0, CTL_ZERO_BYTES, stream);
    Args a{};
    for (int i = 0; i < 23; ++i) a.in[i] = (const float*)d_in[i];
    a.out = (float*)d_out; a.ws = (unsigned char*)d_ws;
#if MK_N_LAUNCHES == 1
    a.ph_lo = 0; a.ph_hi = N_PHASES;
    hipLaunchKernelGGL(mega_fwd<K_ALL>, dim3(grid), dim3(512), LDS_BYTES, stream, a);
#else
    static const int kind_of[12] = {K_NORM, K_FFI, K_FFO, K_NORM, K_WIN, K_MIXA, K_MIXB, K_MIXC, K_WOUT, K_NORM, K_FFI, K_FFO};
    for (int p = 0; p < N_PHASES; ++p) { a.ph_lo = p; a.ph_hi = p + 1; const int kind = p == 0 ? K_P0 : kind_of[(p - 1) % 12];
        switch (kind) {
            case K_P0:   hipLaunchKernelGGL(mega_fwd<K_P0>,   dim3(grid), dim3(512), LDS_BYTES, stream, a); break;
            case K_NORM: hipLaunchKernelGGL(mega_fwd<K_NORM>, dim3(grid), dim3(512), LDS_BYTES, stream, a); break;
            case K_FFI:  hipLaunchKernelGGL(mega_fwd<K_FFI>,  dim3(grid), dim3(512), LDS_BYTES, stream, a); break;
            case K_FFO:  hipLaunchKernelGGL(mega_fwd<K_FFO>,  dim3(grid), dim3(512), LDS_BYTES, stream, a); break;
            case K_WIN:  hipLaunchKernelGGL(mega_fwd<K_WIN>,  dim3(grid), dim3(512), LDS_BYTES, stream, a); break;
            case K_MIXA: hipLaunchKernelGGL(mega_fwd<K_MIXA>, dim3(grid), dim3(512), LDS_BYTES, stream, a); break;
            case K_MIXB: hipLaunchKernelGGL(mega_fwd<K_MIXB>, dim3(grid), dim3(512), LDS_BYTES, stream, a); break;
            case K_MIXC: hipLaunchKernelGGL(mega_fwd<K_MIXC>, dim3(grid), dim3(512), LDS_BYTES, stream, a); break;
            default:     hipLaunchKernelGGL(mega_fwd<K_WOUT>, dim3(grid), dim3(512), LDS_BYTES, stream, a); break;
        }
    }
#endif
}
```

```cpp
#include <hip/hip_runtime.h>
#include <cstdio>
#include <cstdint>
#ifndef MK_N_LAUNCHES
#define MK_N_LAUNCHES 1
#endif
namespace pg8 {
#define PG8_LAS __attribute__((address_space(3)))
typedef unsigned short bf16_t;
typedef short bf16x8 __attribute__((ext_vector_type(8)));
typedef float f32x4 __attribute__((ext_vector_type(4)));
typedef unsigned u32x4 __attribute__((ext_vector_type(4)));
constexpr int BM = 256, BK = 64, HALF = 128, HTB = HALF * BK * 2  , STAGE_BYTES = 8 * HTB, NXCD = 8, WGM = 8;

__host__ __device__ __forceinline__ int lds_byte(int r, int c) { const int st = (r >> 4) * 2 + (c >> 5), rr = r & 15, cc = c & 31, ob = rr * 64 + cc * 2; return st * 1024 + (ob ^ (((ob >> 9) & 1) << 5)); }
__host__ __device__ __forceinline__ void stage_rc(int b, int& R, int& C) { const int st = b / 1024, sb = b % 1024, swz = sb ^ (((sb >> 9) & 1) << 5); R = (st >> 1) * 16 + swz / 64; C = (st & 1) * 32 + (swz % 64) / 2; }
__host__ __device__ __forceinline__ int perm32(int rho) { const int n = rho >> 4, i = rho & 15; return 8 * (i >> 2) + 4 * n + (i & 3); }

struct Unit { int pm, pn; };
struct Gemm { const bf16_t* A; const bf16_t* Bt; int M, N, K; };

struct StaticOrder {
    int nM, nN, nwg, G, c;
    __host__ __device__ void init(int M, int N, int G_, int c_) { nM = M / BM; nN = N / BM; nwg = nM * nN; G = G_; c = c_; }
    __host__ __device__ bool next(int i, Unit& u) const {
        const long L = (long)i * G + c; if (L >= nwg) return false;
        int wgid = (int)L; { const int q = nwg / NXCD, r = nwg % NXCD, xcd = wgid % NXCD, off = wgid / NXCD; wgid = (xcd < r ? xcd * (q + 1) : r * (q + 1) + (xcd - r) * q) + off; }
        const int nig = WGM * nN, gid = wgid / nig, fm = gid * WGM, gsz = (nM - fm) < WGM ? (nM - fm) : WGM;
        u.pm = fm + ((wgid % nig) % gsz); u.pn = (wgid % nig) / gsz; return true;
    }
    __device__ __forceinline__ void a_ready(const Unit&) const {}
    __device__ __forceinline__ void done(const Unit&) const {}
};
__device__ __forceinline__ unsigned cvt_pk_bf16(float lo, float hi) { unsigned r; asm volatile("v_cvt_pk_bf16_f32 %0, %1, %2" : "=v"(r) : "v"(lo), "v"(hi)); return r; }
template <class Epi, class Sched, bool ALIGN_EPI = false, bool SP2 = false>
__device__ __forceinline__ void gemm_phase(PG8_LAS unsigned char* lds, const Gemm g, const Sched& S, const Epi& E) {
    int tid_ = threadIdx.x; asm volatile("" : "+v"(tid_)); const int tid = tid_, wid = __builtin_amdgcn_readfirstlane(tid >> 6), lane = tid & 63, wr = wid >> 2, wc = wid & 3, fr = lane & 15, fq = lane >> 4;
    const int K = g.K, nt = K / BK;
    unsigned voffA[2], voffB[2];
#pragma unroll
    for (int i = 0; i < 2; ++i) { int R, C; stage_rc(tid * 16 + i * 8192, R, C); const int Rb = Epi::PERM ? ((R & ~31) + perm32(R & 31)) : R;
        voffA[i] = (unsigned)(R * K + C) * 2u; voffB[i] = (unsigned)(Rb * K + C) * 2u; }
    const size_t kstep = (size_t)(BK * 2);
    const size_t hstep = (size_t)HALF * K * 2;
    const size_t tstep = 2 * hstep;
    const unsigned ldsw = (unsigned)wid * 1024u;
    const int aoff = lds_byte(wr * 64 + fr, fq * 8), boff = lds_byte(wc * 32 + fr, fq * 8);
#define PG8_SA(b, h) (((b) * 2 + (h)) * HTB)
#define PG8_SB(b, h) ((4 + (b) * 2 + (h)) * HTB)
#define PG8_STAGE(bufoff, gbase, voff) do { _Pragma("unroll") for (int _i = 0; _i < 2; ++_i) \
        __builtin_amdgcn_global_load_lds((const unsigned*)((const char*)(gbase) + (voff)[_i]), (PG8_LAS unsigned*)(lds + (bufoff) + ldsw + _i * 8192), 16, 0, 0); } while (0)
#define PG8_LDA(dst, b, h) do { _Pragma("unroll") for (int m = 0; m < 4; ++m) _Pragma("unroll") for (int k = 0; k < 2; ++k) dst[m][k] = *(const PG8_LAS bf16x8*)(lds + PG8_SA(b, h) + aoff + m * 2048 + k * 1024); } while (0)
#define PG8_LDB(dst, b, h) do { _Pragma("unroll") for (int n = 0; n < 2; ++n) _Pragma("unroll") for (int k = 0; k < 2; ++k) dst[n][k] = *(const PG8_LAS bf16x8*)(lds + PG8_SB(b, h) + boff + n * 2048 + k * 1024); } while (0)
#define PG8_MMA(ai, bj, At, Bt) do { __builtin_amdgcn_s_setprio(1); _Pragma("unroll") for (int m = 0; m < 4; ++m) _Pragma("unroll") for (int n = 0; n < 2; ++n) _Pragma("unroll") for (int k = 0; k < 2; ++k) \
        acc[ai][bj][m][n] = __builtin_amdgcn_mfma_f32_16x16x32_bf16(Bt[n][k], At[m][k], acc[ai][bj][m][n], 0, 0, 0); __builtin_amdgcn_s_setprio(0); } while (0)
#define PG8_WAIT_V(n) asm volatile("s_waitcnt vmcnt(" #n ")" ::: "memory")
#define PG8_WAIT_L(n) asm volatile("s_waitcnt lgkmcnt(" #n ")" ::: "memory")
#define PG8_BAR __builtin_amdgcn_s_barrier()
#define PG8_SCHED __builtin_amdgcn_sched_barrier(0)
    Unit cur, nxt; int ui = 0;
    if (!S.next(0, cur)) return;
    f32x4 acc[2][2][4][2];
#pragma unroll
    for (int a = 0; a < 2; ++a)
#pragma unroll
        for (int b = 0; b < 2; ++b)
#pragma unroll
            for (int m = 0; m < 4; ++m)
#pragma unroll
                for (int n = 0; n < 2; ++n) acc[a][b][m][n] = (f32x4){0.f, 0.f, 0.f, 0.f};
    bf16x8 At[4][2], B0[2][2], B1[2][2];
    const char* cA = (const char*)g.A + (size_t)cur.pm * tstep; const char* cB = (const char*)g.Bt + (size_t)cur.pn * tstep;
    S.a_ready(cur);
    if constexpr (SP2) {
        PG8_STAGE(PG8_SB(0, 0), cB, voffB); PG8_STAGE(PG8_SB(0, 1), cB + hstep, voffB); PG8_STAGE(PG8_SA(0, 0), cA, voffA); PG8_STAGE(PG8_SA(0, 1), cA + hstep, voffA);
        if (wr == 1) PG8_BAR;
        PG8_WAIT_V(2); PG8_BAR;
        PG8_STAGE(PG8_SB(1, 0), cB + kstep, voffB); PG8_STAGE(PG8_SA(1, 0), cA + kstep, voffA); PG8_STAGE(PG8_SB(1, 1), cB + hstep + kstep, voffB);
        PG8_WAIT_V(6); PG8_BAR;
    } else {
        PG8_STAGE(PG8_SB(0, 0), cB, voffB); PG8_STAGE(PG8_SA(0, 0), cA, voffA); PG8_STAGE(PG8_SB(0, 1), cB + hstep, voffB); PG8_STAGE(PG8_SA(0, 1), cA + hstep, voffA);
        if (wr == 1) PG8_BAR;
        PG8_WAIT_V(4); PG8_BAR;
        PG8_STAGE(PG8_SB(1, 0), cB + kstep, voffB); PG8_STAGE(PG8_SA(1, 0), cA + kstep, voffA); PG8_STAGE(PG8_SB(1, 1), cB + hstep + kstep, voffB);
        PG8_WAIT_V(6); PG8_BAR;
    }
    for (;;) {
        const bool has_next = S.next(ui + 1, nxt);
        const char* nA = has_next ? (const char*)g.A + (size_t)nxt.pm * tstep : cA; const char* nB = has_next ? (const char*)g.Bt + (size_t)nxt.pn * tstep : cB;
        for (int t = 0; t < nt; t += 2) {
            const bool last = (t == nt - 2);
            const char* a1 = cA + (size_t)(t + 1) * kstep;
            const char* a2 = last ? nA : cA + (size_t)(t + 2) * kstep; const char* b2 = last ? nB : cB + (size_t)(t + 2) * kstep;
            const char* a3 = a2 + kstep; const char* b3 = b2 + kstep;
            if (last && has_next) S.a_ready(nxt);
            if constexpr (SP2) {
            PG8_LDB(B0, 0, 0); PG8_LDB(B1, 0, 1); PG8_SCHED; PG8_LDA(At, 0, 0); PG8_STAGE(PG8_SA(1, 1), a1 + hstep, voffA);
            PG8_WAIT_V(8); PG8_WAIT_L(0); PG8_BAR; PG8_MMA(0, 0, At, B0); PG8_MMA(0, 1, At, B1); PG8_BAR; PG8_SCHED;
            PG8_LDA(At, 0, 1); PG8_STAGE(PG8_SB(0, 0), b2, voffB); PG8_STAGE(PG8_SB(0, 1), b2 + hstep, voffB); PG8_STAGE(PG8_SA(0, 0), a2, voffA);
            PG8_WAIT_V(8); PG8_WAIT_L(0); PG8_BAR; PG8_MMA(1, 0, At, B0); PG8_MMA(1, 1, At, B1); PG8_BAR; PG8_SCHED;
            PG8_LDB(B0, 1, 0); PG8_LDB(B1, 1, 1); PG8_SCHED; PG8_LDA(At, 1, 0); PG8_STAGE(PG8_SA(0, 1), a2 + hstep, voffA);
            PG8_WAIT_V(8); PG8_WAIT_L(0); PG8_BAR; PG8_MMA(0, 0, At, B0); PG8_MMA(0, 1, At, B1); PG8_BAR; PG8_SCHED;
            PG8_LDA(At, 1, 1); PG8_STAGE(PG8_SB(1, 0), b3, voffB); PG8_STAGE(PG8_SB(1, 1), b3 + hstep, voffB); PG8_STAGE(PG8_SA(1, 0), a3, voffA);
            PG8_WAIT_V(8); PG8_WAIT_L(0); PG8_BAR; PG8_MMA(1, 0, At, B0); PG8_MMA(1, 1, At, B1); PG8_BAR; PG8_SCHED;
            } else {
            PG8_LDB(B0, 0, 0); PG8_SCHED; PG8_LDA(At, 0, 0); PG8_STAGE(PG8_SA(1, 1), a1 + hstep, voffA);
            PG8_WAIT_L(8); PG8_BAR; PG8_WAIT_L(0); PG8_MMA(0, 0, At, B0); PG8_BAR; PG8_SCHED;
            PG8_LDB(B1, 0, 1); PG8_STAGE(PG8_SB(0, 0), b2, voffB);
            PG8_BAR; PG8_WAIT_L(0); PG8_MMA(0, 1, At, B1); PG8_BAR;
            PG8_LDA(At, 0, 1); PG8_STAGE(PG8_SA(0, 0), a2, voffA);
            PG8_BAR; PG8_WAIT_L(0); PG8_MMA(1, 0, At, B0); PG8_BAR; PG8_SCHED;
            PG8_STAGE(PG8_SB(0, 1), b2 + hstep, voffB);
            PG8_WAIT_V(6); PG8_BAR; PG8_MMA(1, 1, At, B1); PG8_BAR;
            PG8_LDB(B0, 1, 0); PG8_SCHED; PG8_LDA(At, 1, 0); PG8_STAGE(PG8_SA(0, 1), a2 + hstep, voffA);
            PG8_WAIT_L(8); PG8_BAR; PG8_WAIT_L(0); PG8_MMA(0, 0, At, B0); PG8_BAR; PG8_SCHED;
            PG8_LDB(B1, 1, 1); PG8_STAGE(PG8_SB(1, 0), b3, voffB);
            PG8_BAR; PG8_WAIT_L(0); PG8_MMA(0, 1, At, B1); PG8_BAR;
            PG8_LDA(At, 1, 1); PG8_STAGE(PG8_SA(1, 0), a3, voffA);
            PG8_BAR; PG8_WAIT_L(0); PG8_MMA(1, 0, At, B0); PG8_BAR; PG8_SCHED;
            PG8_STAGE(PG8_SB(1, 1), b3 + hstep, voffB);
            PG8_WAIT_V(6); PG8_BAR; PG8_MMA(1, 1, At, B1); PG8_BAR;
            }
        }
        if constexpr (ALIGN_EPI) { if (wr == 0) PG8_BAR; }
        if constexpr (!Epi::AFTER_DRAIN) { E(acc, cur, wr, wc, fr, fq); S.done(cur); }
        if (!has_next) break;
#pragma unroll
        for (int a = 0; a < 2; ++a)
#pragma unroll
            for (int b = 0; b < 2; ++b)
#pragma unroll
                for (int m = 0; m < 4; ++m)
#pragma unroll
                    for (int n = 0; n < 2; ++n) acc[a][b][m][n] = (f32x4){0.f, 0.f, 0.f, 0.f};
        cur = nxt; cA = nA; cB = nB; ++ui;
        if constexpr (ALIGN_EPI) { if (wr == 1) PG8_BAR; }
    }
    PG8_WAIT_V(0);
    if constexpr (!ALIGN_EPI) { if (wr == 0) PG8_BAR; }
    PG8_BAR;
    if constexpr (Epi::AFTER_DRAIN) { E.fused(acc, cur, wr, wc, fr, fq, lds, wid, lane); S.done(cur); }
#undef PG8_SA
#undef PG8_SB
#undef PG8_STAGE
#undef PG8_LDA
#undef PG8_LDB
#undef PG8_MMA
#undef PG8_WAIT_V
#undef PG8_WAIT_L
#undef PG8_BAR
#undef PG8_SCHED
}
}

constexpr int DM = 2048, NTOK = 16384, NCTX = 8192, CTX_T = 256, LAT_T = 4096, PAST = 512;
constexpr int DFF = 5632, NFF2 = 11264, INC = 5120, MODW = 18432;
constexpr int ZQ = 0, ZK = 1024, ZV = 1280, ZRQ = 1536, ZRF = 2048, ZRB = 2560, ZRI = 3072, ZRG = 3584, ZCA = 4096, ZCB = 4608;
constexpr float EPS = 1e-6f;
constexpr size_t OUT_Y = 0, OUT_CK = 33554432, OUT_CV = 37748736, OUT_ST = 41943040, OUT_TOTAL = 50331648;
constexpr size_t MiB = 1u << 20;
constexpr size_t WS_CTL = 0, WS_MOD = 1 * MiB, CTL_ZERO_BYTES = 2 * MiB;
constexpr size_t WS_WFI = 2 * MiB;
constexpr size_t WS_WFO = 178 * MiB;
constexpr size_t WS_WIN = 266 * MiB;
constexpr size_t WS_WOUT = 306 * MiB;
constexpr size_t WS_H = 322 * MiB;
constexpr size_t WS_MIX = 386 * MiB;
constexpr size_t WS_Z = 450 * MiB;
constexpr size_t WS_US = 770 * MiB;
constexpr size_t WS_DEC = 1026 * MiB;
constexpr size_t WS_Q = 1028 * MiB;
constexpr size_t WS_K = 1060 * MiB;
constexpr size_t WS_V = 1068 * MiB;
constexpr size_t WS_CK = 1076 * MiB;
constexpr size_t WS_CV = 1077 * MiB;
constexpr size_t WS_END = 1078 * MiB;
constexpr int CW_BAR = 4096;
constexpr int RING_BYTES = 131072, LDSCTL_OFF = RING_BYTES, LDS_BYTES = 147456;

#define GAS __attribute__((address_space(1)))
#define LAS __attribute__((address_space(3)))
typedef unsigned short bf16;
typedef unsigned v4u __attribute__((ext_vector_type(4)));
typedef unsigned v2u __attribute__((ext_vector_type(2)));
typedef float f32x4 __attribute__((ext_vector_type(4)));
typedef float f32x2 __attribute__((ext_vector_type(2)));
typedef short bf16x8 __attribute__((ext_vector_type(8)));
#define LDS_WAIT() asm volatile("s_waitcnt lgkmcnt(0)" ::: "memory")
#define VM_WAIT() asm volatile("s_waitcnt vmcnt(0)" ::: "memory")
__device__ __forceinline__ unsigned pk2(float lo, float hi) { return pg8::cvt_pk_bf16(lo, hi); }
__device__ __forceinline__ unsigned short f2bf(float f) { return (unsigned short)(pg8::cvt_pk_bf16(f, 0.f) & 0xffffu); }
__device__ __forceinline__ float sigm(float x) { return __builtin_amdgcn_rcpf(1.f + __expf(-x)); }
__device__ __forceinline__ float siluf(float x) { return x * __builtin_amdgcn_rcpf(1.f + __expf(-x)); }
__device__ __forceinline__ float wave_sum(float v) {
#pragma unroll
    for (int o = 1; o < 64; o <<= 1) v += __shfl_xor(v, o);
    return v;
}

namespace pg8 {
struct EpiF32 {
    static constexpr bool PERM = false, AFTER_DRAIN = false;
    float* C; int ldc;
    __device__ __forceinline__ void operator()(const f32x4 (&acc)[2][2][4][2], const Unit& u, int wr, int wc, int fr, int fq) const {
        const int row0 = u.pm * BM + wr * 64 + fr, col0 = u.pn * BM + wc * 32 + 4 * fq;
#pragma unroll
        for (int ai = 0; ai < 2; ++ai)
#pragma unroll
            for (int m = 0; m < 4; ++m) { float* rowp = C + (size_t)(row0 + ai * HALF + m * 16) * ldc + col0;
#pragma unroll
                for (int bj = 0; bj < 2; ++bj)
#pragma unroll
                    for (int n = 0; n < 2; ++n) *(f32x4*)(rowp + bj * HALF + n * 16) = acc[ai][bj][m][n]; }
    }
};
struct EpiSwiGLU {
    static constexpr bool PERM = true, AFTER_DRAIN = false;
    bf16_t* O; int ldc;
    __device__ __forceinline__ void operator()(const f32x4 (&acc)[2][2][4][2], const Unit& u, int wr, int wc, int fr, int fq) const {
        const int row0 = u.pm * BM + wr * 64 + fr, col0 = u.pn * HALF + wc * 32 + 8 * fq;
#pragma unroll
        for (int ai = 0; ai < 2; ++ai)
#pragma unroll
            for (int m = 0; m < 4; ++m) { bf16_t* rowp = O + (size_t)(row0 + ai * HALF + m * 16) * ldc + col0;
                float v[8];
#pragma unroll
                for (int n = 0; n < 2; ++n)
#pragma unroll
                    for (int j = 0; j < 4; ++j) { const float a = acc[ai][0][m][n][j], b = acc[ai][1][m][n][j];
                        v[n * 4 + j] = a * __builtin_amdgcn_rcpf(1.f + __expf(-a)) * b; }
                u32x4 w; w.x = cvt_pk_bf16(v[0], v[1]); w.y = cvt_pk_bf16(v[2], v[3]); w.z = cvt_pk_bf16(v[4], v[5]); w.w = cvt_pk_bf16(v[6], v[7]);
                *(u32x4*)rowp = w; }
    }
};
struct EpiResid {
    static constexpr bool PERM = false, AFTER_DRAIN = false;
    float* X; const float* gm; const float* gb; float scale;
    __device__ __forceinline__ void operator()(const f32x4 (&acc)[2][2][4][2], const Unit& u, int wr, int wc, int fr, int fq) const {
        const int row0 = u.pm * BM + wr * 64 + fr, col0 = u.pn * BM + wc * 32 + 4 * fq;
        const int cond = u.pm < 32 ? 0 : 1 + ((u.pm - 32) >> 4);
        const float* g0 = gm + (size_t)cond * 2 * 18432;
        f32x4 gv[2][2];
#pragma unroll
        for (int bj = 0; bj < 2; ++bj)
#pragma unroll
            for (int n = 0; n < 2; ++n) gv[bj][n] = (*(const f32x4*)(g0 + col0 + bj * HALF + n * 16) + *(const f32x4*)(gb + col0 + bj * HALF + n * 16)) * scale;
#pragma unroll
        for (int ai = 0; ai < 2; ++ai)
#pragma unroll
            for (int m = 0; m < 4; ++m) { float* rowp = X + (size_t)(row0 + ai * HALF + m * 16) * 2048 + col0;
#pragma unroll
                for (int bj = 0; bj < 2; ++bj)
#pragma unroll
                    for (int n = 0; n < 2; ++n) { f32x4* p = (f32x4*)(rowp + bj * HALF + n * 16); *p = *p + gv[bj][n] * acc[ai][bj][m][n]; }
                asm volatile("" ::: "memory"); }
    }
};
}
#define XB_TMO      128
#define XB_XCNT(j)  (256  + 64 * (j))
#define XB_XSUB(j)  (1280 + 64 * (j))
#define XB_XGEN(j)  (2304 + 64 * (j))
#define XB_TOP      3328
#define XB_TOPGEN   3392
#define XCD_BAR_WORDS 3456
#define XB_SPIN_CAP (1u << 18)

__device__ __forceinline__ unsigned xb_ld(unsigned* p)              { return __hip_atomic_load(p, __ATOMIC_RELAXED, __HIP_MEMORY_SCOPE_AGENT); }
__device__ __forceinline__ unsigned xb_add(unsigned* p, unsigned v) { return __hip_atomic_fetch_add(p, v, __ATOMIC_RELAXED, __HIP_MEMORY_SCOPE_AGENT); }
__device__ __forceinline__ unsigned xb_xcc_id() { return (unsigned)__builtin_amdgcn_s_getreg((3 << 11) | 20) & 0xFu; }
#define XB_SPIN(cond, bar) do { unsigned _sp = 0; while (cond) { __builtin_amdgcn_s_sleep(1); \
    if ((++_sp & 255u) == 0u) { if (xb_ld(&(bar)[XB_TMO])) break; if (_sp > XB_SPIN_CAP) { atomicAdd(&(bar)[XB_TMO], 1u); break; } } } } while (0)

struct XcdBarrier {
    unsigned* bar; unsigned x;
    volatile LAS unsigned* st;
};

__device__ __forceinline__ XcdBarrier xcd_barrier_post(unsigned* bar, volatile LAS unsigned* st) {
    XcdBarrier b; b.bar = bar; b.x = xb_xcc_id(); b.st = st;
    if (threadIdx.x == 0) (void)xb_add(&bar[XB_XCNT(b.x)], 1u);
    return b;
}
__device__ __forceinline__ void xcd_barrier_complete(unsigned* bar, unsigned x, unsigned& nloc, unsigned& nx) {
    const unsigned G = gridDim.x * gridDim.y * gridDim.z;
    unsigned sum, cnt, mine, sp = 0u;
    for (;;) {
        sum = 0u; cnt = 0u; mine = 0u;
#pragma unroll
        for (unsigned j = 0; j < 16; ++j) { const unsigned c = xb_ld(&bar[XB_XCNT(j)]); sum += c; cnt += (c > 0u) ? 1u : 0u; mine = (j == x) ? c : mine; }
        if (sum == G) break;
        __builtin_amdgcn_s_sleep(1);
        if ((++sp & 255u) == 0u) { if (xb_ld(&bar[XB_TMO])) break; if (sp > XB_SPIN_CAP) { atomicAdd(&bar[XB_TMO], 1u); break; } }
    }
    nloc = mine > 0u ? mine : 1u; nx = cnt > 0u ? cnt : 1u;
}

__device__ __forceinline__ void xcd_barrier(const XcdBarrier& b) {
    asm volatile("s_waitcnt vmcnt(0)" ::: "memory");
    __syncthreads();
    if (threadIdx.x == 0) {
        unsigned* bar = b.bar;
        __builtin_amdgcn_s_waitcnt(0);
        unsigned nloc = b.st[0], nx = b.st[1];
        if (nloc == 0u) { xcd_barrier_complete(bar, b.x, nloc, nx); b.st[0] = nloc; b.st[1] = nx; }
        const unsigned old = xb_add(&bar[XB_XSUB(b.x)], 1u);
        const unsigned gen = old / nloc;
        if (old + 1u == (gen + 1u) * nloc) {
            __builtin_amdgcn_fence(__ATOMIC_RELEASE, "agent");
            asm volatile("s_waitcnt vmcnt(0)" ::: "memory");
            const unsigned og = xb_add(&bar[XB_TOP], 1u);
            const unsigned tg = og / nx;
            if (og + 1u == (tg + 1u) * nx) xb_add(&bar[XB_TOPGEN], 1u);
            else XB_SPIN(xb_ld(&bar[XB_TOPGEN]) == tg, bar);
            __builtin_amdgcn_fence(__ATOMIC_ACQUIRE, "agent");
            xb_add(&bar[XB_XGEN(b.x)], 1u);
            asm volatile("s_waitcnt vmcnt(0)" ::: "memory");
        } else {
            XB_SPIN(xb_ld(&bar[XB_XGEN(b.x)]) == gen, bar);
            __builtin_amdgcn_fence(__ATOMIC_ACQUIRE, "agent");
            asm volatile("s_waitcnt vmcnt(0)" ::: "memory");
        }
    }
    __syncthreads();
}

namespace att {
constexpr int D = 128, NW = 8, QBLK = 32, KVBLK = 64;
constexpr float SCALE = 0.088388347648318440f;
constexpr float THR = 8.f;
#ifndef ATT_SDEPTH
#define ATT_SDEPTH 1
#endif
constexpr int SDEPTH = ATT_SDEPTH;
constexpr int LDQ = 1024, LDK = 256, LDO = 2048;
constexpr size_t SHM_V = KVBLK * D * 2, SHM_K = KVBLK * D * 2, SHM_ATTN = 2 * SHM_V + 2 * SHM_K + NW * 64 * 4;
using s16x4  = __attribute__((ext_vector_type(4))) short;
using f32x16 = __attribute__((ext_vector_type(16))) float;
#define KSWZ(row, colB) ((row) * 256 + ((colB) ^ (((row) & 7) << 4)))
#define SBAR() __builtin_amdgcn_sched_barrier(0)
__device__ __forceinline__ int crow(int r, int hi) { return (r & 3) + 8 * (r >> 2) + 4 * hi; }
__device__ __forceinline__ unsigned cvtpk(float lo, float hi) { unsigned r; asm volatile("v_cvt_pk_bf16_f32 %0, %1, %2" : "=v"(r) : "v"(lo), "v"(hi)); return r; }

__device__ __forceinline__ void partialSM(f32x16& p0, f32x16& p1, float& m_reg, float& mn, float& alpha) {
  constexpr float C = SCALE * 1.4426950408889634f;
  float pmax = p0[0]; for (int r = 1; r < 16; ++r) pmax = fmaxf(pmax, p0[r]); for (int r = 0; r < 16; ++r) pmax = fmaxf(pmax, p1[r]);
  { auto rr = __builtin_amdgcn_permlane32_swap(__float_as_uint(pmax), __float_as_uint(pmax), false, false);
    pmax = fmaxf(__uint_as_float(rr[0]), __uint_as_float(rr[1])); }
  if (__builtin_expect(__all(pmax - m_reg <= THR / SCALE), 1)) { mn = m_reg; alpha = 1.f; }
  else { mn = fmaxf(m_reg, pmax); alpha = __builtin_amdgcn_exp2f((m_reg - mn) * C); m_reg = mn; }
  float mnC = -mn * C;
  for (int r = 0; r < 16; ++r) p0[r] = fmaf(p0[r], C, mnC); for (int r = 0; r < 16; ++r) p1[r] = fmaf(p1[r], C, mnC);
  for (int r = 0; r < 16; ++r) p0[r] = __builtin_amdgcn_exp2f(p0[r]);
}
__device__ __forceinline__ void finishSM(f32x16& p0, f32x16& p1, float alpha, float& l_reg, bf16x8& pa0, bf16x8& pa1, bf16x8& pa2, bf16x8& pa3) {
  for (int r = 0; r < 16; ++r) p1[r] = __builtin_amdgcn_exp2f(p1[r]);
  float ps = 0; for (int r = 0; r < 16; ++r) ps += p0[r]; for (int r = 0; r < 16; ++r) ps += p1[r];
  { auto rr = __builtin_amdgcn_permlane32_swap(__float_as_uint(ps), __float_as_uint(ps), false, false);
    ps = __uint_as_float(rr[0]) + __uint_as_float(rr[1]); }
  l_reg = l_reg * alpha + ps;
#define PK4(P, BASE, OUT) do { unsigned a0 = cvtpk(P[BASE + 0], P[BASE + 1]), a1 = cvtpk(P[BASE + 2], P[BASE + 3]);   \
    unsigned b0 = cvtpk(P[BASE + 4], P[BASE + 5]), b1 = cvtpk(P[BASE + 6], P[BASE + 7]);                              \
    auto r0 = __builtin_amdgcn_permlane32_swap(a0, b0, false, false); auto r1 = __builtin_amdgcn_permlane32_swap(a1, b1, false, false); \
    v4u w = {r0[0], r1[0], r0[1], r1[1]}; OUT = *reinterpret_cast<bf16x8*>(&w); } while (0)
  PK4(p0, 0, pa0); PK4(p0, 8, pa1); PK4(p1, 0, pa2); PK4(p1, 8, pa3);
#undef PK4
}
__device__ __forceinline__ void qkt(f32x16& p0, f32x16& p1, const bf16* Ks, const bf16x8* qr, int r32, int hi) {
  p0 = f32x16{}; p1 = f32x16{};
  for (int d0 = 0; d0 < 8; ++d0) { int cb = (d0 * 16 + hi * 8) * 2;
    bf16x8 b0 = *reinterpret_cast<const bf16x8*>((const char*)Ks + KSWZ(r32, cb));
    bf16x8 b1 = *reinterpret_cast<const bf16x8*>((const char*)Ks + KSWZ(32 + r32, cb));
    p0 = __builtin_amdgcn_mfma_f32_32x32x16_bf16(b0, qr[d0], p0, 0, 0, 0);
    p1 = __builtin_amdgcn_mfma_f32_32x32x16_bf16(b1, qr[d0], p1, 0, 0, 0); }
}
__device__ __forceinline__ int v_st(int k, int c) { const int kk = (k & ~0xC) | ((k & 4) << 1) | ((k & 8) >> 1); return ((kk >> 3) * 4 + (c >> 5)) * 512 + ((kk & 7) * 32 + (c & 31)) * 2; }
__device__ __forceinline__ int v_rd_base(int lane) { return ((lane & 3) << 3) | (((lane >> 2) & 3) << 6) | (((lane >> 4) & 1) << 5) | (((lane >> 5) & 1) << 8); }
constexpr int v_rd_off(int d0, int ks, int half) { return d0 * 512 + ks * 4096 + half * 2048; }
template <int OFF> __device__ __forceinline__ s16x4 tr_read(int vb) {
  s16x4 r; asm volatile("ds_read_b64_tr_b16 %0, %1 offset:%2" : "=&v"(r) : "v"(vb), "i"(OFF) : "memory"); return r;
}
template <int D0> __device__ __forceinline__ void pv_one(f32x16& od, int vb, bf16x8 pa0, bf16x8 pa1, bf16x8 pa2, bf16x8 pa3) {
  const s16x4 l0 = tr_read<v_rd_off(D0, 0, 0)>(vb), h0 = tr_read<v_rd_off(D0, 0, 1)>(vb), l1 = tr_read<v_rd_off(D0, 1, 0)>(vb), h1 = tr_read<v_rd_off(D0, 1, 1)>(vb);
  const s16x4 l2 = tr_read<v_rd_off(D0, 2, 0)>(vb), h2 = tr_read<v_rd_off(D0, 2, 1)>(vb), l3 = tr_read<v_rd_off(D0, 3, 0)>(vb), h3 = tr_read<v_rd_off(D0, 3, 1)>(vb);
  asm volatile("s_waitcnt lgkmcnt(0)" ::: "memory"); SBAR();
#define PK(L, H) (bf16x8){L[0], L[1], L[2], L[3], H[0], H[1], H[2], H[3]}
  od = __builtin_amdgcn_mfma_f32_32x32x16_bf16(pa0, PK(l0, h0), od, 0, 0, 0);
  od = __builtin_amdgcn_mfma_f32_32x32x16_bf16(pa1, PK(l1, h1), od, 0, 0, 0);
  od = __builtin_amdgcn_mfma_f32_32x32x16_bf16(pa2, PK(l2, h2), od, 0, 0, 0);
  od = __builtin_amdgcn_mfma_f32_32x32x16_bf16(pa3, PK(l3, h3), od, 0, 0, 0);
#undef PK
}
__device__ __forceinline__ void pv_d0(f32x16* o, int vb, bf16x8 pa0, bf16x8 pa1, bf16x8 pa2, bf16x8 pa3) {
  pv_one<0>(o[0], vb, pa0, pa1, pa2, pa3); pv_one<1>(o[1], vb, pa0, pa1, pa2, pa3); pv_one<2>(o[2], vb, pa0, pa1, pa2, pa3); pv_one<3>(o[3], vb, pa0, pa1, pa2, pa3);
}
struct KVSrc { const bf16* Kl; const bf16* Vl; const bf16* Kc; const bf16* Vc; int nloc, kstart, nrows; };

__device__ __forceinline__ void attn_body(const bf16* __restrict__ Qb, const KVSrc src, bf16* __restrict__ Ob, int NT, float sink_raw, int qpos0, char* lds) {
  int tid_ = threadIdx.x; asm volatile("" : "+v"(tid_)); const int tid = tid_, wid = tid >> 6, lane = tid & 63, r32 = lane & 31, hi = lane >> 5;
  bf16* V_lds = (bf16*)lds; bf16* K_lds = (bf16*)(lds + 2 * SHM_V);
  float* ws = (float*)(lds + 2 * SHM_V + 2 * SHM_K) + wid * 64; float* li_l = ws; float* al_l = ws + 32;
  float m_reg = sink_raw, l_reg = 1.f; f32x16 o[4] = {}; bf16x8 qr[8];
  const bf16* Qw = Qb + (long)(wid * QBLK + r32) * LDQ + hi * 8;
#pragma unroll
  for (int d0 = 0; d0 < 8; ++d0) qr[d0] = *reinterpret_cast<const bf16x8*>(Qw + d0 * 16);
  const int sr = tid >> 4, sc = (tid & 15) * 8, vst0 = v_st(sr, sc), vst1 = v_st(32 + sr, sc);
  const int vb0 = (int)(uintptr_t)V_lds + v_rd_base(lane);
  const int qpos = qpos0 + wid * QBLK + r32;
  struct { bf16x8 vs0, vs1, ks0, ks1; } sr_[SDEPTH];
#define SLOAD(i, t) do { const bf16 *kp_, *vp_; int r0_, r1_; const int t_ = (t);                                                      \
    if (t_ < src.nloc) { const int k0_ = src.kstart + t_ * KVBLK; r0_ = k0_ + sr; r1_ = k0_ + 32 + sr;                                   \
      r0_ = r0_ < 0 ? 0 : (r0_ >= src.nrows ? src.nrows - 1 : r0_); r1_ = r1_ < 0 ? 0 : (r1_ >= src.nrows ? src.nrows - 1 : r1_); kp_ = src.Kl; vp_ = src.Vl; } \
    else { const int k0_ = (t_ - src.nloc) * KVBLK; r0_ = k0_ + sr; r1_ = k0_ + 32 + sr; kp_ = src.Kc; vp_ = src.Vc; }                  \
    sr_[i].vs0 = *reinterpret_cast<const bf16x8*>(vp_ + (long)r0_ * LDK + sc); sr_[i].vs1 = *reinterpret_cast<const bf16x8*>(vp_ + (long)r1_ * LDK + sc); \
    sr_[i].ks0 = *reinterpret_cast<const bf16x8*>(kp_ + (long)r0_ * LDK + sc); sr_[i].ks1 = *reinterpret_cast<const bf16x8*>(kp_ + (long)r1_ * LDK + sc); } while (0)
#define SWRITE(b, i) do { *(bf16x8*)((char*)V_lds + (b) * SHM_V + vst0) = sr_[i].vs0;          \
    *(bf16x8*)((char*)V_lds + (b) * SHM_V + vst1) = sr_[i].vs1; int kc = sc * 2;               \
    *(bf16x8*)((char*)K_lds + (b) * SHM_K + KSWZ(sr, kc)) = sr_[i].ks0;                       \
    *(bf16x8*)((char*)K_lds + (b) * SHM_K + KSWZ(32 + sr, kc)) = sr_[i].ks1; } while (0)
#define SWAIT() do { if constexpr (SDEPTH == 2) asm volatile("s_waitcnt vmcnt(4)" ::: "memory"); else asm volatile("s_waitcnt vmcnt(0)" ::: "memory"); } while (0)
#define RESC(a) do { if (__any((a) < 1.f)) { if (hi == 0) al_l[r32] = (a); asm volatile("s_waitcnt lgkmcnt(0)" ::: "memory"); \
    for (int d = 0; d < 4; ++d) for (int r = 0; r < 16; ++r) o[d][r] *= al_l[crow(r, hi)]; } } while (0)
#define MASK(P0, P1, t) do { const int t_ = (t); if (t_ < src.nloc) { const int kb_ = src.kstart + t_ * KVBLK;                           \
    _Pragma("unroll") for (int r = 0; r < 16; ++r) { const int k0_ = kb_ + crow(r, hi), k1_ = k0_ + 32;                                  \
      const int d0_ = qpos - k0_, d1_ = qpos - k1_;                                                                                     \
      const bool v0_ = (k0_ >= 0) && (k0_ < src.nrows) && (d0_ <= 128) && (d0_ >= -128);                                                 \
      const bool v1_ = (k1_ >= 0) && (k1_ < src.nrows) && (d1_ <= 128) && (d1_ >= -128);                                                 \
      P0[r] = v0_ ? P0[r] : -1e30f; P1[r] = v1_ ? P1[r] : -1e30f; } } } while (0)
  f32x16 pA0, pA1, pB0, pB1; float mnA, mnB, alA, alB; bf16x8 pa0, pa1, pa2, pa3;
  constexpr int SE = 0, SO = SDEPTH - 1;
  SLOAD(SE, 0); asm volatile("s_waitcnt vmcnt(0)" ::: "memory"); SWRITE(0, SE); __syncthreads();
  qkt(pA0, pA1, K_lds, qr, r32, hi); MASK(pA0, pA1, 0); partialSM(pA0, pA1, m_reg, mnA, alA);
  SLOAD(SO, 1); if constexpr (SDEPTH == 2) { if (2 < NT) SLOAD(SE, 2); }
  SWAIT(); SWRITE(1, SO); __syncthreads();
  for (int j = 1; j + 1 < NT; j += 2) {
    SBAR(); qkt(pB0, pB1, (bf16*)((char*)K_lds + SHM_K), qr, r32, hi);
    finishSM(pA0, pA1, alA, l_reg, pa0, pa1, pa2, pa3); SBAR();
    SLOAD(SO, j + SDEPTH); SBAR();
    pv_d0(o, vb0, pa0, pa1, pa2, pa3); MASK(pB0, pB1, j); partialSM(pB0, pB1, m_reg, mnB, alB);
    __syncthreads(); SWAIT(); SWRITE(0, SE);
    RESC(alB); __syncthreads();
    SBAR(); qkt(pA0, pA1, K_lds, qr, r32, hi);
    finishSM(pB0, pB1, alB, l_reg, pa0, pa1, pa2, pa3); SBAR();
    if (SDEPTH == 1 || j + 3 < NT) SLOAD(SE, j + 1 + SDEPTH); SBAR();
    pv_d0(o, vb0 + (int)SHM_V, pa0, pa1, pa2, pa3); MASK(pA0, pA1, j + 1); partialSM(pA0, pA1, m_reg, mnA, alA);
    __syncthreads(); SWAIT(); SWRITE(1, SO);
    RESC(alA); __syncthreads();
  }
  SBAR(); qkt(pB0, pB1, (bf16*)((char*)K_lds + SHM_K), qr, r32, hi);
  finishSM(pA0, pA1, alA, l_reg, pa0, pa1, pa2, pa3); SBAR();
  pv_d0(o, vb0, pa0, pa1, pa2, pa3); MASK(pB0, pB1, NT - 1); partialSM(pB0, pB1, m_reg, mnB, alB);
  __syncthreads(); RESC(alB);
  finishSM(pB0, pB1, alB, l_reg, pa0, pa1, pa2, pa3); SBAR();
  pv_d0(o, vb0 + (int)SHM_V, pa0, pa1, pa2, pa3);
  if (hi == 0) li_l[r32] = l_reg; asm volatile("s_waitcnt lgkmcnt(0)" ::: "memory");
  float rli[16];
#pragma unroll
  for (int r = 0; r < 16; ++r) rli[r] = __builtin_amdgcn_rcpf(li_l[crow(r, hi)]);
  bf16* Ow = Ob + (long)(wid * QBLK) * LDO;
#pragma unroll
  for (int r = 0; r < 16; ++r) { int orow = crow(r, hi);
    for (int d0 = 0; d0 < 4; ++d0) Ow[(long)orow * LDO + d0 * 32 + r32] = f2bf(o[d0][r] * rli[r]); }
  __syncthreads();
#undef SLOAD
#undef SWRITE
#undef SWAIT
#undef RESC
#undef MASK
}
}

struct Args { const float* in[23]; float* out; unsigned char* ws; int ph_lo, ph_hi; };
enum { I_XP = 0, I_XS, I_CK, I_CV, I_ST, I_C, I_CCTX, I_WADA, I_BADA, I_NG, I_WFI, I_WFO, I_WIN, I_WOUT, I_QG, I_KG, I_SINK, I_LB, I_RG, I_CW, I_CB, I_CLG, I_CLB };

__device__ __forceinline__ void transpose_item(const float* W, int K, int N, bf16* WT, LAS float* scr, int item, int lane, bool interleave) {
    const int nblk = N / 32, kb = item / nblk, nb = item % nblk, k0 = 64 * kb, n0 = 32 * nb;
    int dn0 = n0;
    if (interleave) { const int hh = n0 >= DFF ? 1 : 0, m = n0 - hh * DFF; dn0 = 256 * (m >> 7) + 128 * hh + (m & 127); }
#pragma unroll 8
    for (int i = 0; i < 32; ++i) { const int kk = 2 * i + (lane >> 5); scr[kk * 33 + (lane & 31)] = W[(size_t)(k0 + kk) * N + n0 + (lane & 31)]; }
    LDS_WAIT(); asm volatile("" ::: "memory");
    const int c = lane & 7;
#pragma unroll
    for (int j = 0; j < 4; ++j) { const int n = (lane >> 3) + 8 * j; const LAS float* s = scr + (8 * c) * 33 + n;
        v4u o; o.x = pk2(s[0 * 33], s[1 * 33]); o.y = pk2(s[2 * 33], s[3 * 33]); o.z = pk2(s[4 * 33], s[5 * 33]); o.w = pk2(s[6 * 33], s[7 * 33]);
        *(v4u*)(WT + (size_t)(dn0 + n) * K + k0 + 8 * c) = o; }
    LDS_WAIT(); asm volatile("" ::: "memory");
}

__device__ __forceinline__ void phase_p0(const Args& a, LAS unsigned char* lds, int vcu, int G) {
    int tid_ = threadIdx.x; asm volatile("" : "+v"(tid_)); const int tid = tid_, lane = tid & 63, wave = tid >> 6;
    unsigned char* ws = a.ws;
    {
        LAS float* scr = (LAS float*)(lds + wave * 16384);
        const int gw = vcu * 8 + wave, NGW = G * 8;
        constexpr int I_FI = 32 * 352, I_FO = 88 * 64, I_IN = 32 * 160, I_OUT = 32 * 64, I_LAYER = 2 * I_FI + 2 * I_FO + I_IN + I_OUT;
        for (int it = gw; it < 2 * I_LAYER; it += NGW) {
            const int l = it / I_LAYER; int r = it % I_LAYER;
            if (r < 2 * I_FI) { const int s = r / I_FI; r -= s * I_FI;
                transpose_item(a.in[I_WFI] + (size_t)(l * 2 + s) * DM * NFF2, DM, NFF2, (bf16*)(ws + WS_WFI) + (size_t)(l * 2 + s) * NFF2 * DM, scr, r, lane, true); continue; }
            r -= 2 * I_FI;
            if (r < 2 * I_FO) { const int s = r / I_FO; r -= s * I_FO;
                transpose_item(a.in[I_WFO] + (size_t)(l * 2 + s) * DFF * DM, DFF, DM, (bf16*)(ws + WS_WFO) + (size_t)(l * 2 + s) * DM * DFF, scr, r, lane, false); continue; }
            r -= 2 * I_FO;
            if (r < I_IN) { transpose_item(a.in[I_WIN] + (size_t)l * DM * INC, DM, INC, (bf16*)(ws + WS_WIN) + (size_t)l * INC * DM, scr, r, lane, false); continue; }
            r -= I_IN;
            transpose_item(a.in[I_WOUT] + (size_t)l * DM * DM, DM, DM, (bf16*)(ws + WS_WOUT) + (size_t)l * DM * DM, scr, r, lane, false);
        }
    }
    __syncthreads();
    {
        LAS float* scs = (LAS float*)lds;
        for (int i = tid; i < 3 * DM; i += 512) { const int cond = i / DM, k = i % DM; const float v = cond == 0 ? a.in[I_CCTX][k] : a.in[I_C][(cond - 1) * DM + k]; scs[i] = siluf(v); }
        __syncthreads();
        float* mod = (float*)(ws + WS_MOD);
        const int NIT = 18 * 128, it0 = (int)(((long)vcu * NIT) / G), it1 = (int)(((long)(vcu + 1) * NIT) / G);
        int cur = -1; float acc[3][4];
#pragma unroll
        for (int c = 0; c < 3; ++c)
#pragma unroll
            for (int j = 0; j < 4; ++j) acc[c][j] = 0.f;
        for (int it = it0; it <= it1; ++it) {
            const int lc = it < it1 ? it / 128 : -2;
            if (lc != cur) {
                if (cur >= 0) { const int l = cur / 9, cr = cur % 9;
#pragma unroll
                    for (int c = 0; c < 3; ++c)
#pragma unroll
                        for (int j = 0; j < 4; ++j) { atomicAdd(mod + (size_t)(c * 2 + l) * MODW + cr * 2048 + 4 * tid + j, acc[c][j]); acc[c][j] = 0.f; } }
                cur = lc;
            }
            if (it == it1) break;
            const int l = lc / 9, cr = lc % 9, ks = it % 128;
            const float* Wp = a.in[I_WADA] + ((size_t)l * DM + ks * 16) * MODW + cr * 2048 + 4 * tid;
#pragma unroll
            for (int kk = 0; kk < 16; ++kk) { const f32x4 w = *(const f32x4*)(Wp + (size_t)kk * MODW); const int k = ks * 16 + kk;
                const float s0 = scs[k], s1 = scs[DM + k], s2 = scs[2 * DM + k];
#pragma unroll
                for (int j = 0; j < 4; ++j) { acc[0][j] += s0 * w[j]; acc[1][j] += s1 * w[j]; acc[2][j] += s2 * w[j]; } }
        }
    }
    {
        const int gt = vcu * 512 + tid, NGT = G * 512;
        for (int i = gt; i < 2 * 65536; i += NGT) { const int which = i >> 16, g8 = i & 65535;
            const int dg = g8 & 15, pos = (g8 >> 4) & 511, kvh = (g8 >> 13) & 1, bl = g8 >> 14;
            const float* src = a.in[which ? I_CV : I_CK] + (size_t)g8 * 8;
            const f32x4 x0 = *(const f32x4*)src, x1 = *(const f32x4*)(src + 4);
            v4u o; o.x = pk2(x0[0], x0[1]); o.y = pk2(x0[2], x0[3]); o.z = pk2(x1[0], x1[1]); o.w = pk2(x1[2], x1[3]);
            *(v4u*)((bf16*)(ws + (which ? WS_CV : WS_CK)) + ((size_t)bl * 512 + pos) * 256 + kvh * 128 + dg * 8) = o; }
        f32x4* X4 = (f32x4*)a.out; const f32x4* P4 = (const f32x4*)a.in[I_XP]; const f32x4* S4 = (const f32x4*)a.in[I_XS];
        constexpr int HALF4 = NCTX * DM / 4;
        for (int i = gt; i < HALF4; i += NGT) { X4[i] = P4[i]; X4[HALF4 + i] = S4[i]; }
    }
}

__device__ __forceinline__ void phase_norm(const Args& a, int l, int s, int vcu, int G) {
    int tid_ = threadIdx.x; asm volatile("" : "+v"(tid_)); const int tid = tid_, lane = tid & 63, wave = tid >> 6;
    const float* X = a.out; bf16* H = (bf16*)(a.ws + WS_H);
    const float* mod = (const float*)(a.ws + WS_MOD); const float* bada = a.in[I_BADA] + (size_t)l * MODW;
    const float* ng = a.in[I_NG] + (size_t)(l * 3 + s) * DM;
    for (int row = vcu * 8 + wave; row < NTOK; row += G * 8) {
        const int cond = row < NCTX ? 0 : 1 + ((row - NCTX) >> 12);
        const float* m0 = mod + (size_t)(cond * 2 + l) * MODW;
        const f32x4* xr = (const f32x4*)(X + (size_t)row * DM) + lane;
        f32x4 v[8]; float ss = 0.f;
#pragma unroll
        for (int j = 0; j < 8; ++j) { v[j] = xr[64 * j]; ss += (v[j].x * v[j].x + v[j].y * v[j].y) + (v[j].z * v[j].z + v[j].w * v[j].w); }
        const float rstd = 1.0f / sqrtf(wave_sum(ss) * (1.f / DM) + EPS);
        v2u* o8 = (v2u*)(H + (size_t)row * DM) + lane;
#pragma unroll
        for (int j = 0; j < 8; ++j) { const int col = 4 * lane + 256 * j;
            const f32x4 g = *(const f32x4*)(ng + col);
            const f32x4 sh = *(const f32x4*)(m0 + (3 * s) * DM + col) + *(const f32x4*)(bada + (3 * s) * DM + col);
            const f32x4 sc = *(const f32x4*)(m0 + (3 * s + 1) * DM + col) + *(const f32x4*)(bada + (3 * s + 1) * DM + col);
            const f32x4 h = v[j] * rstd * g * (sc + 1.0f) + sh;
            v2u w; w.x = pk2(h.x, h.y); w.y = pk2(h.z, h.w); o8[64 * j] = w; }
    }
}

__device__ __forceinline__ float lb_val(const Args& a, int l, int dir, int ch) {
    if (l == 0) return 0.f;
    const float a0 = a.in[I_LB][dir * 512 + ch], a1 = a.in[I_LB][1024 + dir * 512 + ch];
    return 1.f / (1.f + expf(a0 - a1));
}
__device__ __forceinline__ void gate_fn(float z, float lb, float& k, float& lf) {
    const float sg = 1.f / (1.f + expf(-z)), sn = 1.f / (1.f + expf(z));
    const float f = lb + (1.f - lb) * sg;
    lf = logf(fmaxf(f, 1e-30f)); k = (1.f - lb) * sn;
}

__device__ __forceinline__ void phase_prep(const Args& a, int l, int vcu, int G) {
    int tid_ = threadIdx.x; asm volatile("" : "+v"(tid_)); const int tid = tid_, lane = tid & 63, wave = tid >> 6;
    const float* Z = (const float*)(a.ws + WS_Z);
    bf16* Qb = (bf16*)(a.ws + WS_Q); bf16* Kb = (bf16*)(a.ws + WS_K); bf16* Vb = (bf16*)(a.ws + WS_V);
    const int hf = lane >> 5, j = lane & 31, e1 = 64 * hf + j, e2 = e1 + 32;
    const float invf = exp2f(-(float)j * (13.287712379549449f / 32.f));
    const float qg1 = a.in[I_QG][l * 128 + e1], qg2 = a.in[I_QG][l * 128 + e2], kg1 = a.in[I_KG][l * 128 + e1], kg2 = a.in[I_KG][l * 128 + e2];
    for (int row = vcu * 8 + wave; row < NTOK; row += G * 8) {
        const float* z = Z + (size_t)row * INC;
        const bool lat = row >= NCTX;
        float cs = 1.f, sn = 0.f;
        if (lat) { const int p = (row - NCTX) & 4095; const int pos = hf ? (p & 63) : (p >> 6); const float ang = (float)pos * invf; cs = cosf(ang); sn = sinf(ang); }
#pragma unroll
        for (int hd = 0; hd < 10; ++hd) {
            const int base = hd < 8 ? ZQ + hd * 128 : ZK + (hd - 8) * 128;
            const float x1 = z[base + e1], x2 = z[base + e2];
            const float rstd = 1.0f / sqrtf(wave_sum(x1 * x1 + x2 * x2) * (1.f / 128.f) + EPS);
            float y1 = x1 * rstd * (hd < 8 ? qg1 : kg1), y2 = x2 * rstd * (hd < 8 ? qg2 : kg2);
            if (!lat && hd >= 8) { const int b = row >> 8, pos = row & 255; float* ck = a.out + OUT_CK + ((((size_t)b * 2 + l) * 2 + (hd - 8)) * 256 + pos) * 128; ck[e1] = y1; ck[e2] = y2; }
            if (lat) { const float r1 = y1 * cs - y2 * sn, r2 = y1 * sn + y2 * cs; y1 = r1; y2 = r2; }
            if (hd < 8) { bf16* q = Qb + (size_t)row * 1024 + hd * 128; q[e1] = f2bf(y1); q[e2] = f2bf(y2); }
            else { bf16* k = Kb + (size_t)row * 256 + (hd - 8) * 128; k[e1] = f2bf(y1); k[e2] = f2bf(y2); }
        }
        const f32x4 v = *(const f32x4*)(z + ZV + 4 * lane);
        v2u w; w.x = pk2(v.x, v.y); w.y = pk2(v.z, v.w); *((v2u*)(Vb + (size_t)row * 256) + lane) = w;
        if (!lat) { const int b = row >> 8, pos = row & 255, kvh = lane >> 5; *(f32x4*)(a.out + OUT_CV + ((((size_t)b * 2 + l) * 2 + kvh) * 256 + pos) * 128 + ((4 * lane) & 127)) = v; }
    }
}

__device__ __forceinline__ void phase_hgrn_a(const Args& a, LAS unsigned char* lds, int l, int vcu, int G) {
    int tid_ = threadIdx.x; asm volatile("" : "+v"(tid_)); const int tid = tid_, lane = tid & 63, wave = tid >> 6, fr = lane & 15, fq = lane >> 4;
    const float* Z = (const float*)(a.ws + WS_Z);
    float* US = (float*)(a.ws + WS_US); float* DEC = (float*)(a.ws + WS_DEC);
    LAS unsigned char* KT = lds;
    LAS unsigned char* VT = lds + 20480;
    for (int item = vcu; item < 2048; item += G) {
        const int gb = item >> 2, head = item & 3, row0 = gb * 32;
        if (tid < 256) {
            const int dir = tid >> 7, d = tid & 127;
            const int zcol = (dir ? ZRB : ZRF) + head * 128 + d;
            const float lb = lb_val(a, l, dir, head * 128 + d);
            float kk[32], cum[32]; float run = 0.f;
#pragma unroll
            for (int i = 0; i < 32; ++i) { const int p = dir ? 31 - i : i; float k, lf; gate_fn(Z[(size_t)(row0 + p) * INC + zcol], lb, k, lf); run += lf; kk[i] = k; cum[i] = run; }
#pragma unroll
            for (int i = 0; i < 32; i += 2) { const float va = kk[i] * expf(run - cum[i]), vb = kk[i + 1] * expf(run - cum[i + 1]);
                const int p = dir ? 30 - i : i;
                *(LAS unsigned*)(KT + (dir * 128 + d) * 80 + p * 2) = pk2(dir ? vb : va, dir ? va : vb); }
            DEC[((size_t)(dir * 512 + gb) * 4 + head) * 128 + d] = expf(run);
        } else {
            const int t2 = tid - 256, e = t2 & 127, ph = t2 >> 7;
#pragma unroll
            for (int i = 0; i < 16; i += 2) { const int p = ph * 16 + i;
                const float v0 = Z[(size_t)(row0 + p) * INC + ZRI + head * 128 + e], v1 = Z[(size_t)(row0 + p + 1) * INC + ZRI + head * 128 + e];
                *(LAS unsigned*)(VT + e * 80 + p * 2) = pk2(v0, v1); }
        }
        __syncthreads();
#pragma unroll
        for (int dir = 0; dir < 2; ++dir) {
            const bf16x8 af = *(const LAS bf16x8*)(KT + (dir * 128 + wave * 16 + fr) * 80 + fq * 16);
            float* Ub = US + ((size_t)(dir * 512 + gb) * 4 + head) * 16384;
#pragma unroll
            for (int et = 0; et < 8; ++et) {
                const bf16x8 bfv = *(const LAS bf16x8*)(VT + (et * 16 + fr) * 80 + fq * 16);
                f32x4 acc = {0.f, 0.f, 0.f, 0.f};
                acc = __builtin_amdgcn_mfma_f32_16x16x32_bf16(af, bfv, acc, 0, 0, 0);
#pragma unroll
                for (int i = 0; i < 4; ++i) Ub[(wave * 16 + 4 * fq + i) * 128 + et * 16 + fr] = acc[i];
            }
        }
        __syncthreads();
    }
}

__device__ __forceinline__ void phase_conv(const Args& a, LAS unsigned char* lds, int l, int vcu, int G) {
    int tid_ = threadIdx.x; asm volatile("" : "+v"(tid_)); const int tid = tid_, lane = tid & 63, wave = tid >> 6, ch = tid;
    const float* Z = (const float*)(a.ws + WS_Z); bf16* MIX = (bf16*)(a.ws + WS_MIX);
    LAS float* red = (LAS float*)lds;
    float w[31];
#pragma unroll
    for (int j = 0; j < 31; ++j) w[j] = a.in[I_CW][(size_t)(l * 31 + j) * 512 + ch];
    const float bias = a.in[I_CB][l * 512 + ch], lg = a.in[I_CLG][l * 512 + ch], lbb = a.in[I_CLB][l * 512 + ch];
    for (int gb = vcu; gb < 512; gb += G) {
        const int row0 = gb * 32;
        int s0, T; if (row0 < NCTX) { s0 = row0 & ~255; T = 256; } else { s0 = NCTX + ((row0 - NCTX) & ~4095); T = 4096; }
        float h[62];
#pragma unroll
        for (int i = 0; i < 62; ++i) { const int r = row0 - 15 + i; float v = 0.f;
            if (r >= s0 && r < s0 + T) { const float ca = Z[(size_t)r * INC + ZCA + ch], cb = Z[(size_t)r * INC + ZCB + ch]; v = ca * sigm(cb); }
            h[i] = v; }
        float o[32];
#pragma unroll
        for (int p = 0; p < 32; ++p) { float acc = bias;
#pragma unroll
            for (int j = 0; j < 31; ++j) acc += w[j] * h[p + j];
            o[p] = acc; }
#pragma unroll
        for (int p = 0; p < 32; ++p) { const float s1 = wave_sum(o[p]), s2 = wave_sum(o[p] * o[p]); if (lane == 0) { red[(wave * 32 + p) * 2] = s1; red[(wave * 32 + p) * 2 + 1] = s2; } }
        __syncthreads();
#pragma unroll
        for (int p = 0; p < 32; ++p) { float s1 = 0.f, s2 = 0.f;
#pragma unroll
            for (int wv = 0; wv < 8; ++wv) { s1 += red[(wv * 32 + p) * 2]; s2 += red[(wv * 32 + p) * 2 + 1]; }
            const float mu = s1 * (1.f / 512.f), var = fmaxf(s2 * (1.f / 512.f) - mu * mu, 0.f);
            const float y = (o[p] - mu) * (1.0f / sqrtf(var + EPS)) * lg + lbb;
            MIX[(size_t)(row0 + p) * DM + 1536 + ch] = f2bf(siluf(y)); }
        __syncthreads();
    }
}

__device__ __forceinline__ void phase_attn(const Args& a, unsigned char* lds_generic, int l, int vcu, int G) {
    const bf16* Qb = (const bf16*)(a.ws + WS_Q); const bf16* Kb = (const bf16*)(a.ws + WS_K); const bf16* Vb = (const bf16*)(a.ws + WS_V);
    bf16* MIX = (bf16*)(a.ws + WS_MIX);
    for (int item = vcu; item < 512; item += G) {
        if (item < 256) {
            const int b = item >> 3, h = item & 7, kvh = h >> 2; const size_t r0 = (size_t)b * 256;
            att::KVSrc src; src.Kl = nullptr; src.Vl = nullptr; src.Kc = Kb + r0 * 256 + kvh * 128; src.Vc = Vb + r0 * 256 + kvh * 128; src.nloc = 0; src.kstart = 0; src.nrows = 1;
            att::attn_body(Qb + r0 * 1024 + h * 128, src, MIX + r0 * DM + h * 128, 4, a.in[I_SINK][l * 8 + h] * (1.0f / att::SCALE), 0, (char*)lds_generic);
        } else {
            const int it = item - 256, b2 = it >> 7, h = (it >> 4) & 7, qi = it & 15, kvh = h >> 2; const size_t rb = (size_t)NCTX + (size_t)b2 * 4096;
            att::KVSrc src; src.Kl = Kb + rb * 256 + kvh * 128; src.Vl = Vb + rb * 256 + kvh * 128;
            src.Kc = (const bf16*)(a.ws + WS_CK) + ((size_t)(b2 * 2 + l) * 512) * 256 + kvh * 128; src.Vc = (const bf16*)(a.ws + WS_CV) + ((size_t)(b2 * 2 + l) * 512) * 256 + kvh * 128;
            src.nloc = 8; src.kstart = 256 * qi - 128; src.nrows = 4096;
            att::attn_body(Qb + (rb + 256 * qi) * 1024 + h * 128, src, MIX + (rb + 256 * qi) * DM + h * 128, 16, a.in[I_SINK][l * 8 + h] * (1.0f / att::SCALE), 256 * qi, (char*)lds_generic);
        }
    }
}

__device__ __forceinline__ void phase_hgrn_b(const Args& a, int l, int vcu, int G) {
    int tid_ = threadIdx.x; asm volatile("" : "+v"(tid_)); const int tid = tid_;
    float* US = (float*)(a.ws + WS_US); const float* DEC = (const float*)(a.ws + WS_DEC);
    for (int item = vcu; item < 256; item += G) {
        const int b = item >> 3, head = (item >> 1) & 3, dir = item & 1;
        f32x4 S[8];
#pragma unroll
        for (int j = 0; j < 8; ++j) S[j] = (f32x4){0.f, 0.f, 0.f, 0.f};
        for (int i = 0; i < 8; ++i) { const int cc = dir ? 7 - i : i, gb = b * 8 + cc;
            f32x4* U4 = (f32x4*)(US + ((size_t)(dir * 512 + gb) * 4 + head) * 16384); const float* dc = DEC + ((size_t)(dir * 512 + gb) * 4 + head) * 128;
#pragma unroll
            for (int j = 0; j < 8; ++j) { const int i4 = tid + 512 * j; const f32x4 u = U4[i4]; const float dd = dc[i4 >> 5]; U4[i4] = S[j]; S[j] = S[j] * dd + u; } }
        f32x4* O4 = (f32x4*)(a.out + OUT_ST + ((((size_t)b * 2 + l) * 2 + dir) * 4 + head) * 16384);
#pragma unroll
        for (int j = 0; j < 8; ++j) O4[tid + 512 * j] = S[j];
    }
    for (int item = vcu; item < 256; item += G) {
        const int combo = item >> 4, part = item & 15, b2 = combo >> 3, dir = (combo >> 2) & 1, head = combo & 3;
        const int flat = part * 1024 + tid * 2, d = flat >> 7;
        f32x2 S = *(const f32x2*)(a.in[I_ST] + ((((size_t)b2 * 2 + l) * 2 + dir) * 4 + head) * 16384 + flat);
        const int gb0 = 256 + b2 * 128;
#pragma unroll 8
        for (int i = 0; i < 128; ++i) { const int cc = dir ? 127 - i : i, gb = gb0 + cc;
            f32x2* U2 = (f32x2*)(US + ((size_t)(dir * 512 + gb) * 4 + head) * 16384 + flat);
            const float dd = DEC[((size_t)(dir * 512 + gb) * 4 + head) * 128 + d];
            const f32x2 u = *U2; *U2 = S; S = S * dd + u; }
    }
}

__device__ __forceinline__ void phase_hgrn_c(const Args& a, LAS unsigned char* lds, int l, int vcu, int G) {
    int tid_ = threadIdx.x; asm volatile("" : "+v"(tid_)); const int tid = tid_, lane = tid & 63, wave = tid >> 6, fr = lane & 15, fq = lane >> 4;
    const float* Z = (const float*)(a.ws + WS_Z); const float* US = (const float*)(a.ws + WS_US); bf16* MIX = (bf16*)(a.ws + WS_MIX);
    constexpr int QP = 272;
    constexpr int O_QX = 0, O_KX = 17408, O_VT = 34816, O_ST = 45056, O_AM = 110592, O_ER = 115712, O_RED = 116736;
    LAS unsigned char* QX = lds + O_QX;
    LAS unsigned char* KX = lds + O_KX;
    LAS unsigned char* VT = lds + O_VT;
    LAS unsigned char* ST = lds + O_ST;
    LAS unsigned char* AM = lds + O_AM;
    LAS float* ER = (LAS float*)(lds + O_ER);
    LAS float* RED = (LAS float*)(lds + O_RED);
    for (int item = vcu; item < 2048; item += G) {
        const int gb = item >> 2, head = item & 3, row0 = gb * 32;
        if (tid < 256) {
            const int dir = tid >> 7, d = tid & 127;
            const int zcol = (dir ? ZRB : ZRF) + head * 128 + d;
            const float lb = lb_val(a, l, dir, head * 128 + d);
            float kk[32], cum[32]; float run = 0.f;
#pragma unroll
            for (int i = 0; i < 32; ++i) { const int p = dir ? 31 - i : i; float k, lf; gate_fn(Z[(size_t)(row0 + p) * INC + zcol], lb, k, lf); run += lf; kk[i] = k; cum[i] = run; }
            const float ref = cum[15];
#pragma unroll
            for (int i = 0; i < 32; ++i) { const int p = dir ? 31 - i : i; const float q = Z[(size_t)(row0 + p) * INC + ZRQ + head * 128 + d];
                *(LAS bf16*)(QX + (dir * 32 + p) * QP + d * 2) = f2bf(q * expf(cum[i] - ref));
                *(LAS bf16*)(KX + (dir * 32 + p) * QP + d * 2) = f2bf(kk[i] * expf(ref - cum[i])); }
            ER[dir * 128 + d] = expf(ref);
        } else {
            const int t2 = tid - 256, e = t2 & 127, ph = t2 >> 7;
#pragma unroll
            for (int i = 0; i < 16; i += 2) { const int p = ph * 16 + i;
                const float v0 = Z[(size_t)(row0 + p) * INC + ZRI + head * 128 + e], v1 = Z[(size_t)(row0 + p + 1) * INC + ZRI + head * 128 + e];
                *(LAS unsigned*)(VT + e * 80 + p * 2) = pk2(v0, v1); }
        }
        __syncthreads();
#pragma unroll
        for (int dir = 0; dir < 2; ++dir) {
            const float* Sg = US + ((size_t)(dir * 512 + gb) * 4 + head) * 16384;
#pragma unroll 4
            for (int it = 0; it < 16; ++it) { const int pi = wave * 16 + it, eb = pi & 7, c = pi >> 3, e = eb * 16 + fr, d0 = 8 * c + 2 * fq;
                const float s0 = Sg[d0 * 128 + e] * ER[dir * 128 + d0], s1 = Sg[(d0 + 1) * 128 + e] * ER[dir * 128 + d0 + 1];
                *(LAS unsigned*)(ST + dir * 32768 + e * 256 + ((c ^ (e & 15)) * 16) + fq * 4) = pk2(s0, s1); }
        }
        {
            const int dir = wave >> 2, mt = (wave >> 1) & 1, nt = wave & 1;
            f32x4 acc = {0.f, 0.f, 0.f, 0.f};
#pragma unroll
            for (int kt = 0; kt < 4; ++kt) {
                const bf16x8 af = *(const LAS bf16x8*)(QX + (dir * 32 + mt * 16 + fr) * QP + kt * 64 + fq * 16);
                const bf16x8 bfv = *(const LAS bf16x8*)(KX + (dir * 32 + nt * 16 + fr) * QP + kt * 64 + fq * 16);
                acc = __builtin_amdgcn_mfma_f32_16x16x32_bf16(af, bfv, acc, 0, 0, 0); }
#pragma unroll
            for (int i = 0; i < 4; ++i) { const int p = mt * 16 + 4 * fq + i, pp = nt * 16 + fr; const bool keep = dir ? (pp >= p) : (pp <= p);
                *(LAS bf16*)(AM + (dir * 32 + p) * 80 + pp * 2) = f2bf(keep ? acc[i] : 0.f); }
        }
        __syncthreads();
        f32x4 o[2];
#pragma unroll
        for (int mt = 0; mt < 2; ++mt) { o[mt] = (f32x4){0.f, 0.f, 0.f, 0.f};
#pragma unroll
            for (int dir = 0; dir < 2; ++dir) {
#pragma unroll
                for (int kt = 0; kt < 4; ++kt) {
                    const bf16x8 af = *(const LAS bf16x8*)(QX + (dir * 32 + mt * 16 + fr) * QP + kt * 64 + fq * 16);
                    const bf16x8 bfv = *(const LAS bf16x8*)(ST + dir * 32768 + (wave * 16 + fr) * 256 + (((4 * kt + fq) ^ fr) * 16));
                    o[mt] = __builtin_amdgcn_mfma_f32_16x16x32_bf16(af, bfv, o[mt], 0, 0, 0); }
                const bf16x8 af = *(const LAS bf16x8*)(AM + (dir * 32 + mt * 16 + fr) * 80 + fq * 16);
                const bf16x8 bfv = *(const LAS bf16x8*)(VT + (wave * 16 + fr) * 80 + fq * 16);
                o[mt] = __builtin_amdgcn_mfma_f32_16x16x32_bf16(af, bfv, o[mt], 0, 0, 0);
            } }
#pragma unroll
        for (int mt = 0; mt < 2; ++mt)
#pragma unroll
            for (int i = 0; i < 4; ++i) { float ss = o[mt][i] * o[mt][i]; ss += __shfl_xor(ss, 1); ss += __shfl_xor(ss, 2); ss += __shfl_xor(ss, 4); ss += __shfl_xor(ss, 8);
                if (fr == 0) RED[wave * 32 + mt * 16 + 4 * fq + i] = ss; }
        __syncthreads();
        const int e = wave * 16 + fr; const float gn = a.in[I_RG][(size_t)(l * 4 + head) * 128 + e];
#pragma unroll
        for (int mt = 0; mt < 2; ++mt)
#pragma unroll
            for (int i = 0; i < 4; ++i) { const int p = mt * 16 + 4 * fq + i; float ss = 0.f;
#pragma unroll
                for (int wv = 0; wv < 8; ++wv) ss += RED[wv * 32 + p];
                const float rstd = 1.0f / sqrtf(ss * (1.f / 128.f) + EPS);
                const float rg = Z[(size_t)(row0 + p) * INC + ZRG + head * 128 + e];
                MIX[(size_t)(row0 + p) * DM + 1024 + head * 128 + e] = f2bf(o[mt][i] * rstd * gn * siluf(rg)); }
        __syncthreads();
    }
}

constexpr int N_PHASES = 25;
enum { K_ALL = 0, K_P0, K_NORM, K_FFI, K_FFO, K_WIN, K_MIXA, K_MIXB, K_MIXC, K_WOUT };
template <int KIND>
__global__ void __launch_bounds__(512, 2) mega_fwd(Args args) {
    extern __shared__ __attribute__((aligned(16))) unsigned char lds_raw[];
    LAS unsigned char* lds = (LAS unsigned char*)lds_raw;
    const int tid = threadIdx.x;
    const int G = gridDim.x; const int bx = blockIdx.x; const int vcu = (G % 8 == 0) ? (bx % 8) * (G / 8) + bx / 8 : bx;
    for (int u = tid; u < (LDS_BYTES - LDSCTL_OFF) / 4; u += 512) ((LAS unsigned*)(lds + LDSCTL_OFF))[u] = 0u;
    __syncthreads();
    const int lo = args.ph_lo, hi = args.ph_hi;
    XcdBarrier bar; bar.bar = (unsigned*)(args.ws + WS_CTL) + CW_BAR; bar.x = 0; bar.st = nullptr;
    if (hi - lo > 1) bar = xcd_barrier_post((unsigned*)(args.ws + WS_CTL) + CW_BAR, (volatile LAS unsigned*)(lds + LDSCTL_OFF + 64));
#define IN(k) (lo <= (k) && (k) < hi)
#define HAS(kind) (KIND == K_ALL || KIND == (kind))
#define SEAM(k) do { if (IN(k) && IN((k) + 1)) xcd_barrier(bar); } while (0)
    unsigned char* ws = args.ws;
    float* X = args.out;
    const float* mod = (const float*)(ws + WS_MOD);

    if (HAS(K_P0) && IN(0)) { phase_p0(args, lds, vcu, G); SEAM(0); }

    for (int l = 0; l < 2; ++l) {
        const int pb = 1 + 12 * l;
        const float* bada = args.in[I_BADA] + (size_t)l * MODW;
        if (HAS(K_NORM) && IN(pb + 0)) { phase_norm(args, l, 0, vcu, G); SEAM(pb + 0); }
        if (HAS(K_FFI) && IN(pb + 1)) {
            pg8::Gemm g{(const bf16*)(ws + WS_H), (const bf16*)(ws + WS_WFI) + (size_t)(l * 2 + 0) * NFF2 * DM, NTOK, NFF2, DM}; pg8::StaticOrder S; S.init(NTOK, NFF2, G, bx);
            pg8::EpiSwiGLU E{(bf16*)(ws + WS_Z), DFF};
            pg8::gemm_phase<pg8::EpiSwiGLU, pg8::StaticOrder, true, true>(lds, g, S, E);
            SEAM(pb + 1);
        }
        if (HAS(K_FFO) && IN(pb + 2)) {
            pg8::Gemm g{(const bf16*)(ws + WS_Z), (const bf16*)(ws + WS_WFO) + (size_t)(l * 2 + 0) * DM * DFF, NTOK, DM, DFF}; pg8::StaticOrder S; S.init(NTOK, DM, G, bx);
            pg8::EpiResid E{X, mod + (size_t)l * MODW + 2 * DM, bada + 2 * DM, 0.5f};
            pg8::gemm_phase<pg8::EpiResid, pg8::StaticOrder, true, true>(lds, g, S, E);
            SEAM(pb + 2);
        }
        if (HAS(K_NORM) && IN(pb + 3)) { phase_norm(args, l, 1, vcu, G); SEAM(pb + 3); }
        if (HAS(K_WIN) && IN(pb + 4)) {
            pg8::Gemm g{(const bf16*)(ws + WS_H), (const bf16*)(ws + WS_WIN) + (size_t)l * INC * DM, NTOK, INC, DM}; pg8::StaticOrder S; S.init(NTOK, INC, G, bx);
            pg8::EpiF32 E{(float*)(ws + WS_Z), INC};
            pg8::gemm_phase<pg8::EpiF32, pg8::StaticOrder, true, true>(lds, g, S, E);
            SEAM(pb + 4);
        }
        if (HAS(K_MIXA) && IN(pb + 5)) {
#ifndef NO_PREP
            phase_prep(args, l, vcu, G);
#endif
#ifndef NO_HGRNA
            phase_hgrn_a(args, lds, l, vcu, G);
#endif
#ifndef NO_CONV
            phase_conv(args, lds, l, vcu, G);
#endif
            SEAM(pb + 5); }
        if (HAS(K_MIXB) && IN(pb + 6)) {
#ifndef NO_ATTN
            phase_attn(args, lds_raw, l, vcu, G);
#endif
#ifndef NO_HGRNB
            phase_hgrn_b(args, l, vcu, G);
#endif
            SEAM(pb + 6); }
        if (HAS(K_MIXC) && IN(pb + 7)) { phase_hgrn_c(args, lds, l, vcu, G); SEAM(pb + 7); }
        if (HAS(K_WOUT) && IN(pb + 8)) {
            pg8::Gemm g{(const bf16*)(ws + WS_MIX), (const bf16*)(ws + WS_WOUT) + (size_t)l * DM * DM, NTOK, DM, DM}; pg8::StaticOrder S; S.init(NTOK, DM, G, bx);
            pg8::EpiResid E{X, mod + (size_t)l * MODW + 5 * DM, bada + 5 * DM, 1.0f};
            pg8::gemm_phase<pg8::EpiResid, pg8::StaticOrder, true, true>(lds, g, S, E);
            SEAM(pb + 8);
        }
        if (HAS(K_NORM) && IN(pb + 9)) { phase_norm(args, l, 2, vcu, G); SEAM(pb + 9); }
        if (HAS(K_FFI) && IN(pb + 10)) {
            pg8::Gemm g{(const bf16*)(ws + WS_H), (const bf16*)(ws + WS_WFI) + (size_t)(l * 2 + 1) * NFF2 * DM, NTOK, NFF2, DM}; pg8::StaticOrder S; S.init(NTOK, NFF2, G, bx);
            pg8::EpiSwiGLU E{(bf16*)(ws + WS_Z), DFF};
            pg8::gemm_phase<pg8::EpiSwiGLU, pg8::StaticOrder, true, true>(lds, g, S, E);
            SEAM(pb + 10);
        }
        if (HAS(K_FFO) && IN(pb + 11)) {
            pg8::Gemm g{(const bf16*)(ws + WS_Z), (const bf16*)(ws + WS_WFO) + (size_t)(l * 2 + 1) * DM * DFF, NTOK, DM, DFF}; pg8::StaticOrder S; S.init(NTOK, DM, G, bx);
            pg8::EpiResid E{X, mod + (size_t)l * MODW + 8 * DM, bada + 8 * DM, 0.5f};
            pg8::gemm_phase<pg8::EpiResid, pg8::StaticOrder, true, true>(lds, g, S, E);
            SEAM(pb + 11);
        }
    }
#undef IN
#undef HAS
#undef SEAM
}

extern "C" void kernel_launch(void* const* d_in, const int* in_sizes, int n_in, void* d_out, int out_size, void* d_ws, size_t ws_size, hipStream_t stream) {
    static int grid = 0;
    if (grid == 0) {
        if (n_in != 23 || (size_t)out_size != OUT_TOTAL || ws_size < WS_END) { fprintf(stderr, "kernel_launch: shape mismatch: n_in %d out %d ws %zu (need >= %zu); nothing launched\n", n_in, out_size, ws_size, (size_t)WS_END); grid = -1; return; }
        int dev = 0, cus = 0, per_cu = 0;
        if (hipGetDevice(&dev) != hipSuccess || hipDeviceGetAttribute(&cus, hipDeviceAttributeMultiprocessorCount, dev) != hipSuccess) { grid = -1; return; }
#if MK_N_LAUNCHES == 1
        const void* fns[1] = {(const void*)mega_fwd<K_ALL>};
#else
        const void* fns[9] = {(const void*)mega_fwd<K_P0>, (const void*)mega_fwd<K_NORM>, (const void*)mega_fwd<K_FFI>, (const void*)mega_fwd<K_FFO>, (const void*)mega_fwd<K_WIN>,
                              (const void*)mega_fwd<K_MIXA>, (const void*)mega_fwd<K_MIXB>, (const void*)mega_fwd<K_MIXC>, (const void*)mega_fwd<K_WOUT>};
#endif
        for (const void* f : fns) {
            if (hipFuncSetAttribute(f, hipFuncAttributeMaxDynamicSharedMemorySize, LDS_BYTES) != hipSuccess) { fprintf(stderr, "kernel_launch: hipFuncSetAttribute failed\n"); grid = -1; return; }
            if (hipOccupancyMaxActiveBlocksPerMultiprocessor(&per_cu, f, 512, LDS_BYTES) != hipSuccess || per_cu < 1) { fprintf(stderr, "kernel_launch: occupancy query says %d\n", per_cu); }
        }
        (void)hipGetLastError();
        grid = cus;
    }
    if (grid < 0) return;
    (void)hipMemsetAsync((char*)d_ws + WS_CTL, 0, CTL_ZERO_BYTES, stream);
    Args a{};
    for (int i = 0; i < 23; ++i) a.in[i] = (const float*)d_in[i];
    a.out = (float*)d_out; a.ws = (unsigned char*)d_ws;
#if MK_N_LAUNCHES == 1
    a.ph_lo = 0; a.ph_hi = N_PHASES;
    hipLaunchKernelGGL(mega_fwd<K_ALL>, dim3(grid), dim3(512), LDS_BYTES, stream, a);
#else
    static const int kind_of[12] = {K_NORM, K_FFI, K_FFO, K_NORM, K_WIN, K_MIXA, K_MIXB, K_MIXC, K_WOUT, K_NORM, K_FFI, K_FFO};
    for (int p = 0; p < N_PHASES; ++p) { a.ph_lo = p; a.ph_hi = p + 1; const int kind = p == 0 ? K_P0 : kind_of[(p - 1) % 12];
        switch (kind) {
            case K_P0:   hipLaunchKernelGGL(mega_fwd<K_P0>,   dim3(grid), dim3(512), LDS_BYTES, stream, a); break;
            case K_NORM: hipLaunchKernelGGL(mega_fwd<K_NORM>, dim3(grid), dim3(512), LDS_BYTES, stream, a); break;
            case K_FFI:  hipLaunchKernelGGL(mega_fwd<K_FFI>,  dim3(grid), dim3(512), LDS_BYTES, stream, a); break;
            case K_FFO:  hipLaunchKernelGGL(mega_fwd<K_FFO>,  dim3(grid), dim3(512), LDS_BYTES, stream, a); break;
            case K_WIN:  hipLaunchKernelGGL(mega_fwd<K_WIN>,  dim3(grid), dim3(512), LDS_BYTES, stream, a); break;
            case K_MIXA: hipLaunchKernelGGL(mega_fwd<K_MIXA>, dim3(grid), dim3(512), LDS_BYTES, stream, a); break;
            case K_MIXB: hipLaunchKernelGGL(mega_fwd<K_MIXB>, dim3(grid), dim3(512), LDS_BYTES, stream, a); break;
            case K_MIXC: hipLaunchKernelGGL(mega_fwd<K_MIXC>, dim3(grid), dim3(512), LDS_BYTES, stream, a); break;
            default:     hipLaunchKernelGGL(mega_fwd<K_WOUT>, dim3(grid), dim3(512), LDS_BYTES, stream, a); break;
        }
    }
#endif
}
```

```cpp
#include <hip/hip_runtime.h>
#include <cstdio>
#include <cstdint>
#ifndef MK_N_LAUNCHES
#define MK_N_LAUNCHES 1
#endif
namespace pg8 {
#define PG8_LAS __attribute__((address_space(3)))
typedef unsigned short bf16_t;
typedef short bf16x8 __attribute__((ext_vector_type(8)));
typedef float f32x4 __attribute__((ext_vector_type(4)));
typedef unsigned u32x4 __attribute__((ext_vector_type(4)));
constexpr int BM = 256, BK = 64, HALF = 128, HTB = HALF * BK * 2  , STAGE_BYTES = 8 * HTB, NXCD = 8, WGM = 8;

__host__ __device__ __forceinline__ int lds_byte(int r, int c) { const int st = (r >> 4) * 2 + (c >> 5), rr = r & 15, cc = c & 31, ob = rr * 64 + cc * 2; return st * 1024 + (ob ^ (((ob >> 9) & 1) << 5)); }
__host__ __device__ __forceinline__ void stage_rc(int b, int& R, int& C) { const int st = b / 1024, sb = b % 1024, swz = sb ^ (((sb >> 9) & 1) << 5); R = (st >> 1) * 16 + swz / 64; C = (st & 1) * 32 + (swz % 64) / 2; }
__host__ __device__ __forceinline__ int perm32(int rho) { const int n = rho >> 4, i = rho & 15; return 8 * (i >> 2) + 4 * n + (i & 3); }

struct Unit { int pm, pn; };
struct Gemm { const bf16_t* A; const bf16_t* Bt; int M, N, K; };

struct StaticOrder {
    int nM, nN, nwg, G, c;
    __host__ __device__ void init(int M, int N, int G_, int c_) { nM = M / BM; nN = N / BM; nwg = nM * nN; G = G_; c = c_; }
    __host__ __device__ bool next(int i, Unit& u) const {
        const long L = (long)i * G + c; if (L >= nwg) return false;
        int wgid = (int)L; { const int q = nwg / NXCD, r = nwg % NXCD, xcd = wgid % NXCD, off = wgid / NXCD; wgid = (xcd < r ? xcd * (q + 1) : r * (q + 1) + (xcd - r) * q) + off; }
        const int nig = WGM * nN, gid = wgid / nig, fm = gid * WGM, gsz = (nM - fm) < WGM ? (nM - fm) : WGM;
        u.pm = fm + ((wgid % nig) % gsz); u.pn = (wgid % nig) / gsz; return true;
    }
    __device__ __forceinline__ void a_ready(const Unit&) const {}
    __device__ __forceinline__ void done(const Unit&) const {}
};
__device__ __forceinline__ unsigned cvt_pk_bf16(float lo, float hi) { unsigned r; asm volatile("v_cvt_pk_bf16_f32 %0, %1, %2" : "=v"(r) : "v"(lo), "v"(hi)); return r; }
template <class Epi, class Sched, bool ALIGN_EPI = false, bool SP2 = false>
__device__ __forceinline__ void gemm_phase(PG8_LAS unsigned char* lds, const Gemm g, const Sched& S, const Epi& E) {
    int tid_ = threadIdx.x; asm volatile("" : "+v"(tid_)); const int tid = tid_, wid = __builtin_amdgcn_readfirstlane(tid >> 6), lane = tid & 63, wr = wid >> 2, wc = wid & 3, fr = lane & 15, fq = lane >> 4;
    const int K = g.K, nt = K / BK;
    unsigned voffA[2], voffB[2];
#pragma unroll
    for (int i = 0; i < 2; ++i) { int R, C; stage_rc(tid * 16 + i * 8192, R, C); const int Rb = Epi::PERM ? ((R & ~31) + perm32(R & 31)) : R;
        voffA[i] = (unsigned)(R * K + C) * 2u; voffB[i] = (unsigned)(Rb * K + C) * 2u; }
    const size_t kstep = (size_t)(BK * 2);
    const size_t hstep = (size_t)HALF * K * 2;
    const size_t tstep = 2 * hstep;
    const unsigned ldsw = (unsigned)wid * 1024u;
    const int aoff = lds_byte(wr * 64 + fr, fq * 8), boff = lds_byte(wc * 32 + fr, fq * 8);
#define PG8_SA(b, h) (((b) * 2 + (h)) * HTB)
#define PG8_SB(b, h) ((4 + (b) * 2 + (h)) * HTB)
#define PG8_STAGE(bufoff, gbase, voff) do { _Pragma("unroll") for (int _i = 0; _i < 2; ++_i) \
        __builtin_amdgcn_global_load_lds((const unsigned*)((const char*)(gbase) + (voff)[_i]), (PG8_LAS unsigned*)(lds + (bufoff) + ldsw + _i * 8192), 16, 0, 0); } while (0)
#define PG8_LDA(dst, b, h) do { _Pragma("unroll") for (int m = 0; m < 4; ++m) _Pragma("unroll") for (int k = 0; k < 2; ++k) dst[m][k] = *(const PG8_LAS bf16x8*)(lds + PG8_SA(b, h) + aoff + m * 2048 + k * 1024); } while (0)
#define PG8_LDB(dst, b, h) do { _Pragma("unroll") for (int n = 0; n < 2; ++n) _Pragma("unroll") for (int k = 0; k < 2; ++k) dst[n][k] = *(const PG8_LAS bf16x8*)(lds + PG8_SB(b, h) + boff + n * 2048 + k * 1024); } while (0)
#define PG8_MMA(ai, bj, At, Bt) do { __builtin_amdgcn_s_setprio(1); _Pragma("unroll") for (int m = 0; m < 4; ++m) _Pragma("unroll") for (int n = 0; n < 2; ++n) _Pragma("unroll") for (int k = 0; k < 2; ++k) \
        acc[ai][bj][m][n] = __builtin_amdgcn_mfma_f32_16x16x32_bf16(Bt[n][k], At[m][k], acc[ai][bj][m][n], 0, 0, 0); __builtin_amdgcn_s_setprio(0); } while (0)
#define PG8_WAIT_V(n) asm volatile("s_waitcnt vmcnt(" #n ")" ::: "memory")
#define PG8_WAIT_L(n) asm volatile("s_waitcnt lgkmcnt(" #n ")" ::: "memory")
#define PG8_BAR __builtin_amdgcn_s_barrier()
#define PG8_SCHED __builtin_amdgcn_sched_barrier(0)
    Unit cur, nxt; int ui = 0;
    if (!S.next(0, cur)) return;
    f32x4 acc[2][2][4][2];
#pragma unroll
    for (int a = 0; a < 2; ++a)
#pragma unroll
        for (int b = 0; b < 2; ++b)
#pragma unroll
            for (int m = 0; m < 4; ++m)
#pragma unroll
                for (int n = 0; n < 2; ++n) acc[a][b][m][n] = (f32x4){0.f, 0.f, 0.f, 0.f};
    bf16x8 At[4][2], B0[2][2], B1[2][2];
    const char* cA = (const char*)g.A + (size_t)cur.pm * tstep; const char* cB = (const char*)g.Bt + (size_t)cur.pn * tstep;
    S.a_ready(cur);
    if constexpr (SP2) {
        PG8_STAGE(PG8_SB(0, 0), cB, voffB); PG8_STAGE(PG8_SB(0, 1), cB + hstep, voffB); PG8_STAGE(PG8_SA(0, 0), cA, voffA); PG8_STAGE(PG8_SA(0, 1), cA + hstep, voffA);
        if (wr == 1) PG8_BAR;
        PG8_WAIT_V(2); PG8_BAR;
        PG8_STAGE(PG8_SB(1, 0), cB + kstep, voffB); PG8_STAGE(PG8_SA(1, 0), cA + kstep, voffA); PG8_STAGE(PG8_SB(1, 1), cB + hstep + kstep, voffB);
        PG8_WAIT_V(6); PG8_BAR;
    } else {
        PG8_STAGE(PG8_SB(0, 0), cB, voffB); PG8_STAGE(PG8_SA(0, 0), cA, voffA); PG8_STAGE(PG8_SB(0, 1), cB + hstep, voffB); PG8_STAGE(PG8_SA(0, 1), cA + hstep, voffA);
        if (wr == 1) PG8_BAR;
        PG8_WAIT_V(4); PG8_BAR;
        PG8_STAGE(PG8_SB(1, 0), cB + kstep, voffB); PG8_STAGE(PG8_SA(1, 0), cA + kstep, voffA); PG8_STAGE(PG8_SB(1, 1), cB + hstep + kstep, voffB);
        PG8_WAIT_V(6); PG8_BAR;
    }
    for (;;) {
        const bool has_next = S.next(ui + 1, nxt);
        const char* nA = has_next ? (const char*)g.A + (size_t)nxt.pm * tstep : cA; const char* nB = has_next ? (const char*)g.Bt + (size_t)nxt.pn * tstep : cB;
        for (int t = 0; t < nt; t += 2) {
            const bool last = (t == nt - 2);
            const char* a1 = cA + (size_t)(t + 1) * kstep;
            const char* a2 = last ? nA : cA + (size_t)(t + 2) * kstep; const char* b2 = last ? nB : cB + (size_t)(t + 2) * kstep;
            const char* a3 = a2 + kstep; const char* b3 = b2 + kstep;
            if (last && has_next) S.a_ready(nxt);
            if constexpr (SP2) {
            PG8_LDB(B0, 0, 0); PG8_LDB(B1, 0, 1); PG8_SCHED; PG8_LDA(At, 0, 0); PG8_STAGE(PG8_SA(1, 1), a1 + hstep, voffA);
            PG8_WAIT_V(8); PG8_WAIT_L(0); PG8_BAR; PG8_MMA(0, 0, At, B0); PG8_MMA(0, 1, At, B1); PG8_BAR; PG8_SCHED;
            PG8_LDA(At, 0, 1); PG8_STAGE(PG8_SB(0, 0), b2, voffB); PG8_STAGE(PG8_SB(0, 1), b2 + hstep, voffB); PG8_STAGE(PG8_SA(0, 0), a2, voffA);
            PG8_WAIT_V(8); PG8_WAIT_L(0); PG8_BAR; PG8_MMA(1, 0, At, B0); PG8_MMA(1, 1, At, B1); PG8_BAR; PG8_SCHED;
            PG8_LDB(B0, 1, 0); PG8_LDB(B1, 1, 1); PG8_SCHED; PG8_LDA(At, 1, 0); PG8_STAGE(PG8_SA(0, 1), a2 + hstep, voffA);
            PG8_WAIT_V(8); PG8_WAIT_L(0); PG8_BAR; PG8_MMA(0, 0, At, B0); PG8_MMA(0, 1, At, B1); PG8_BAR; PG8_SCHED;
            PG8_LDA(At, 1, 1); PG8_STAGE(PG8_SB(1, 0), b3, voffB); PG8_STAGE(PG8_SB(1, 1), b3 + hstep, voffB); PG8_STAGE(PG8_SA(1, 0), a3, voffA);
            PG8_WAIT_V(8); PG8_WAIT_L(0); PG8_BAR; PG8_MMA(1, 0, At, B0); PG8_MMA(1, 1, At, B1); PG8_BAR; PG8_SCHED;
            } else {
            PG8_LDB(B0, 0, 0); PG8_SCHED; PG8_LDA(At, 0, 0); PG8_STAGE(PG8_SA(1, 1), a1 + hstep, voffA);
            PG8_WAIT_L(8); PG8_BAR; PG8_WAIT_L(0); PG8_MMA(0, 0, At, B0); PG8_BAR; PG8_SCHED;
            PG8_LDB(B1, 0, 1); PG8_STAGE(PG8_SB(0, 0), b2, voffB);
            PG8_BAR; PG8_WAIT_L(0); PG8_MMA(0, 1, At, B1); PG8_BAR;
            PG8_LDA(At, 0, 1); PG8_STAGE(PG8_SA(0, 0), a2, voffA);
            PG8_BAR; PG8_WAIT_L(0); PG8_MMA(1, 0, At, B0); PG8_BAR; PG8_SCHED;
            PG8_STAGE(PG8_SB(0, 1), b2 + hstep, voffB);
            PG8_WAIT_V(6); PG8_BAR; PG8_MMA(1, 1, At, B1); PG8_BAR;
            PG8_LDB(B0, 1, 0); PG8_SCHED; PG8_LDA(At, 1, 0); PG8_STAGE(PG8_SA(0, 1), a2 + hstep, voffA);
            PG8_WAIT_L(8); PG8_BAR; PG8_WAIT_L(0); PG8_MMA(0, 0, At, B0); PG8_BAR; PG8_SCHED;
            PG8_LDB(B1, 1, 1); PG8_STAGE(PG8_SB(1, 0), b3, voffB);
            PG8_BAR; PG8_WAIT_L(0); PG8_MMA(0, 1, At, B1); PG8_BAR;
            PG8_LDA(At, 1, 1); PG8_STAGE(PG8_SA(1, 0), a3, voffA);
            PG8_BAR; PG8_WAIT_L(0); PG8_MMA(1, 0, At, B0); PG8_BAR; PG8_SCHED;
            PG8_STAGE(PG8_SB(1, 1), b3 + hstep, voffB);
            PG8_WAIT_V(6); PG8_BAR; PG8_MMA(1, 1, At, B1); PG8_BAR;
            }
        }
        if constexpr (ALIGN_EPI) { if (wr == 0) PG8_BAR; }
        if constexpr (!Epi::AFTER_DRAIN) { E(acc, cur, wr, wc, fr, fq); S.done(cur); }
        if (!has_next) break;
#pragma unroll
        for (int a = 0; a < 2; ++a)
#pragma unroll
            for (int b = 0; b < 2; ++b)
#pragma unroll
                for (int m = 0; m < 4; ++m)
#pragma unroll
                    for (int n = 0; n < 2; ++n) acc[a][b][m][n] = (f32x4){0.f, 0.f, 0.f, 0.f};
        cur = nxt; cA = nA; cB = nB; ++ui;
        if constexpr (ALIGN_EPI) { if (wr == 1) PG8_BAR; }
    }
    PG8_WAIT_V(0);
    if constexpr (!ALIGN_EPI) { if (wr == 0) PG8_BAR; }
    PG8_BAR;
    if constexpr (Epi::AFTER_DRAIN) { E.fused(acc, cur, wr, wc, fr, fq, lds, wid, lane); S.done(cur); }
#undef PG8_SA
#undef PG8_SB
#undef PG8_STAGE
#undef PG8_LDA
#undef PG8_LDB
#undef PG8_MMA
#undef PG8_WAIT_V
#undef PG8_WAIT_L
#undef PG8_BAR
#undef PG8_SCHED
}
}
#ifndef PROBE_DUP
#define PROBE_DUP 0
#endif
#define REP(k) (PROBE_DUP == (k) ? 2 : 1)

constexpr int DM = 2048, NTOK = 16384, NCTX = 8192, CTX_T = 256, LAT_T = 4096, PAST = 512;
constexpr int DFF = 5632, NFF2 = 11264, INC = 5120, MODW = 18432;
constexpr int ZQ = 0, ZK = 1024, ZV = 1280, ZRQ = 1536, ZRF = 2048, ZRB = 2560, ZRI = 3072, ZRG = 3584, ZCA = 4096, ZCB = 4608;
constexpr float EPS = 1e-6f;
constexpr size_t OUT_Y = 0, OUT_CK = 33554432, OUT_CV = 37748736, OUT_ST = 41943040, OUT_TOTAL = 50331648;
constexpr size_t MiB = 1u << 20;
constexpr size_t WS_CTL = 0, WS_MOD = 1 * MiB, CTL_ZERO_BYTES = 2 * MiB;
constexpr size_t WS_WFI = 2 * MiB;
constexpr size_t WS_WFO = 178 * MiB;
constexpr size_t WS_WIN = 266 * MiB;
constexpr size_t WS_WOUT = 306 * MiB;
constexpr size_t WS_H = 322 * MiB;
constexpr size_t WS_MIX = 386 * MiB;
constexpr size_t WS_Z = 450 * MiB;
constexpr size_t WS_US = 770 * MiB;
constexpr size_t WS_DEC = 1026 * MiB;
constexpr size_t WS_Q = 1028 * MiB;
constexpr size_t WS_K = 1060 * MiB;
constexpr size_t WS_V = 1068 * MiB;
constexpr size_t WS_CK = 1076 * MiB;
constexpr size_t WS_CV = 1077 * MiB;
constexpr size_t WS_GLU = 1078 * MiB;
constexpr size_t WS_ST16 = 1110 * MiB;
constexpr size_t WS_END = 1238 * MiB;
constexpr size_t WS_LBV = WS_MOD + 512 * 1024;
constexpr int CW_BAR = 4096;
constexpr int RING_BYTES = 131072, LDSCTL_OFF = RING_BYTES, LDS_BYTES = 147456;

#define GAS __attribute__((address_space(1)))
#define LAS __attribute__((address_space(3)))
typedef unsigned short bf16;
typedef unsigned v4u __attribute__((ext_vector_type(4)));
typedef unsigned v2u __attribute__((ext_vector_type(2)));
typedef float f32x4 __attribute__((ext_vector_type(4)));
typedef float f32x2 __attribute__((ext_vector_type(2)));
typedef short bf16x8 __attribute__((ext_vector_type(8)));
#define LDS_WAIT() asm volatile("s_waitcnt lgkmcnt(0)" ::: "memory")
#define VM_WAIT() asm volatile("s_waitcnt vmcnt(0)" ::: "memory")
__device__ __forceinline__ unsigned pk2(float lo, float hi) { return pg8::cvt_pk_bf16(lo, hi); }
__device__ __forceinline__ unsigned short f2bf(float f) { return (unsigned short)(pg8::cvt_pk_bf16(f, 0.f) & 0xffffu); }
__device__ __forceinline__ float sigm(float x) { return __builtin_amdgcn_rcpf(1.f + __expf(-x)); }
__device__ __forceinline__ float siluf(float x) { return x * __builtin_amdgcn_rcpf(1.f + __expf(-x)); }
__device__ __forceinline__ float wave_sum(float v) {
#pragma unroll
    for (int o = 1; o < 64; o <<= 1) v += __shfl_xor(v, o);
    return v;
}

namespace pg8 {
struct EpiF32 {
    static constexpr bool PERM = false, AFTER_DRAIN = false;
    float* C; int ldc;
    __device__ __forceinline__ void operator()(const f32x4 (&acc)[2][2][4][2], const Unit& u, int wr, int wc, int fr, int fq) const {
        const int row0 = u.pm * BM + wr * 64 + fr, col0 = u.pn * BM + wc * 32 + 4 * fq;
#pragma unroll
        for (int ai = 0; ai < 2; ++ai)
#pragma unroll
            for (int m = 0; m < 4; ++m) { float* rowp = C + (size_t)(row0 + ai * HALF + m * 16) * ldc + col0;
#pragma unroll
                for (int bj = 0; bj < 2; ++bj)
#pragma unroll
                    for (int n = 0; n < 2; ++n) *(f32x4*)(rowp + bj * HALF + n * 16) = acc[ai][bj][m][n]; }
    }
};
struct EpiWin {
    static constexpr bool PERM = false, AFTER_DRAIN = false;
    float* Z; const float* lbv; float* GLU;
    __device__ __forceinline__ void operator()(const f32x4 (&acc)[2][2][4][2], const Unit& u, int wr, int wc, int fr, int fq) const {
        const int row0 = u.pm * BM + wr * 64 + fr, col0 = u.pn * BM + wc * 32 + 4 * fq;
        if (u.pn >= 8 && u.pn < 12) {
            f32x4 lb[2][2];
#pragma unroll
            for (int bj = 0; bj < 2; ++bj)
#pragma unroll
                for (int n = 0; n < 2; ++n) lb[bj][n] = *(const f32x4*)(lbv + (col0 - 2048) + bj * HALF + n * 16);
#pragma unroll
            for (int ai = 0; ai < 2; ++ai)
#pragma unroll
                for (int m = 0; m < 4; ++m) { float* rowp = Z + (size_t)(row0 + ai * HALF + m * 16) * 5120 + col0;
#pragma unroll
                    for (int bj = 0; bj < 2; ++bj)
#pragma unroll
                        for (int n = 0; n < 2; ++n) { f32x4 kv, lv;
#pragma unroll
                            for (int j = 0; j < 4; ++j) { const float z = fminf(fmaxf(acc[ai][bj][m][n][j], -80.f), 80.f), lbj = lb[bj][n][j], ez = __expf(-z);
                                const float sg = __builtin_amdgcn_rcpf(1.f + ez), sn = ez * sg;
                                kv[j] = (1.f - lbj) * sn; lv[j] = __logf(fmaxf(lbj + (1.f - lbj) * sg, 1e-30f)); }
                            *(f32x4*)(rowp + bj * HALF + n * 16) = kv; *(f32x4*)(rowp + 2048 + bj * HALF + n * 16) = lv; } }
        } else if (u.pn >= 16) {
            const int c0 = (u.pn - 16) * HALF + wc * 32 + 4 * fq;
#pragma unroll
            for (int ai = 0; ai < 2; ++ai)
#pragma unroll
                for (int m = 0; m < 4; ++m) { float* rowp = GLU + (size_t)(row0 + ai * HALF + m * 16) * 512 + c0;
#pragma unroll
                    for (int n = 0; n < 2; ++n) { f32x4 gv;
#pragma unroll
                        for (int j = 0; j < 4; ++j) { const float a = acc[ai][0][m][n][j], b = acc[ai][1][m][n][j]; gv[j] = a * __builtin_amdgcn_rcpf(1.f + __expf(-b)); }
                        *(f32x4*)(rowp + n * 16) = gv; } }
        } else {
#pragma unroll
            for (int ai = 0; ai < 2; ++ai)
#pragma unroll
                for (int m = 0; m < 4; ++m) { float* rowp = Z + (size_t)(row0 + ai * HALF + m * 16) * 5120 + col0;
#pragma unroll
                    for (int bj = 0; bj < 2; ++bj)
#pragma unroll
                        for (int n = 0; n < 2; ++n) *(f32x4*)(rowp + bj * HALF + n * 16) = acc[ai][bj][m][n]; }
        }
    }
};
struct EpiSwiGLU {
    static constexpr bool PERM = true, AFTER_DRAIN = false;
    bf16_t* O; int ldc;
    __device__ __forceinline__ void operator()(const f32x4 (&acc)[2][2][4][2], const Unit& u, int wr, int wc, int fr, int fq) const {
        const int row0 = u.pm * BM + wr * 64 + fr, col0 = u.pn * HALF + wc * 32 + 8 * fq;
#pragma unroll
        for (int ai = 0; ai < 2; ++ai)
#pragma unroll
            for (int m = 0; m < 4; ++m) { bf16_t* rowp = O + (size_t)(row0 + ai * HALF + m * 16) * ldc + col0;
                float v[8];
#pragma unroll
                for (int n = 0; n < 2; ++n)
#pragma unroll
                    for (int j = 0; j < 4; ++j) { const float a = acc[ai][0][m][n][j], b = acc[ai][1][m][n][j];
                        v[n * 4 + j] = a * __builtin_amdgcn_rcpf(1.f + __expf(-a)) * b; }
                u32x4 w; w.x = cvt_pk_bf16(v[0], v[1]); w.y = cvt_pk_bf16(v[2], v[3]); w.z = cvt_pk_bf16(v[4], v[5]); w.w = cvt_pk_bf16(v[6], v[7]);
                *(u32x4*)rowp = w; }
    }
};
struct EpiResid {
    static constexpr bool PERM = false, AFTER_DRAIN = false;
    float* X; const float* gm; const float* gb; float scale;
    __device__ __forceinline__ void operator()(const f32x4 (&acc)[2][2][4][2], const Unit& u, int wr, int wc, int fr, int fq) const {
        const int row0 = u.pm * BM + wr * 64 + fr, col0 = u.pn * BM + wc * 32 + 4 * fq;
        const int cond = u.pm < 32 ? 0 : 1 + ((u.pm - 32) >> 4);
        const float* g0 = gm + (size_t)cond * 2 * 18432;
        f32x4 gv[2][2];
#pragma unroll
        for (int bj = 0; bj < 2; ++bj)
#pragma unroll
            for (int n = 0; n < 2; ++n) gv[bj][n] = (*(const f32x4*)(g0 + col0 + bj * HALF + n * 16) + *(const f32x4*)(gb + col0 + bj * HALF + n * 16)) * scale;
#pragma unroll
        for (int ai = 0; ai < 2; ++ai)
#pragma unroll
            for (int m = 0; m < 4; ++m) { float* rowp = X + (size_t)(row0 + ai * HALF + m * 16) * 2048 + col0;
#pragma unroll
                for (int bj = 0; bj < 2; ++bj)
#pragma unroll
                    for (int n = 0; n < 2; ++n) { f32x4* p = (f32x4*)(rowp + bj * HALF + n * 16); *p = *p + gv[bj][n] * acc[ai][bj][m][n]; }
                asm volatile("" ::: "memory"); }
    }
};
}
#define XB_TMO      128
#define XB_XCNT(j)  (256  + 64 * (j))
#define XB_XSUB(j)  (1280 + 64 * (j))
#define XB_XGEN(j)  (2304 + 64 * (j))
#define XB_TOP      3328
#define XB_TOPGEN   3392
#define XCD_BAR_WORDS 3456
#define XB_SPIN_CAP (1u << 18)

__device__ __forceinline__ unsigned xb_ld(unsigned* p)              { return __hip_atomic_load(p, __ATOMIC_RELAXED, __HIP_MEMORY_SCOPE_AGENT); }
__device__ __forceinline__ unsigned xb_add(unsigned* p, unsigned v) { return __hip_atomic_fetch_add(p, v, __ATOMIC_RELAXED, __HIP_MEMORY_SCOPE_AGENT); }
__device__ __forceinline__ unsigned xb_xcc_id() { return (unsigned)__builtin_amdgcn_s_getreg((3 << 11) | 20) & 0xFu; }
#define XB_SPIN(cond, bar) do { unsigned _sp = 0; while (cond) { __builtin_amdgcn_s_sleep(1); \
    if ((++_sp & 255u) == 0u) { if (xb_ld(&(bar)[XB_TMO])) break; if (_sp > XB_SPIN_CAP) { atomicAdd(&(bar)[XB_TMO], 1u); break; } } } } while (0)

struct XcdBarrier {
    unsigned* bar; unsigned x;
    volatile LAS unsigned* st;
};

__device__ __forceinline__ XcdBarrier xcd_barrier_post(unsigned* bar, volatile LAS unsigned* st) {
    XcdBarrier b; b.bar = bar; b.x = xb_xcc_id(); b.st = st;
    if (threadIdx.x == 0) (void)xb_add(&bar[XB_XCNT(b.x)], 1u);
    return b;
}
__device__ __forceinline__ void xcd_barrier_complete(unsigned* bar, unsigned x, unsigned& nloc, unsigned& nx) {
    const unsigned G = gridDim.x * gridDim.y * gridDim.z;
    unsigned sum, cnt, mine, sp = 0u;
    for (;;) {
        sum = 0u; cnt = 0u; mine = 0u;
#pragma unroll
        for (unsigned j = 0; j < 16; ++j) { const unsigned c = xb_ld(&bar[XB_XCNT(j)]); sum += c; cnt += (c > 0u) ? 1u : 0u; mine = (j == x) ? c : mine; }
        if (sum == G) break;
        __builtin_amdgcn_s_sleep(1);
        if ((++sp & 255u) == 0u) { if (xb_ld(&bar[XB_TMO])) break; if (sp > XB_SPIN_CAP) { atomicAdd(&bar[XB_TMO], 1u); break; } }
    }
    nloc = mine > 0u ? mine : 1u; nx = cnt > 0u ? cnt : 1u;
}

__device__ __forceinline__ void xcd_barrier(const XcdBarrier& b) {
    asm volatile("s_waitcnt vmcnt(0)" ::: "memory");
    __syncthreads();
    if (threadIdx.x == 0) {
        unsigned* bar = b.bar;
        __builtin_amdgcn_s_waitcnt(0);
        unsigned nloc = b.st[0], nx = b.st[1];
        if (nloc == 0u) { xcd_barrier_complete(bar, b.x, nloc, nx); b.st[0] = nloc; b.st[1] = nx; }
        const unsigned old = xb_add(&bar[XB_XSUB(b.x)], 1u);
        const unsigned gen = old / nloc;
        if (old + 1u == (gen + 1u) * nloc) {
            __builtin_amdgcn_fence(__ATOMIC_RELEASE, "agent");
            asm volatile("s_waitcnt vmcnt(0)" ::: "memory");
            const unsigned og = xb_add(&bar[XB_TOP], 1u);
            const unsigned tg = og / nx;
            if (og + 1u == (tg + 1u) * nx) xb_add(&bar[XB_TOPGEN], 1u);
            else XB_SPIN(xb_ld(&bar[XB_TOPGEN]) == tg, bar);
            __builtin_amdgcn_fence(__ATOMIC_ACQUIRE, "agent");
            xb_add(&bar[XB_XGEN(b.x)], 1u);
            asm volatile("s_waitcnt vmcnt(0)" ::: "memory");
        } else {
            XB_SPIN(xb_ld(&bar[XB_XGEN(b.x)]) == gen, bar);
            __builtin_amdgcn_fence(__ATOMIC_ACQUIRE, "agent");
            asm volatile("s_waitcnt vmcnt(0)" ::: "memory");
        }
    }
    __syncthreads();
}

namespace att {
constexpr int D = 128, NW = 8, QBLK = 32, KVBLK = 64;
constexpr float SCALE = 0.088388347648318440f;
constexpr float THR = 8.f;
#ifndef ATT_SDEPTH
#define ATT_SDEPTH 1
#endif
constexpr int SDEPTH = ATT_SDEPTH;
constexpr int LDQ = 1024, LDK = 256, LDO = 2048;
constexpr size_t SHM_V = KVBLK * D * 2, SHM_K = KVBLK * D * 2, SHM_ATTN = 2 * SHM_V + 2 * SHM_K + NW * 64 * 4;
using s16x4  = __attribute__((ext_vector_type(4))) short;
using f32x16 = __attribute__((ext_vector_type(16))) float;
#define KSWZ(row, colB) ((row) * 256 + ((colB) ^ (((row) & 7) << 4)))
#define SBAR() __builtin_amdgcn_sched_barrier(0)
__device__ __forceinline__ int crow(int r, int hi) { return (r & 3) + 8 * (r >> 2) + 4 * hi; }
__device__ __forceinline__ unsigned cvtpk(float lo, float hi) { unsigned r; asm volatile("v_cvt_pk_bf16_f32 %0, %1, %2" : "=v"(r) : "v"(lo), "v"(hi)); return r; }

__device__ __forceinline__ void partialSM(f32x16& p0, f32x16& p1, float& m_reg, float& mn, float& alpha) {
  constexpr float C = SCALE * 1.4426950408889634f;
  float pmax = p0[0]; for (int r = 1; r < 16; ++r) pmax = fmaxf(pmax, p0[r]); for (int r = 0; r < 16; ++r) pmax = fmaxf(pmax, p1[r]);
  { auto rr = __builtin_amdgcn_permlane32_swap(__float_as_uint(pmax), __float_as_uint(pmax), false, false);
    pmax = fmaxf(__uint_as_float(rr[0]), __uint_as_float(rr[1])); }
  if (__builtin_expect(__all(pmax - m_reg <= THR / SCALE), 1)) { mn = m_reg; alpha = 1.f; }
  else { mn = fmaxf(m_reg, pmax); alpha = __builtin_amdgcn_exp2f((m_reg - mn) * C); m_reg = mn; }
  float mnC = -mn * C;
  for (int r = 0; r < 16; ++r) p0[r] = fmaf(p0[r], C, mnC); for (int r = 0; r < 16; ++r) p1[r] = fmaf(p1[r], C, mnC);
  for (int r = 0; r < 16; ++r) p0[r] = __builtin_amdgcn_exp2f(p0[r]);
}
__device__ __forceinline__ void finishSM(f32x16& p0, f32x16& p1, float alpha, float& l_reg, bf16x8& pa0, bf16x8& pa1, bf16x8& pa2, bf16x8& pa3) {
  for (int r = 0; r < 16; ++r) p1[r] = __builtin_amdgcn_exp2f(p1[r]);
  float ps = 0; for (int r = 0; r < 16; ++r) ps += p0[r]; for (int r = 0; r < 16; ++r) ps += p1[r];
  { auto rr = __builtin_amdgcn_permlane32_swap(__float_as_uint(ps), __float_as_uint(ps), false, false);
    ps = __uint_as_float(rr[0]) + __uint_as_float(rr[1]); }
  l_reg = l_reg * alpha + ps;
#define PK4(P, BASE, OUT) do { unsigned a0 = cvtpk(P[BASE + 0], P[BASE + 1]), a1 = cvtpk(P[BASE + 2], P[BASE + 3]);   \
    unsigned b0 = cvtpk(P[BASE + 4], P[BASE + 5]), b1 = cvtpk(P[BASE + 6], P[BASE + 7]);                              \
    auto r0 = __builtin_amdgcn_permlane32_swap(a0, b0, false, false); auto r1 = __builtin_amdgcn_permlane32_swap(a1, b1, false, false); \
    v4u w = {r0[0], r1[0], r0[1], r1[1]}; OUT = *reinterpret_cast<bf16x8*>(&w); } while (0)
  PK4(p0, 0, pa0); PK4(p0, 8, pa1); PK4(p1, 0, pa2); PK4(p1, 8, pa3);
#undef PK4
}
__device__ __forceinline__ void qkt(f32x16& p0, f32x16& p1, const bf16* Ks, const bf16x8* qr, int r32, int hi) {
  p0 = f32x16{}; p1 = f32x16{};
  for (int d0 = 0; d0 < 8; ++d0) { int cb = (d0 * 16 + hi * 8) * 2;
    bf16x8 b0 = *reinterpret_cast<const bf16x8*>((const char*)Ks + KSWZ(r32, cb));
    bf16x8 b1 = *reinterpret_cast<const bf16x8*>((const char*)Ks + KSWZ(32 + r32, cb));
    p0 = __builtin_amdgcn_mfma_f32_32x32x16_bf16(b0, qr[d0], p0, 0, 0, 0);
    p1 = __builtin_amdgcn_mfma_f32_32x32x16_bf16(b1, qr[d0], p1, 0, 0, 0); }
}
__device__ __forceinline__ int v_st(int k, int c) { const int kk = (k & ~0xC) | ((k & 4) << 1) | ((k & 8) >> 1); return ((kk >> 3) * 4 + (c >> 5)) * 512 + ((kk & 7) * 32 + (c & 31)) * 2; }
__device__ __forceinline__ int v_rd_base(int lane) { return ((lane & 3) << 3) | (((lane >> 2) & 3) << 6) | (((lane >> 4) & 1) << 5) | (((lane >> 5) & 1) << 8); }
constexpr int v_rd_off(int d0, int ks, int half) { return d0 * 512 + ks * 4096 + half * 2048; }
template <int OFF> __device__ __forceinline__ s16x4 tr_read(int vb) {
  s16x4 r; asm volatile("ds_read_b64_tr_b16 %0, %1 offset:%2" : "=&v"(r) : "v"(vb), "i"(OFF) : "memory"); return r;
}
template <int D0> __device__ __forceinline__ void pv_one(f32x16& od, int vb, bf16x8 pa0, bf16x8 pa1, bf16x8 pa2, bf16x8 pa3) {
  const s16x4 l0 = tr_read<v_rd_off(D0, 0, 0)>(vb), h0 = tr_read<v_rd_off(D0, 0, 1)>(vb), l1 = tr_read<v_rd_off(D0, 1, 0)>(vb), h1 = tr_read<v_rd_off(D0, 1, 1)>(vb);
  const s16x4 l2 = tr_read<v_rd_off(D0, 2, 0)>(vb), h2 = tr_read<v_rd_off(D0, 2, 1)>(vb), l3 = tr_read<v_rd_off(D0, 3, 0)>(vb), h3 = tr_read<v_rd_off(D0, 3, 1)>(vb);
  asm volatile("s_waitcnt lgkmcnt(0)" ::: "memory"); SBAR();
#define PK(L, H) (bf16x8){L[0], L[1], L[2], L[3], H[0], H[1], H[2], H[3]}
  od = __builtin_amdgcn_mfma_f32_32x32x16_bf16(pa0, PK(l0, h0), od, 0, 0, 0);
  od = __builtin_amdgcn_mfma_f32_32x32x16_bf16(pa1, PK(l1, h1), od, 0, 0, 0);
  od = __builtin_amdgcn_mfma_f32_32x32x16_bf16(pa2, PK(l2, h2), od, 0, 0, 0);
  od = __builtin_amdgcn_mfma_f32_32x32x16_bf16(pa3, PK(l3, h3), od, 0, 0, 0);
#undef PK
}
__device__ __forceinline__ void pv_d0(f32x16* o, int vb, bf16x8 pa0, bf16x8 pa1, bf16x8 pa2, bf16x8 pa3) {
  pv_one<0>(o[0], vb, pa0, pa1, pa2, pa3); pv_one<1>(o[1], vb, pa0, pa1, pa2, pa3); pv_one<2>(o[2], vb, pa0, pa1, pa2, pa3); pv_one<3>(o[3], vb, pa0, pa1, pa2, pa3);
}
struct KVSrc { const bf16* Kl; const bf16* Vl; const bf16* Kc; const bf16* Vc; int nloc, kstart, nrows; };

__device__ __forceinline__ void attn_body(const bf16* __restrict__ Qb, const KVSrc src, bf16* __restrict__ Ob, int NT, float sink_raw, int qpos0, char* lds) {
  int tid_ = threadIdx.x; asm volatile("" : "+v"(tid_)); const int tid = tid_, wid = tid >> 6, lane = tid & 63, r32 = lane & 31, hi = lane >> 5;
  bf16* V_lds = (bf16*)lds; bf16* K_lds = (bf16*)(lds + 2 * SHM_V);
  float* ws = (float*)(lds + 2 * SHM_V + 2 * SHM_K) + wid * 64; float* li_l = ws; float* al_l = ws + 32;
  float m_reg = sink_raw, l_reg = 1.f; f32x16 o[4] = {}; bf16x8 qr[8];
  const bf16* Qw = Qb + (long)(wid * QBLK + r32) * LDQ + hi * 8;
#pragma unroll
  for (int d0 = 0; d0 < 8; ++d0) qr[d0] = *reinterpret_cast<const bf16x8*>(Qw + d0 * 16);
  const int sr = tid >> 4, sc = (tid & 15) * 8, vst0 = v_st(sr, sc), vst1 = v_st(32 + sr, sc);
  const int vb0 = (int)(uintptr_t)V_lds + v_rd_base(lane);
  const int qpos = qpos0 + wid * QBLK + r32;
  struct { bf16x8 vs0, vs1, ks0, ks1; } sr_[SDEPTH];
#define SLOAD(i, t) do { const bf16 *kp_, *vp_; int r0_, r1_; const int t_ = (t);                                                      \
    if (t_ < src.nloc) { const int k0_ = src.kstart + t_ * KVBLK; r0_ = k0_ + sr; r1_ = k0_ + 32 + sr;                                   \
      r0_ = r0_ < 0 ? 0 : (r0_ >= src.nrows ? src.nrows - 1 : r0_); r1_ = r1_ < 0 ? 0 : (r1_ >= src.nrows ? src.nrows - 1 : r1_); kp_ = src.Kl; vp_ = src.Vl; } \
    else { const int k0_ = (t_ - src.nloc) * KVBLK; r0_ = k0_ + sr; r1_ = k0_ + 32 + sr; kp_ = src.Kc; vp_ = src.Vc; }                  \
    sr_[i].vs0 = *reinterpret_cast<const bf16x8*>(vp_ + (long)r0_ * LDK + sc); sr_[i].vs1 = *reinterpret_cast<const bf16x8*>(vp_ + (long)r1_ * LDK + sc); \
    sr_[i].ks0 = *reinterpret_cast<const bf16x8*>(kp_ + (long)r0_ * LDK + sc); sr_[i].ks1 = *reinterpret_cast<const bf16x8*>(kp_ + (long)r1_ * LDK + sc); } while (0)
#define SWRITE(b, i) do { *(bf16x8*)((char*)V_lds + (b) * SHM_V + vst0) = sr_[i].vs0;          \
    *(bf16x8*)((char*)V_lds + (b) * SHM_V + vst1) = sr_[i].vs1; int kc = sc * 2;               \
    *(bf16x8*)((char*)K_lds + (b) * SHM_K + KSWZ(sr, kc)) = sr_[i].ks0;                       \
    *(bf16x8*)((char*)K_lds + (b) * SHM_K + KSWZ(32 + sr, kc)) = sr_[i].ks1; } while (0)
#define SWAIT() do { if constexpr (SDEPTH == 2) asm volatile("s_waitcnt vmcnt(4)" ::: "memory"); else asm volatile("s_waitcnt vmcnt(0)" ::: "memory"); } while (0)
#define RESC(a) do { if (__any((a) < 1.f)) { if (hi == 0) al_l[r32] = (a); asm volatile("s_waitcnt lgkmcnt(0)" ::: "memory"); \
    for (int d = 0; d < 4; ++d) for (int r = 0; r < 16; ++r) o[d][r] *= al_l[crow(r, hi)]; } } while (0)
#define MASK(P0, P1, t) do { const int t_ = (t); if (t_ < src.nloc) { const int kb_ = src.kstart + t_ * KVBLK;                           \
    _Pragma("unroll") for (int r = 0; r < 16; ++r) { const int k0_ = kb_ + crow(r, hi), k1_ = k0_ + 32;                                  \
      const int d0_ = qpos - k0_, d1_ = qpos - k1_;                                                                                     \
      const bool v0_ = (k0_ >= 0) && (k0_ < src.nrows) && (d0_ <= 128) && (d0_ >= -128);                                                 \
      const bool v1_ = (k1_ >= 0) && (k1_ < src.nrows) && (d1_ <= 128) && (d1_ >= -128);                                                 \
      P0[r] = v0_ ? P0[r] : -1e30f; P1[r] = v1_ ? P1[r] : -1e30f; } } } while (0)
  f32x16 pA0, pA1, pB0, pB1; float mnA, mnB, alA, alB; bf16x8 pa0, pa1, pa2, pa3;
  constexpr int SE = 0, SO = SDEPTH - 1;
  SLOAD(SE, 0); asm volatile("s_waitcnt vmcnt(0)" ::: "memory"); SWRITE(0, SE); __syncthreads();
  qkt(pA0, pA1, K_lds, qr, r32, hi); MASK(pA0, pA1, 0); partialSM(pA0, pA1, m_reg, mnA, alA);
  SLOAD(SO, 1); if constexpr (SDEPTH == 2) { if (2 < NT) SLOAD(SE, 2); }
  SWAIT(); SWRITE(1, SO); __syncthreads();
  for (int j = 1; j + 1 < NT; j += 2) {
    SBAR(); qkt(pB0, pB1, (bf16*)((char*)K_lds + SHM_K), qr, r32, hi);
    finishSM(pA0, pA1, alA, l_reg, pa0, pa1, pa2, pa3); SBAR();
    SLOAD(SO, j + SDEPTH); SBAR();
    pv_d0(o, vb0, pa0, pa1, pa2, pa3); MASK(pB0, pB1, j); partialSM(pB0, pB1, m_reg, mnB, alB);
    __syncthreads(); SWAIT(); SWRITE(0, SE);
    RESC(alB); __syncthreads();
    SBAR(); qkt(pA0, pA1, K_lds, qr, r32, hi);
    finishSM(pB0, pB1, alB, l_reg, pa0, pa1, pa2, pa3); SBAR();
    if (SDEPTH == 1 || j + 3 < NT) SLOAD(SE, j + 1 + SDEPTH); SBAR();
    pv_d0(o, vb0 + (int)SHM_V, pa0, pa1, pa2, pa3); MASK(pA0, pA1, j + 1); partialSM(pA0, pA1, m_reg, mnA, alA);
    __syncthreads(); SWAIT(); SWRITE(1, SO);
    RESC(alA); __syncthreads();
  }
  SBAR(); qkt(pB0, pB1, (bf16*)((char*)K_lds + SHM_K), qr, r32, hi);
  finishSM(pA0, pA1, alA, l_reg, pa0, pa1, pa2, pa3); SBAR();
  pv_d0(o, vb0, pa0, pa1, pa2, pa3); MASK(pB0, pB1, NT - 1); partialSM(pB0, pB1, m_reg, mnB, alB);
  __syncthreads(); RESC(alB);
  finishSM(pB0, pB1, alB, l_reg, pa0, pa1, pa2, pa3); SBAR();
  pv_d0(o, vb0 + (int)SHM_V, pa0, pa1, pa2, pa3);
  if (hi == 0) li_l[r32] = l_reg; asm volatile("s_waitcnt lgkmcnt(0)" ::: "memory");
  float rli[16];
#pragma unroll
  for (int r = 0; r < 16; ++r) rli[r] = __builtin_amdgcn_rcpf(li_l[crow(r, hi)]);
  bf16* Ow = Ob + (long)(wid * QBLK) * LDO;
#pragma unroll
  for (int r = 0; r < 16; ++r) { int orow = crow(r, hi);
    for (int d0 = 0; d0 < 4; ++d0) Ow[(long)orow * LDO + d0 * 32 + r32] = f2bf(o[d0][r] * rli[r]); }
  __syncthreads();
#undef SLOAD
#undef SWRITE
#undef SWAIT
#undef RESC
#undef MASK
}
}

struct Args { const float* in[23]; float* out; unsigned char* ws; int ph_lo, ph_hi; };
enum { I_XP = 0, I_XS, I_CK, I_CV, I_ST, I_C, I_CCTX, I_WADA, I_BADA, I_NG, I_WFI, I_WFO, I_WIN, I_WOUT, I_QG, I_KG, I_SINK, I_LB, I_RG, I_CW, I_CB, I_CLG, I_CLB };

__device__ __forceinline__ void transpose_item(const float* W, int K, int N, bf16* WT, LAS float* scr, int item, int lane, int mode) {
    const int nblk = N / 32, kb = item / nblk, nb = item % nblk, k0 = 64 * kb, n0 = 32 * nb;
    int dn0 = n0;
    if (mode == 1) { const int hh = n0 >= DFF ? 1 : 0, m = n0 - hh * DFF; dn0 = 256 * (m >> 7) + 128 * hh + (m & 127); }
    if (mode == 2 && n0 >= ZCA) { const int hh = n0 >= ZCB ? 1 : 0, m = n0 - ZCA - hh * 512; dn0 = ZCA + 256 * (m >> 7) + 128 * hh + (m & 127); }
#pragma unroll 8
    for (int i = 0; i < 32; ++i) { const int kk = 2 * i + (lane >> 5); scr[kk * 33 + (lane & 31)] = W[(size_t)(k0 + kk) * N + n0 + (lane & 31)]; }
    LDS_WAIT(); asm volatile("" ::: "memory");
    const int c = lane & 7;
#pragma unroll
    for (int j = 0; j < 4; ++j) { const int n = (lane >> 3) + 8 * j; const LAS float* s = scr + (8 * c) * 33 + n;
        v4u o; o.x = pk2(s[0 * 33], s[1 * 33]); o.y = pk2(s[2 * 33], s[3 * 33]); o.z = pk2(s[4 * 33], s[5 * 33]); o.w = pk2(s[6 * 33], s[7 * 33]);
        *(v4u*)(WT + (size_t)(dn0 + n) * K + k0 + 8 * c) = o; }
    LDS_WAIT(); asm volatile("" ::: "memory");
}

__device__ __forceinline__ void phase_p0(const Args& a, LAS unsigned char* lds, int vcu, int G) {
    int tid_ = threadIdx.x; asm volatile("" : "+v"(tid_)); const int tid = tid_, lane = tid & 63, wave = tid >> 6;
    unsigned char* ws = a.ws;
    {
        LAS float* scr = (LAS float*)(lds + wave * 16384);
        const int gw = vcu * 8 + wave, NGW = G * 8;
        constexpr int I_FI = 32 * 352, I_FO = 88 * 64, I_IN = 32 * 160, I_OUT = 32 * 64, I_LAYER = 2 * I_FI + 2 * I_FO + I_IN + I_OUT;
        for (int rp = 0; rp < REP(8); ++rp)
        for (int it = gw; it < 2 * I_LAYER; it += NGW) {
            const int l = it / I_LAYER; int r = it % I_LAYER;
            if (r < 2 * I_FI) { const int s = r / I_FI; r -= s * I_FI;
                transpose_item(a.in[I_WFI] + (size_t)(l * 2 + s) * DM * NFF2, DM, NFF2, (bf16*)(ws + WS_WFI) + (size_t)(l * 2 + s) * NFF2 * DM, scr, r, lane, 1); continue; }
            r -= 2 * I_FI;
            if (r < 2 * I_FO) { const int s = r / I_FO; r -= s * I_FO;
                transpose_item(a.in[I_WFO] + (size_t)(l * 2 + s) * DFF * DM, DFF, DM, (bf16*)(ws + WS_WFO) + (size_t)(l * 2 + s) * DM * DFF, scr, r, lane, 0); continue; }
            r -= 2 * I_FO;
            if (r < I_IN) { transpose_item(a.in[I_WIN] + (size_t)l * DM * INC, DM, INC, (bf16*)(ws + WS_WIN) + (size_t)l * INC * DM, scr, r, lane, 2); continue; }
            r -= I_IN;
            transpose_item(a.in[I_WOUT] + (size_t)l * DM * DM, DM, DM, (bf16*)(ws + WS_WOUT) + (size_t)l * DM * DM, scr, r, lane, 0);
        }
    }
    __syncthreads();
    {
        LAS float* scs = (LAS float*)lds;
        for (int i = tid; i < 3 * DM; i += 512) { const int cond = i / DM, k = i % DM; const float v = cond == 0 ? a.in[I_CCTX][k] : a.in[I_C][(cond - 1) * DM + k]; scs[i] = siluf(v); }
        __syncthreads();
        float* mod = (float*)(ws + WS_MOD);
        const int NIT = 18 * 128, it0 = (int)(((long)vcu * NIT) / G), it1 = (int)(((long)(vcu + 1) * NIT) / G);
        int cur = -1; float acc[3][4];
#pragma unroll
        for (int c = 0; c < 3; ++c)
#pragma unroll
            for (int j = 0; j < 4; ++j) acc[c][j] = 0.f;
        for (int it = it0; it <= it1; ++it) {
            const int lc = it < it1 ? it / 128 : -2;
            if (lc != cur) {
                if (cur >= 0) { const int l = cur / 9, cr = cur % 9;
#pragma unroll
                    for (int c = 0; c < 3; ++c)
#pragma unroll
                        for (int j = 0; j < 4; ++j) { atomicAdd(mod + (size_t)(c * 2 + l) * MODW + cr * 2048 + 4 * tid + j, acc[c][j]); acc[c][j] = 0.f; } }
                cur = lc;
            }
            if (it == it1) break;
            const int l = lc / 9, cr = lc % 9, ks = it % 128;
            const float* Wp = a.in[I_WADA] + ((size_t)l * DM + ks * 16) * MODW + cr * 2048 + 4 * tid;
#pragma unroll
            for (int kk = 0; kk < 16; ++kk) { const f32x4 w = *(const f32x4*)(Wp + (size_t)kk * MODW); const int k = ks * 16 + kk;
                const float s0 = scs[k], s1 = scs[DM + k], s2 = scs[2 * DM + k];
#pragma unroll
                for (int j = 0; j < 4; ++j) { acc[0][j] += s0 * w[j]; acc[1][j] += s1 * w[j]; acc[2][j] += s2 * w[j]; } }
        }
    }
    {
        const int gt = vcu * 512 + tid, NGT = G * 512;
        for (int i = gt; i < 2 * 65536; i += NGT) { const int which = i >> 16, g8 = i & 65535;
            const int dg = g8 & 15, pos = (g8 >> 4) & 511, kvh = (g8 >> 13) & 1, bl = g8 >> 14;
            const float* src = a.in[which ? I_CV : I_CK] + (size_t)g8 * 8;
            const f32x4 x0 = *(const f32x4*)src, x1 = *(const f32x4*)(src + 4);
            v4u o; o.x = pk2(x0[0], x0[1]); o.y = pk2(x0[2], x0[3]); o.z = pk2(x1[0], x1[1]); o.w = pk2(x1[2], x1[3]);
            *(v4u*)((bf16*)(ws + (which ? WS_CV : WS_CK)) + ((size_t)bl * 512 + pos) * 256 + kvh * 128 + dg * 8) = o; }
        f32x4* X4 = (f32x4*)a.out; const f32x4* P4 = (const f32x4*)a.in[I_XP]; const f32x4* S4 = (const f32x4*)a.in[I_XS];
        constexpr int HALF4 = NCTX * DM / 4;
        for (int i = gt; i < HALF4; i += NGT) { X4[i] = P4[i]; X4[HALF4 + i] = S4[i]; }
        if (gt < 2048) { const int l = gt >> 10, j = gt & 1023; float v = 0.f; if (l) { const float a0 = a.in[I_LB][j], a1 = a.in[I_LB][1024 + j]; v = 1.f / (1.f + expf(a0 - a1)); } ((float*)(ws + WS_LBV))[gt] = v; }
    }
}

__device__ __forceinline__ void phase_norm(const Args& a, int l, int s, int vcu, int G) {
    int tid_ = threadIdx.x; asm volatile("" : "+v"(tid_)); const int tid = tid_, lane = tid & 63, wave = tid >> 6;
    const float* X = a.out; bf16* H = (bf16*)(a.ws + WS_H);
    const float* mod = (const float*)(a.ws + WS_MOD); const float* bada = a.in[I_BADA] + (size_t)l * MODW;
    const float* ng = a.in[I_NG] + (size_t)(l * 3 + s) * DM;
    for (int row = vcu * 8 + wave; row < NTOK; row += G * 8) {
        const int cond = row < NCTX ? 0 : 1 + ((row - NCTX) >> 12);
        const float* m0 = mod + (size_t)(cond * 2 + l) * MODW;
        const f32x4* xr = (const f32x4*)(X + (size_t)row * DM) + lane;
        f32x4 v[8]; float ss = 0.f;
#pragma unroll
        for (int j = 0; j < 8; ++j) { v[j] = xr[64 * j]; ss += (v[j].x * v[j].x + v[j].y * v[j].y) + (v[j].z * v[j].z + v[j].w * v[j].w); }
        const float rstd = 1.0f / sqrtf(wave_sum(ss) * (1.f / DM) + EPS);
        v2u* o8 = (v2u*)(H + (size_t)row * DM) + lane;
#pragma unroll
        for (int j = 0; j < 8; ++j) { const int col = 4 * lane + 256 * j;
            const f32x4 g = *(const f32x4*)(ng + col);
            const f32x4 sh = *(const f32x4*)(m0 + (3 * s) * DM + col) + *(const f32x4*)(bada + (3 * s) * DM + col);
            const f32x4 sc = *(const f32x4*)(m0 + (3 * s + 1) * DM + col) + *(const f32x4*)(bada + (3 * s + 1) * DM + col);
            const f32x4 h = v[j] * rstd * g * (sc + 1.0f) + sh;
            v2u w; w.x = pk2(h.x, h.y); w.y = pk2(h.z, h.w); o8[64 * j] = w; }
    }
}

__device__ __forceinline__ void phase_prep(const Args& a, int l, int vcu, int G) {
    int tid_ = threadIdx.x; asm volatile("" : "+v"(tid_)); const int tid = tid_, lane = tid & 63, wave = tid >> 6;
    const float* Z = (const float*)(a.ws + WS_Z);
    bf16* Qb = (bf16*)(a.ws + WS_Q); bf16* Kb = (bf16*)(a.ws + WS_K); bf16* Vb = (bf16*)(a.ws + WS_V);
    const int hf = lane >> 5, j = lane & 31, e1 = 64 * hf + j, e2 = e1 + 32;
    const float invf = exp2f(-(float)j * (13.287712379549449f / 32.f));
    const float qg1 = a.in[I_QG][l * 128 + e1], qg2 = a.in[I_QG][l * 128 + e2], kg1 = a.in[I_KG][l * 128 + e1], kg2 = a.in[I_KG][l * 128 + e2];
    for (int row = vcu * 8 + wave; row < NTOK; row += G * 8) {
        const float* z = Z + (size_t)row * INC;
        const bool lat = row >= NCTX;
        float cs = 1.f, sn = 0.f;
        if (lat) { const int p = (row - NCTX) & 4095; const int pos = hf ? (p & 63) : (p >> 6); const float ang = (float)pos * invf; cs = cosf(ang); sn = sinf(ang); }
#pragma unroll
        for (int hd = 0; hd < 10; ++hd) {
            const int base = hd < 8 ? ZQ + hd * 128 : ZK + (hd - 8) * 128;
            const float x1 = z[base + e1], x2 = z[base + e2];
            const float rstd = 1.0f / sqrtf(wave_sum(x1 * x1 + x2 * x2) * (1.f / 128.f) + EPS);
            float y1 = x1 * rstd * (hd < 8 ? qg1 : kg1), y2 = x2 * rstd * (hd < 8 ? qg2 : kg2);
            if (!lat && hd >= 8) { const int b = row >> 8, pos = row & 255; float* ck = a.out + OUT_CK + ((((size_t)b * 2 + l) * 2 + (hd - 8)) * 256 + pos) * 128; ck[e1] = y1; ck[e2] = y2; }
            if (lat) { const float r1 = y1 * cs - y2 * sn, r2 = y1 * sn + y2 * cs; y1 = r1; y2 = r2; }
            if (hd < 8) { bf16* q = Qb + (size_t)row * 1024 + hd * 128; q[e1] = f2bf(y1); q[e2] = f2bf(y2); }
            else { bf16* k = Kb + (size_t)row * 256 + (hd - 8) * 128; k[e1] = f2bf(y1); k[e2] = f2bf(y2); }
        }
        const f32x4 v = *(const f32x4*)(z + ZV + 4 * lane);
        v2u w; w.x = pk2(v.x, v.y); w.y = pk2(v.z, v.w); *((v2u*)(Vb + (size_t)row * 256) + lane) = w;
        if (!lat) { const int b = row >> 8, pos = row & 255, kvh = lane >> 5; *(f32x4*)(a.out + OUT_CV + ((((size_t)b * 2 + l) * 2 + kvh) * 256 + pos) * 128 + ((4 * lane) & 127)) = v; }
    }
}

__device__ __forceinline__ void phase_hgrn_a(const Args& a, LAS unsigned char* lds, int l, int vcu, int G) {
    int tid_ = threadIdx.x; asm volatile("" : "+v"(tid_)); const int tid = tid_, lane = tid & 63, wave = tid >> 6, fr = lane & 15, fq = lane >> 4;
    const float* Z = (const float*)(a.ws + WS_Z);
    float* UT = (float*)(a.ws + WS_US); float* DEC = (float*)(a.ws + WS_DEC);
    LAS unsigned char* KT = lds;
    LAS unsigned char* VT = lds + 20480;
    LAS float* TOT = (LAS float*)(lds + 30720);
    const int d = tid & 127, h = (tid >> 7) & 1, dir = tid >> 8, pq = tid >> 7;
    for (int item = vcu; item < 2048; item += G) {
        const int gb = item >> 2, head = item & 3, row0 = gb * 32;
        const float* zk = Z + (size_t)row0 * INC + 2048 + dir * 512 + head * 128 + d;
        float kk[16], c[16]; float run = 0.f;
#pragma unroll
        for (int j = 0; j < 16; ++j) { const int i = 16 * h + j, p = dir ? 31 - i : i; kk[j] = zk[(size_t)p * INC]; c[j] = zk[(size_t)p * INC + 2048]; }
        float vv[8];
#pragma unroll
        for (int j = 0; j < 8; ++j) vv[j] = Z[(size_t)(row0 + 8 * pq + j) * INC + ZRI + head * 128 + d];
#pragma unroll
        for (int j = 0; j < 16; ++j) { run += c[j]; c[j] = run; }
        TOT[(dir * 2 + h) * 128 + d] = run;
        { v4u w; w.x = pk2(vv[0], vv[1]); w.y = pk2(vv[2], vv[3]); w.z = pk2(vv[4], vv[5]); w.w = pk2(vv[6], vv[7]); *(LAS v4u*)(VT + d * 80 + pq * 16) = w; }
        __syncthreads();
        const float other = TOT[(dir * 2 + (1 - h)) * 128 + d];
        const float base = h ? run : run + other;
#pragma unroll
        for (int j = 0; j < 16; j += 2) { const float va = kk[j] * __expf(base - c[j]), vb = kk[j + 1] * __expf(base - c[j + 1]);
            const int i = 16 * h + j, p = dir ? 30 - i : i;
            *(LAS unsigned*)(KT + (dir * 128 + d) * 80 + p * 2) = pk2(dir ? vb : va, dir ? va : vb); }
        if (h == 0) DEC[((size_t)(dir * 512 + gb) * 4 + head) * 128 + d] = __expf(run + other);
        __syncthreads();
        const bf16x8 af = *(const LAS bf16x8*)(VT + (wave * 16 + fr) * 80 + fq * 16);
#pragma unroll
        for (int dr = 0; dr < 2; ++dr) {
            float* Ub = UT + ((size_t)(dr * 512 + gb) * 4 + head) * 16384;
#pragma unroll
            for (int dt = 0; dt < 8; ++dt) {
                const bf16x8 bfv = *(const LAS bf16x8*)(KT + (dr * 128 + dt * 16 + fr) * 80 + fq * 16);
                f32x4 acc = {0.f, 0.f, 0.f, 0.f};
                acc = __builtin_amdgcn_mfma_f32_16x16x32_bf16(af, bfv, acc, 0, 0, 0);
#pragma unroll
                for (int i = 0; i < 4; ++i) Ub[(wave * 16 + 4 * fq + i) * 128 + dt * 16 + fr] = acc[i];
            }
        }
        __syncthreads();
    }
}

__device__ __forceinline__ void phase_conv(const Args& a, LAS unsigned char* lds, int l, int vcu, int G) {
    int tid_ = threadIdx.x; asm volatile("" : "+v"(tid_)); const int tid = tid_, lane = tid & 63, wave = tid >> 6, ch = tid;
    const float* GL = (const float*)(a.ws + WS_GLU); bf16* MIX = (bf16*)(a.ws + WS_MIX);
    LAS float* OB = (LAS float*)lds;
    LAS float* STS = (LAS float*)(lds + 65536);
    float w[31];
#pragma unroll
    for (int j = 0; j < 31; ++j) w[j] = a.in[I_CW][(size_t)(l * 31 + j) * 512 + ch];
    const float bias = a.in[I_CB][l * 512 + ch], lg = a.in[I_CLG][l * 512 + ch], lbb = a.in[I_CLB][l * 512 + ch];
    for (int gb = vcu; gb < 512; gb += G) {
        const int row0 = gb * 32;
        int s0, T; if (row0 < NCTX) { s0 = row0 & ~255; T = 256; } else { s0 = NCTX + ((row0 - NCTX) & ~4095); T = 4096; }
        float h[62];
#pragma unroll
        for (int i = 0; i < 62; ++i) { const int r = row0 - 15 + i; h[i] = (r >= s0 && r < s0 + T) ? GL[(size_t)r * 512 + ch] : 0.f; }
        float o[32];
#pragma unroll
        for (int p = 0; p < 32; ++p) { float acc = bias;
#pragma unroll
            for (int j = 0; j < 31; ++j) acc += w[j] * h[p + j];
            o[p] = acc; OB[p * 512 + ch] = acc; }
        __syncthreads();
#pragma unroll
        for (int t = 0; t < 4; ++t) { const int p = wave * 4 + t;
            const f32x4 x0 = *(const LAS f32x4*)(OB + p * 512 + lane * 8), x1 = *(const LAS f32x4*)(OB + p * 512 + lane * 8 + 4);
            const float s1 = wave_sum((x0.x + x0.y) + (x0.z + x0.w) + (x1.x + x1.y) + (x1.z + x1.w));
            const float s2 = wave_sum((x0.x * x0.x + x0.y * x0.y) + (x0.z * x0.z + x0.w * x0.w) + (x1.x * x1.x + x1.y * x1.y) + (x1.z * x1.z + x1.w * x1.w));
            const float mu = s1 * (1.f / 512.f), var = fmaxf(s2 * (1.f / 512.f) - mu * mu, 0.f);
            if (lane == 0) { STS[p * 2] = mu; STS[p * 2 + 1] = 1.0f / sqrtf(var + EPS); } }
        __syncthreads();
#pragma unroll
        for (int p = 0; p < 32; ++p) { const float y = (o[p] - STS[p * 2]) * STS[p * 2 + 1] * lg + lbb;
            MIX[(size_t)(row0 + p) * DM + 1536 + ch] = f2bf(siluf(y)); }
        __syncthreads();
    }
}

__device__ __forceinline__ void phase_attn(const Args& a, unsigned char* lds_generic, int l, int vcu, int G) {
    const bf16* Qb = (const bf16*)(a.ws + WS_Q); const bf16* Kb = (const bf16*)(a.ws + WS_K); const bf16* Vb = (const bf16*)(a.ws + WS_V);
    bf16* MIX = (bf16*)(a.ws + WS_MIX);
    for (int item = vcu; item < 512; item += G) {
        if (item < 256) {
            const int b = item >> 3, h = item & 7, kvh = h >> 2; const size_t r0 = (size_t)b * 256;
            att::KVSrc src; src.Kl = nullptr; src.Vl = nullptr; src.Kc = Kb + r0 * 256 + kvh * 128; src.Vc = Vb + r0 * 256 + kvh * 128; src.nloc = 0; src.kstart = 0; src.nrows = 1;
            att::attn_body(Qb + r0 * 1024 + h * 128, src, MIX + r0 * DM + h * 128, 4, a.in[I_SINK][l * 8 + h] * (1.0f / att::SCALE), 0, (char*)lds_generic);
        } else {
            const int it = item - 256, b2 = it >> 7, h = (it >> 4) & 7, qi = it & 15, kvh = h >> 2; const size_t rb = (size_t)NCTX + (size_t)b2 * 4096;
            att::KVSrc src; src.Kl = Kb + rb * 256 + kvh * 128; src.Vl = Vb + rb * 256 + kvh * 128;
            src.Kc = (const bf16*)(a.ws + WS_CK) + ((size_t)(b2 * 2 + l) * 512) * 256 + kvh * 128; src.Vc = (const bf16*)(a.ws + WS_CV) + ((size_t)(b2 * 2 + l) * 512) * 256 + kvh * 128;
            src.nloc = 8; src.kstart = 256 * qi - 128; src.nrows = 4096;
            att::attn_body(Qb + (rb + 256 * qi) * 1024 + h * 128, src, MIX + (rb + 256 * qi) * DM + h * 128, 16, a.in[I_SINK][l * 8 + h] * (1.0f / att::SCALE), 256 * qi, (char*)lds_generic);
        }
    }
}

__device__ __forceinline__ void phase_hgrn_b(const Args& a, LAS unsigned char* lds, int l, int vcu, int G) {
    int tid_ = threadIdx.x; asm volatile("" : "+v"(tid_)); const int tid = tid_;
    const float* __restrict__ UT = (const float*)(a.ws + WS_US); const float* __restrict__ DEC = (const float*)(a.ws + WS_DEC);
    bf16* __restrict__ ST = (bf16*)(a.ws + WS_ST16);
    LAS float* TR = (LAS float*)lds;
    for (int item = vcu; item < 256; item += G) {
        const int b = item >> 3, head = (item >> 1) & 3, dir = item & 1;
        f32x4 S[4][2];
#pragma unroll
        for (int j = 0; j < 4; ++j) { S[j][0] = (f32x4){0.f, 0.f, 0.f, 0.f}; S[j][1] = (f32x4){0.f, 0.f, 0.f, 0.f}; }
#pragma unroll 2
        for (int i = 0; i < 8; ++i) { const int cc = dir ? 7 - i : i, gb = b * 8 + cc; const size_t cb = ((size_t)(dir * 512 + gb) * 4 + head);
            const float* U = UT + cb * 16384; const float* dc = DEC + cb * 128; bf16* So = ST + cb * 16384;
#pragma unroll
            for (int j = 0; j < 4; ++j) { const int flat = 8 * (tid + 512 * j), d0 = flat & 127;
                const f32x4 u0 = *(const f32x4*)(U + flat), u1 = *(const f32x4*)(U + flat + 4), e0 = *(const f32x4*)(dc + d0), e1 = *(const f32x4*)(dc + d0 + 4);
                v4u w; w.x = pk2(S[j][0].x, S[j][0].y); w.y = pk2(S[j][0].z, S[j][0].w); w.z = pk2(S[j][1].x, S[j][1].y); w.w = pk2(S[j][1].z, S[j][1].w);
                *(v4u*)(So + flat) = w;
                S[j][0] = S[j][0] * e0 + u0; S[j][1] = S[j][1] * e1 + u1; } }
        __syncthreads();
#pragma unroll
        for (int j = 0; j < 4; ++j) { const int flat = 8 * (tid + 512 * j), e = flat >> 7, d0 = flat & 127;
#pragma unroll
            for (int k = 0; k < 4; ++k) { TR[e * 129 + d0 + k] = S[j][0][k]; TR[e * 129 + d0 + 4 + k] = S[j][1][k]; } }
        __syncthreads();
        float* O = a.out + OUT_ST + ((((size_t)b * 2 + l) * 2 + dir) * 4 + head) * 16384;
#pragma unroll
        for (int j = 0; j < 8; ++j) { const int idx = tid + 512 * j, dd = idx >> 5, e4 = (idx & 31) * 4;
            f32x4 v; v.x = TR[e4 * 129 + dd]; v.y = TR[(e4 + 1) * 129 + dd]; v.z = TR[(e4 + 2) * 129 + dd]; v.w = TR[(e4 + 3) * 129 + dd];
            *(f32x4*)(O + dd * 128 + e4) = v; }
        __syncthreads();
    }
    for (int item = vcu; item < 256; item += G) {
        const int combo = item >> 4, part = item & 15, b2 = combo >> 3, dir = (combo >> 2) & 1, head = combo & 3;
        const int flat = part * 1024 + tid * 2, e = flat >> 7, d0 = flat & 127;
        const float* Sin = a.in[I_ST] + ((((size_t)b2 * 2 + l) * 2 + dir) * 4 + head) * 16384;
        f32x2 S; S.x = Sin[d0 * 128 + e]; S.y = Sin[(d0 + 1) * 128 + e];
        const int gb0 = 256 + b2 * 128;
#pragma unroll 16
        for (int i = 0; i < 128; ++i) { const int cc = dir ? 127 - i : i, gb = gb0 + cc; const size_t cb = ((size_t)(dir * 512 + gb) * 4 + head);
            const f32x2 u = *(const f32x2*)(UT + cb * 16384 + flat), dd = *(const f32x2*)(DEC + cb * 128 + d0);
            *(unsigned*)(ST + cb * 16384 + flat) = pk2(S.x, S.y);
            S = S * dd + u; }
    }
}

__device__ __forceinline__ void phase_hgrn_c(const Args& a, LAS unsigned char* lds, int l, int vcu, int G) {
    int tid_ = threadIdx.x; asm volatile("" : "+v"(tid_)); const int tid = tid_, lane = tid & 63, wave = tid >> 6, fr = lane & 15, fq = lane >> 4;
    const float* Z = (const float*)(a.ws + WS_Z); const bf16* ST = (const bf16*)(a.ws + WS_ST16); bf16* MIX = (bf16*)(a.ws + WS_MIX);
    constexpr int QP = 272;
    constexpr int O_QX = 0, O_KX = 17408, O_QI = 34816, O_VT = 52224, O_AM = 62464, O_TOT = 67584, O_RED = 69632;
    LAS unsigned char* QX = lds + O_QX;
    LAS unsigned char* KX = lds + O_KX;
    LAS unsigned char* QI = lds + O_QI;
    LAS unsigned char* VT = lds + O_VT;
    LAS unsigned char* AM = lds + O_AM;
    LAS float* TOT = (LAS float*)(lds + O_TOT);
    LAS float* RED = (LAS float*)(lds + O_RED);
    const int d = tid & 127, h = (tid >> 7) & 1, dir = tid >> 8, pq = tid >> 7;
    for (int item = vcu; item < 2048; item += G) {
        const int gb = item >> 2, head = item & 3, row0 = gb * 32;
        bf16x8 sB[2][4];
#pragma unroll
        for (int dr = 0; dr < 2; ++dr)
#pragma unroll
            for (int kt = 0; kt < 4; ++kt) sB[dr][kt] = *(const bf16x8*)(ST + ((size_t)(dr * 512 + gb) * 4 + head) * 16384 + (wave * 16 + fr) * 128 + (4 * kt + fq) * 8);
        const float* zk = Z + (size_t)row0 * INC + 2048 + dir * 512 + head * 128 + d;
        const float* zq = Z + (size_t)row0 * INC + ZRQ + head * 128 + d;
        float kk[16], c[16], qq[16]; float run = 0.f;
#pragma unroll
        for (int j = 0; j < 16; ++j) { const int i = 16 * h + j, p = dir ? 31 - i : i; kk[j] = zk[(size_t)p * INC]; c[j] = zk[(size_t)p * INC + 2048]; qq[j] = zq[(size_t)p * INC]; }
        float vv[8];
#pragma unroll
        for (int j = 0; j < 8; ++j) vv[j] = Z[(size_t)(row0 + 8 * pq + j) * INC + ZRI + head * 128 + d];
#pragma unroll
        for (int j = 0; j < 16; ++j) { run += c[j]; c[j] = run; }
        TOT[(dir * 2 + h) * 128 + d] = run;
        { v4u w; w.x = pk2(vv[0], vv[1]); w.y = pk2(vv[2], vv[3]); w.z = pk2(vv[4], vv[5]); w.w = pk2(vv[6], vv[7]); *(LAS v4u*)(VT + d * 80 + pq * 16) = w; }
        __syncthreads();
        const float other = TOT[(dir * 2 + (1 - h)) * 128 + d];
        const float xo = h ? 0.f : -run;
        const float io = h ? other : 0.f;
#pragma unroll
        for (int j = 0; j < 16; ++j) { const int i = 16 * h + j, p = dir ? 31 - i : i; const int off = (dir * 32 + p) * QP + d * 2;
            const float ex = __expf(c[j] + xo);
            *(LAS bf16*)(QX + off) = f2bf(qq[j] * ex);
            *(LAS bf16*)(KX + off) = f2bf(kk[j] * __builtin_amdgcn_rcpf(ex));
            *(LAS bf16*)(QI + off) = f2bf(qq[j] * __expf(c[j] + io)); }
        __syncthreads();
        {
            const int dr = wave >> 2, mt = (wave >> 1) & 1, nt = wave & 1;
            f32x4 acc = {0.f, 0.f, 0.f, 0.f};
#pragma unroll
            for (int kt = 0; kt < 4; ++kt) {
                const bf16x8 af = *(const LAS bf16x8*)(QX + (dr * 32 + mt * 16 + fr) * QP + kt * 64 + fq * 16);
                const bf16x8 bfv = *(const LAS bf16x8*)(KX + (dr * 32 + nt * 16 + fr) * QP + kt * 64 + fq * 16);
                acc = __builtin_amdgcn_mfma_f32_16x16x32_bf16(af, bfv, acc, 0, 0, 0); }
#pragma unroll
            for (int i = 0; i < 4; ++i) { const int p = mt * 16 + 4 * fq + i, pp = nt * 16 + fr; const bool keep = dr ? (pp >= p) : (pp <= p);
                *(LAS bf16*)(AM + (dr * 32 + p) * 80 + pp * 2) = f2bf(keep ? acc[i] : 0.f); }
        }
        __syncthreads();
        f32x4 o[2];
#pragma unroll
        for (int mt = 0; mt < 2; ++mt) { o[mt] = (f32x4){0.f, 0.f, 0.f, 0.f};
#pragma unroll
            for (int dr = 0; dr < 2; ++dr) {
#pragma unroll
                for (int kt = 0; kt < 4; ++kt) {
                    const bf16x8 af = *(const LAS bf16x8*)(QI + (dr * 32 + mt * 16 + fr) * QP + kt * 64 + fq * 16);
                    o[mt] = __builtin_amdgcn_mfma_f32_16x16x32_bf16(af, sB[dr][kt], o[mt], 0, 0, 0); }
                const bf16x8 af = *(const LAS bf16x8*)(AM + (dr * 32 + mt * 16 + fr) * 80 + fq * 16);
                const bf16x8 bfv = *(const LAS bf16x8*)(VT + (wave * 16 + fr) * 80 + fq * 16);
                o[mt] = __builtin_amdgcn_mfma_f32_16x16x32_bf16(af, bfv, o[mt], 0, 0, 0);
            } }
#pragma unroll
        for (int mt = 0; mt < 2; ++mt)
#pragma unroll
            for (int i = 0; i < 4; ++i) { float ss = o[mt][i] * o[mt][i]; ss += __shfl_xor(ss, 1); ss += __shfl_xor(ss, 2); ss += __shfl_xor(ss, 4); ss += __shfl_xor(ss, 8);
                if (fr == 0) RED[wave * 32 + mt * 16 + 4 * fq + i] = ss; }
        __syncthreads();
        const int e = wave * 16 + fr; const float gn = a.in[I_RG][(size_t)(l * 4 + head) * 128 + e];
#pragma unroll
        for (int mt = 0; mt < 2; ++mt)
#pragma unroll
            for (int i = 0; i < 4; ++i) { const int p = mt * 16 + 4 * fq + i; float ss = 0.f;
#pragma unroll
                for (int wv = 0; wv < 8; ++wv) ss += RED[wv * 32 + p];
                const float rstd = 1.0f / sqrtf(ss * (1.f / 128.f) + EPS);
                const float rg = Z[(size_t)(row0 + p) * INC + ZRG + head * 128 + e];
                MIX[(size_t)(row0 + p) * DM + 1024 + head * 128 + e] = f2bf(o[mt][i] * rstd * gn * siluf(rg)); }
        __syncthreads();
    }
}

constexpr int N_PHASES = 25;

enum { K_ALL = 0, K_P0, K_NORM, K_FFI, K_FFO, K_WIN, K_MIXA, K_MIXB, K_MIXC, K_WOUT };
template <int KIND>
__global__ void __launch_bounds__(512, 2) mega_fwd(Args args) {
    extern __shared__ __attribute__((aligned(16))) unsigned char lds_raw[];
    LAS unsigned char* lds = (LAS unsigned char*)lds_raw;
    const int tid = threadIdx.x;
    const int G = gridDim.x; const int bx = blockIdx.x; const int vcu = (G % 8 == 0) ? (bx % 8) * (G / 8) + bx / 8 : bx;
    for (int u = tid; u < (LDS_BYTES - LDSCTL_OFF) / 4; u += 512) ((LAS unsigned*)(lds + LDSCTL_OFF))[u] = 0u;
    __syncthreads();
    const int lo = args.ph_lo, hi = args.ph_hi;
    XcdBarrier bar; bar.bar = (unsigned*)(args.ws + WS_CTL) + CW_BAR; bar.x = 0; bar.st = nullptr;
    if (hi - lo > 1) bar = xcd_barrier_post((unsigned*)(args.ws + WS_CTL) + CW_BAR, (volatile LAS unsigned*)(lds + LDSCTL_OFF + 64));
#define IN(k) (lo <= (k) && (k) < hi)
#define HAS(kind) (KIND == K_ALL || KIND == (kind))
#define SEAM(k) do { if (IN(k) && IN((k) + 1)) xcd_barrier(bar); } while (0)
    unsigned char* ws = args.ws;
    float* X = args.out;
    const float* mod = (const float*)(ws + WS_MOD);

    if (HAS(K_P0) && IN(0)) { phase_p0(args, lds, vcu, G); SEAM(0); }

    for (int l = 0; l < 2; ++l) {
        const int pb = 1 + 12 * l;
        const float* bada = args.in[I_BADA] + (size_t)l * MODW;
        if (HAS(K_NORM) && IN(pb + 0)) { for (int rp = 0; rp < REP(1); ++rp) phase_norm(args, l, 0, vcu, G); SEAM(pb + 0); }
        if (HAS(K_FFI) && IN(pb + 1)) {
            pg8::Gemm g{(const bf16*)(ws + WS_H), (const bf16*)(ws + WS_WFI) + (size_t)(l * 2 + 0) * NFF2 * DM, NTOK, NFF2, DM}; pg8::StaticOrder S; S.init(NTOK, NFF2, G, bx);
            pg8::EpiSwiGLU E{(bf16*)(ws + WS_Z), DFF};
            for (int rp = 0; rp < REP(7); ++rp) pg8::gemm_phase<pg8::EpiSwiGLU, pg8::StaticOrder, true, true>(lds, g, S, E);
            SEAM(pb + 1);
        }
        if (HAS(K_FFO) && IN(pb + 2)) {
            pg8::Gemm g{(const bf16*)(ws + WS_Z), (const bf16*)(ws + WS_WFO) + (size_t)(l * 2 + 0) * DM * DFF, NTOK, DM, DFF}; pg8::StaticOrder S; S.init(NTOK, DM, G, bx);
            pg8::EpiResid E{X, mod + (size_t)l * MODW + 2 * DM, bada + 2 * DM, 0.5f};
            pg8::gemm_phase<pg8::EpiResid, pg8::StaticOrder, true, true>(lds, g, S, E);
            SEAM(pb + 2);
        }
        if (HAS(K_NORM) && IN(pb + 3)) { for (int rp = 0; rp < REP(1); ++rp) phase_norm(args, l, 1, vcu, G); SEAM(pb + 3); }
        if (HAS(K_WIN) && IN(pb + 4)) {
            pg8::Gemm g{(const bf16*)(ws + WS_H), (const bf16*)(ws + WS_WIN) + (size_t)l * INC * DM, NTOK, INC, DM}; pg8::StaticOrder S; S.init(NTOK, INC, G, bx);
            pg8::EpiWin E{(float*)(ws + WS_Z), (const float*)(ws + WS_LBV) + l * 1024, (float*)(ws + WS_GLU)};
            pg8::gemm_phase<pg8::EpiWin, pg8::StaticOrder, true, true>(lds, g, S, E);
            SEAM(pb + 4);
        }
        if (HAS(K_MIXA) && IN(pb + 5)) {
#ifndef NO_PREP
            for (int rp = 0; rp < REP(2); ++rp) phase_prep(args, l, vcu, G);
#endif
#ifndef NO_HGRNA
            for (int rp = 0; rp < REP(3); ++rp) phase_hgrn_a(args, lds, l, vcu, G);
#endif
#ifndef NO_CONV
            for (int rp = 0; rp < REP(4); ++rp) phase_conv(args, lds, l, vcu, G);
#endif
            SEAM(pb + 5); }
        if (HAS(K_MIXB) && IN(pb + 6)) {
#ifndef NO_ATTN
            for (int rp = 0; rp < REP(5); ++rp) phase_attn(args, lds_raw, l, vcu, G);
#endif
#ifndef NO_HGRNB
            phase_hgrn_b(args, lds, l, vcu, G);
#endif
            SEAM(pb + 6); }
        if (HAS(K_MIXC) && IN(pb + 7)) { for (int rp = 0; rp < REP(6); ++rp) phase_hgrn_c(args, lds, l, vcu, G); SEAM(pb + 7); }
        if (HAS(K_WOUT) && IN(pb + 8)) {
            pg8::Gemm g{(const bf16*)(ws + WS_MIX), (const bf16*)(ws + WS_WOUT) + (size_t)l * DM * DM, NTOK, DM, DM}; pg8::StaticOrder S; S.init(NTOK, DM, G, bx);
            pg8::EpiResid E{X, mod + (size_t)l * MODW + 5 * DM, bada + 5 * DM, 1.0f};
            pg8::gemm_phase<pg8::EpiResid, pg8::StaticOrder, true, true>(lds, g, S, E);
            SEAM(pb + 8);
        }
        if (HAS(K_NORM) && IN(pb + 9)) { for (int rp = 0; rp < REP(1); ++rp) phase_norm(args, l, 2, vcu, G); SEAM(pb + 9); }
        if (HAS(K_FFI) && IN(pb + 10)) {
            pg8::Gemm g{(const bf16*)(ws + WS_H), (const bf16*)(ws + WS_WFI) + (size_t)(l * 2 + 1) * NFF2 * DM, NTOK, NFF2, DM}; pg8::StaticOrder S; S.init(NTOK, NFF2, G, bx);
            pg8::EpiSwiGLU E{(bf16*)(ws + WS_Z), DFF};
            for (int rp = 0; rp < REP(7); ++rp) pg8::gemm_phase<pg8::EpiSwiGLU, pg8::StaticOrder, true, true>(lds, g, S, E);
            SEAM(pb + 10);
        }
        if (HAS(K_FFO) && IN(pb + 11)) {
            pg8::Gemm g{(const bf16*)(ws + WS_Z), (const bf16*)(ws + WS_WFO) + (size_t)(l * 2 + 1) * DM * DFF, NTOK, DM, DFF}; pg8::StaticOrder S; S.init(NTOK, DM, G, bx);
            pg8::EpiResid E{X, mod + (size_t)l * MODW + 8 * DM, bada + 8 * DM, 0.5f};
            pg8::gemm_phase<pg8::EpiResid, pg8::StaticOrder, true, true>(lds, g, S, E);
            SEAM(pb + 11);
        }
    }
#undef IN
#undef HAS
#undef SEAM
}

extern "C" void kernel_launch(void* const* d_in, const int* in_sizes, int n_in, void* d_out, int out_size, void* d_ws, size_t ws_size, hipStream_t stream) {
    static int grid = 0;
    if (grid == 0) {
        if (n_in != 23 || (size_t)out_size != OUT_TOTAL || ws_size < WS_END) { fprintf(stderr, "kernel_launch: shape mismatch: n_in %d out %d ws %zu (need >= %zu); nothing launched\n", n_in, out_size, ws_size, (size_t)WS_END); grid = -1; return; }
        int dev = 0, cus = 0, per_cu = 0;
        if (hipGetDevice(&dev) != hipSuccess || hipDeviceGetAttribute(&cus, hipDeviceAttributeMultiprocessorCount, dev) != hipSuccess) { grid = -1; return; }
#if MK_N_LAUNCHES == 1
        const void* fns[1] = {(const void*)mega_fwd<K_ALL>};
#else
        const void* fns[9] = {(const void*)mega_fwd<K_P0>, (const void*)mega_fwd<K_NORM>, (const void*)mega_fwd<K_FFI>, (const void*)mega_fwd<K_FFO>, (const void*)mega_fwd<K_WIN>,
                              (const void*)mega_fwd<K_MIXA>, (const void*)mega_fwd<K_MIXB>, (const void*)mega_fwd<K_MIXC>, (const void*)mega_fwd<K_WOUT>};
#endif
        for (const void* f : fns) {
            if (hipFuncSetAttribute(f, hipFuncAttributeMaxDynamicSharedMemorySize, LDS_BYTES) != hipSuccess) { fprintf(stderr, "kernel_launch: hipFuncSetAttribute failed\n"); grid = -1; return; }
            if (hipOccupancyMaxActiveBlocksPerMultiprocessor(&per_cu, f, 512, LDS_BYTES) != hipSuccess || per_cu < 1) { fprintf(stderr, "kernel_launch: occupancy query says %d\n", per_cu); }
        }
        (void)hipGetLastError();
        grid = cus;
    }
    if (grid < 0) return;
    (void)hipMemsetAsync((char*)d_ws + WS_CTL, 0, CTL_ZERO_BYTES, stream);
    Args a{};
    for (int i = 0; i < 23; ++i) a.in[i] = (const float*)d_in[i];
    a.out = (float*)d_out; a.ws = (unsigned char*)d_ws;
#if MK_N_LAUNCHES == 1
    a.ph_lo = 0; a.ph_hi = N_PHASES;
    hipLaunchKernelGGL(mega_fwd<K_ALL>, dim3(grid), dim3(512), LDS_BYTES, stream, a);
#else
    static const int kind_of[12] = {K_NORM, K_FFI, K_FFO, K_NORM, K_WIN, K_MIXA, K_MIXB, K_MIXC, K_WOUT, K_NORM, K_FFI, K_FFO};
    for (int p = 0; p < N_PHASES; ++p) { a.ph_lo = p; a.ph_hi = p + 1; const int kind = p == 0 ? K_P0 : kind_of[(p - 1) % 12];
        switch (kind) {
            case K_P0:   hipLaunchKernelGGL(mega_fwd<K_P0>,   dim3(grid), dim3(512), LDS_BYTES, stream, a); break;
            case K_NORM: hipLaunchKernelGGL(mega_fwd<K_NORM>, dim3(grid), dim3(512), LDS_BYTES, stream, a); break;
            case K_FFI:  hipLaunchKernelGGL(mega_fwd<K_FFI>,  dim3(grid), dim3(512), LDS_BYTES, stream, a); break;
            case K_FFO:  hipLaunchKernelGGL(mega_fwd<K_FFO>,  dim3(grid), dim3(512), LDS_BYTES, stream, a); break;
            case K_WIN:  hipLaunchKernelGGL(mega_fwd<K_WIN>,  dim3(grid), dim3(512), LDS_BYTES, stream, a); break;
            case K_MIXA: hipLaunchKernelGGL(mega_fwd<K_MIXA>, dim3(grid), dim3(512), LDS_BYTES, stream, a); break;
            case K_MIXB: hipLaunchKernelGGL(mega_fwd<K_MIXB>, dim3(grid), dim3(512), LDS_BYTES, stream, a); break;
            case K_MIXC: hipLaunchKernelGGL(mega_fwd<K_MIXC>, dim3(grid), dim3(512), LDS_BYTES, stream, a); break;
            default:     hipLaunchKernelGGL(mega_fwd<K_WOUT>, dim3(grid), dim3(512), LDS_BYTES, stream, a); break;
        }
    }
#endif
}
```

```cpp
#include <hip/hip_runtime.h>
#include <cstdio>
#include <cstdint>
#ifndef MK_N_LAUNCHES
#define MK_N_LAUNCHES 1
#endif
namespace pg8 {
#define PG8_LAS __attribute__((address_space(3)))
typedef unsigned short bf16_t;
typedef short bf16x8 __attribute__((ext_vector_type(8)));
typedef float f32x4 __attribute__((ext_vector_type(4)));
typedef unsigned u32x4 __attribute__((ext_vector_type(4)));
constexpr int BM = 256, BK = 64, HALF = 128, HTB = HALF * BK * 2  , STAGE_BYTES = 8 * HTB, NXCD = 8, WGM = 8;

__host__ __device__ __forceinline__ int lds_byte(int r, int c) { const int st = (r >> 4) * 2 + (c >> 5), rr = r & 15, cc = c & 31, ob = rr * 64 + cc * 2; return st * 1024 + (ob ^ (((ob >> 9) & 1) << 5)); }
__host__ __device__ __forceinline__ void stage_rc(int b, int& R, int& C) { const int st = b / 1024, sb = b % 1024, swz = sb ^ (((sb >> 9) & 1) << 5); R = (st >> 1) * 16 + swz / 64; C = (st & 1) * 32 + (swz % 64) / 2; }
__host__ __device__ __forceinline__ int perm32(int rho) { const int n = rho >> 4, i = rho & 15; return 8 * (i >> 2) + 4 * n + (i & 3); }

struct Unit { int pm, pn; };
struct Gemm { const bf16_t* A; const bf16_t* Bt; int M, N, K; };

struct StaticOrder {
    int nM, nN, nwg, G, c;
    __host__ __device__ void init(int M, int N, int G_, int c_) { nM = M / BM; nN = N / BM; nwg = nM * nN; G = G_; c = c_; }
    __host__ __device__ bool next(int i, Unit& u) const {
        const long L = (long)i * G + c; if (L >= nwg) return false;
        int wgid = (int)L; { const int q = nwg / NXCD, r = nwg % NXCD, xcd = wgid % NXCD, off = wgid / NXCD; wgid = (xcd < r ? xcd * (q + 1) : r * (q + 1) + (xcd - r) * q) + off; }
        const int nig = WGM * nN, gid = wgid / nig, fm = gid * WGM, gsz = (nM - fm) < WGM ? (nM - fm) : WGM;
        u.pm = fm + ((wgid % nig) % gsz); u.pn = (wgid % nig) / gsz; return true;
    }
    __device__ __forceinline__ void a_ready(const Unit&) const {}
    __device__ __forceinline__ void done(const Unit&) const {}
};
__device__ __forceinline__ unsigned cvt_pk_bf16(float lo, float hi) { unsigned r; asm volatile("v_cvt_pk_bf16_f32 %0, %1, %2" : "=v"(r) : "v"(lo), "v"(hi)); return r; }
typedef int i32x8 __attribute__((ext_vector_type(8)));
typedef short s16x16 __attribute__((ext_vector_type(16)));
typedef int i32x4 __attribute__((ext_vector_type(4)));
template <class Epi, class Sched, bool ALIGN_EPI = false, bool SP2 = false, bool F8 = false, bool I8 = false>
__device__ __forceinline__ void gemm_phase(PG8_LAS unsigned char* lds, const Gemm g, const Sched& S, const Epi& E) {
    int tid_ = threadIdx.x; asm volatile("" : "+v"(tid_)); const int tid = tid_, wid = __builtin_amdgcn_readfirstlane(tid >> 6), lane = tid & 63, wr = wid >> 2, wc = wid & 3, fr = lane & 15, fq = lane >> 4;
    const int K = g.K, nt = K / BK;
    unsigned voffA[2], voffB[2];
#pragma unroll
    for (int i = 0; i < 2; ++i) { int R, C; stage_rc(tid * 16 + i * 8192, R, C); const int Rb = Epi::PERM ? ((R & ~31) + perm32(R & 31)) : R;
        voffA[i] = (unsigned)(R * K + C) * 2u; voffB[i] = (unsigned)(Rb * K + C) * 2u; }
    const size_t kstep = (size_t)(BK * 2);
    const size_t hstep = (size_t)HALF * K * 2;
    const size_t tstep = 2 * hstep;
    const unsigned ldsw = (unsigned)wid * 1024u;
    const int aoff = lds_byte(wr * 64 + fr, fq * 8), boff = lds_byte(wc * 32 + fr, fq * 8);
#define PG8_SA(b, h) (((b) * 2 + (h)) * HTB)
#define PG8_SB(b, h) ((4 + (b) * 2 + (h)) * HTB)
#define PG8_STAGE(bufoff, gbase, voff) do { _Pragma("unroll") for (int _i = 0; _i < 2; ++_i) \
        __builtin_amdgcn_global_load_lds((const unsigned*)((const char*)(gbase) + (voff)[_i]), (PG8_LAS unsigned*)(lds + (bufoff) + ldsw + _i * 8192), 16, 0, 0); } while (0)
#define PG8_LDA(dst, b, h) do { if constexpr (F8) { _Pragma("unroll") for (int m = 0; m < 4; ++m) dst##8[m] = PG8_CAT(*(const PG8_LAS bf16x8*)(lds + PG8_SA(b, h) + aoff + m * 2048), *(const PG8_LAS bf16x8*)(lds + PG8_SA(b, h) + aoff + m * 2048 + 1024)); } \
        else { _Pragma("unroll") for (int m = 0; m < 4; ++m) _Pragma("unroll") for (int k = 0; k < 2; ++k) dst[m][k] = *(const PG8_LAS bf16x8*)(lds + PG8_SA(b, h) + aoff + m * 2048 + k * 1024); } } while (0)
#define PG8_LDB(dst, b, h) do { if constexpr (F8) { _Pragma("unroll") for (int n = 0; n < 2; ++n) dst##8[n] = PG8_CAT(*(const PG8_LAS bf16x8*)(lds + PG8_SB(b, h) + boff + n * 2048), *(const PG8_LAS bf16x8*)(lds + PG8_SB(b, h) + boff + n * 2048 + 1024)); } \
        else { _Pragma("unroll") for (int n = 0; n < 2; ++n) _Pragma("unroll") for (int k = 0; k < 2; ++k) dst[n][k] = *(const PG8_LAS bf16x8*)(lds + PG8_SB(b, h) + boff + n * 2048 + k * 1024); } } while (0)
#define PG8_CAT(lo, hi) __builtin_bit_cast(i32x8, __builtin_shufflevector(lo, hi, 0, 1, 2, 3, 4, 5, 6, 7, 8, 9, 10, 11, 12, 13, 14, 15))
#define PG8_MMA(ai, bj, At, Bt) do { __builtin_amdgcn_s_setprio(1); _Pragma("unroll") for (int m = 0; m < 4; ++m) _Pragma("unroll") for (int n = 0; n < 2; ++n) { \
        if constexpr (F8) asm volatile("v_mfma_scale_f32_16x16x128_f8f6f4 %0, %1, %2, %0, %3, %3 op_sel_hi:[0,0,0]" : "+v"(acc[ai][bj][m][n]) : "v"(Bt##8[n]), "v"(At##8[m]), "v"(f8scale)); \
        else if constexpr (I8) { _Pragma("unroll") for (int k = 0; k < 2; ++k) acc[ai][bj][m][n] = __builtin_bit_cast(f32x4, __builtin_amdgcn_mfma_i32_16x16x64_i8(__builtin_bit_cast(i32x4, Bt[n][k]), __builtin_bit_cast(i32x4, At[m][k]), __builtin_bit_cast(i32x4, acc[ai][bj][m][n]), 0, 0, 0)); } \
        else { _Pragma("unroll") for (int k = 0; k < 2; ++k) acc[ai][bj][m][n] = __builtin_amdgcn_mfma_f32_16x16x32_bf16(Bt[n][k], At[m][k], acc[ai][bj][m][n], 0, 0, 0); } } \
        __builtin_amdgcn_s_setprio(0); } while (0)
#define PG8_WAIT_V(n) asm volatile("s_waitcnt vmcnt(" #n ")" ::: "memory")
#define PG8_WAIT_L(n) asm volatile("s_waitcnt lgkmcnt(" #n ")" ::: "memory")
#define PG8_BAR __builtin_amdgcn_s_barrier()
#define PG8_SCHED __builtin_amdgcn_sched_barrier(0)
    Unit cur, nxt; int ui = 0;
    if (!S.next(0, cur)) return;
    f32x4 acc[2][2][4][2];
#pragma unroll
    for (int a = 0; a < 2; ++a)
#pragma unroll
        for (int b = 0; b < 2; ++b)
#pragma unroll
            for (int m = 0; m < 4; ++m)
#pragma unroll
                for (int n = 0; n < 2; ++n) acc[a][b][m][n] = (f32x4){0.f, 0.f, 0.f, 0.f};
    bf16x8 At[4][2], B0[2][2], B1[2][2]; i32x8 At8[4], B08[2], B18[2];
    int f8scale = 0x7f7f7f7f; asm volatile("" : "+v"(f8scale));
    const char* cA = (const char*)g.A + (size_t)cur.pm * tstep; const char* cB = (const char*)g.Bt + (size_t)cur.pn * tstep;
    S.a_ready(cur);
    if constexpr (SP2) {
        PG8_STAGE(PG8_SB(0, 0), cB, voffB); PG8_STAGE(PG8_SB(0, 1), cB + hstep, voffB); PG8_STAGE(PG8_SA(0, 0), cA, voffA); PG8_STAGE(PG8_SA(0, 1), cA + hstep, voffA);
        if (wr == 1) PG8_BAR;
        PG8_WAIT_V(2); PG8_BAR;
        PG8_STAGE(PG8_SB(1, 0), cB + kstep, voffB); PG8_STAGE(PG8_SA(1, 0), cA + kstep, voffA); PG8_STAGE(PG8_SB(1, 1), cB + hstep + kstep, voffB);
        PG8_WAIT_V(6); PG8_BAR;
    } else {
        PG8_STAGE(PG8_SB(0, 0), cB, voffB); PG8_STAGE(PG8_SA(0, 0), cA, voffA); PG8_STAGE(PG8_SB(0, 1), cB + hstep, voffB); PG8_STAGE(PG8_SA(0, 1), cA + hstep, voffA);
        if (wr == 1) PG8_BAR;
        PG8_WAIT_V(4); PG8_BAR;
        PG8_STAGE(PG8_SB(1, 0), cB + kstep, voffB); PG8_STAGE(PG8_SA(1, 0), cA + kstep, voffA); PG8_STAGE(PG8_SB(1, 1), cB + hstep + kstep, voffB);
        PG8_WAIT_V(6); PG8_BAR;
    }
    for (;;) {
        const bool has_next = S.next(ui + 1, nxt);
        const char* nA = has_next ? (const char*)g.A + (size_t)nxt.pm * tstep : cA; const char* nB = has_next ? (const char*)g.Bt + (size_t)nxt.pn * tstep : cB;
        for (int t = 0; t < nt; t += 2) {
            const bool last = (t == nt - 2);
            const char* a1 = cA + (size_t)(t + 1) * kstep;
            const char* a2 = last ? nA : cA + (size_t)(t + 2) * kstep; const char* b2 = last ? nB : cB + (size_t)(t + 2) * kstep;
            const char* a3 = a2 + kstep; const char* b3 = b2 + kstep;
            if (last && has_next) S.a_ready(nxt);
            if constexpr (SP2) {
            PG8_LDB(B0, 0, 0); PG8_LDB(B1, 0, 1); PG8_SCHED; PG8_LDA(At, 0, 0); PG8_STAGE(PG8_SA(1, 1), a1 + hstep, voffA);
            PG8_WAIT_V(8); PG8_WAIT_L(0); PG8_BAR; PG8_MMA(0, 0, At, B0); PG8_MMA(0, 1, At, B1); PG8_BAR; PG8_SCHED;
            PG8_LDA(At, 0, 1); PG8_STAGE(PG8_SB(0, 0), b2, voffB); PG8_STAGE(PG8_SB(0, 1), b2 + hstep, voffB); PG8_STAGE(PG8_SA(0, 0), a2, voffA);
            PG8_WAIT_V(8); PG8_WAIT_L(0); PG8_BAR; PG8_MMA(1, 0, At, B0); PG8_MMA(1, 1, At, B1); PG8_BAR; PG8_SCHED;
            PG8_LDB(B0, 1, 0); PG8_LDB(B1, 1, 1); PG8_SCHED; PG8_LDA(At, 1, 0); PG8_STAGE(PG8_SA(0, 1), a2 + hstep, voffA);
            PG8_WAIT_V(8); PG8_WAIT_L(0); PG8_BAR; PG8_MMA(0, 0, At, B0); PG8_MMA(0, 1, At, B1); PG8_BAR; PG8_SCHED;
            PG8_LDA(At, 1, 1); PG8_STAGE(PG8_SB(1, 0), b3, voffB); PG8_STAGE(PG8_SB(1, 1), b3 + hstep, voffB); PG8_STAGE(PG8_SA(1, 0), a3, voffA);
            PG8_WAIT_V(8); PG8_WAIT_L(0); PG8_BAR; PG8_MMA(1, 0, At, B0); PG8_MMA(1, 1, At, B1); PG8_BAR; PG8_SCHED;
            } else {
            PG8_LDB(B0, 0, 0); PG8_SCHED; PG8_LDA(At, 0, 0); PG8_STAGE(PG8_SA(1, 1), a1 + hstep, voffA);
            PG8_WAIT_L(8); PG8_BAR; PG8_WAIT_L(0); PG8_MMA(0, 0, At, B0); PG8_BAR; PG8_SCHED;
            PG8_LDB(B1, 0, 1); PG8_STAGE(PG8_SB(0, 0), b2, voffB);
            PG8_BAR; PG8_WAIT_L(0); PG8_MMA(0, 1, At, B1); PG8_BAR;
            PG8_LDA(At, 0, 1); PG8_STAGE(PG8_SA(0, 0), a2, voffA);
            PG8_BAR; PG8_WAIT_L(0); PG8_MMA(1, 0, At, B0); PG8_BAR; PG8_SCHED;
            PG8_STAGE(PG8_SB(0, 1), b2 + hstep, voffB);
            PG8_WAIT_V(6); PG8_BAR; PG8_MMA(1, 1, At, B1); PG8_BAR;
            PG8_LDB(B0, 1, 0); PG8_SCHED; PG8_LDA(At, 1, 0); PG8_STAGE(PG8_SA(0, 1), a2 + hstep, voffA);
            PG8_WAIT_L(8); PG8_BAR; PG8_WAIT_L(0); PG8_MMA(0, 0, At, B0); PG8_BAR; PG8_SCHED;
            PG8_LDB(B1, 1, 1); PG8_STAGE(PG8_SB(1, 0), b3, voffB);
            PG8_BAR; PG8_WAIT_L(0); PG8_MMA(0, 1, At, B1); PG8_BAR;
            PG8_LDA(At, 1, 1); PG8_STAGE(PG8_SA(1, 0), a3, voffA);
            PG8_BAR; PG8_WAIT_L(0); PG8_MMA(1, 0, At, B0); PG8_BAR; PG8_SCHED;
            PG8_STAGE(PG8_SB(1, 1), b3 + hstep, voffB);
            PG8_WAIT_V(6); PG8_BAR; PG8_MMA(1, 1, At, B1); PG8_BAR;
            }
        }
        if constexpr (F8) asm volatile("s_nop 7\n\ts_nop 7\n\ts_nop 7" ::: "memory");
        if constexpr (I8) {
#pragma unroll
            for (int a = 0; a < 2; ++a)
#pragma unroll
                for (int b = 0; b < 2; ++b)
#pragma unroll
                    for (int m = 0; m < 4; ++m)
#pragma unroll
                        for (int n = 0; n < 2; ++n) { const i32x4 iv = __builtin_bit_cast(i32x4, acc[a][b][m][n]); acc[a][b][m][n] = (f32x4){(float)iv[0], (float)iv[1], (float)iv[2], (float)iv[3]}; }
        }
        if constexpr (ALIGN_EPI) { if (wr == 0) PG8_BAR; }
#if defined(PROBE_EPI) && PROBE_EPI
        { const unsigned long long te0_ = __builtin_amdgcn_s_memrealtime();
          if constexpr (!Epi::AFTER_DRAIN) { E(acc, cur, wr, wc, fr, fq); S.done(cur); }
          const unsigned long long ted_ = __builtin_amdgcn_s_memrealtime() - te0_, ts_ = __builtin_amdgcn_s_memrealtime();
          while (__builtin_amdgcn_s_memrealtime() - ts_ < ted_) __builtin_amdgcn_s_sleep(1); }
#else
        if constexpr (!Epi::AFTER_DRAIN) { E(acc, cur, wr, wc, fr, fq); S.done(cur); }
#endif
        if (!has_next) break;
#pragma unroll
        for (int a = 0; a < 2; ++a)
#pragma unroll
            for (int b = 0; b < 2; ++b)
#pragma unroll
                for (int m = 0; m < 4; ++m)
#pragma unroll
                    for (int n = 0; n < 2; ++n) acc[a][b][m][n] = (f32x4){0.f, 0.f, 0.f, 0.f};
        cur = nxt; cA = nA; cB = nB; ++ui;
        if constexpr (ALIGN_EPI) { if (wr == 1) PG8_BAR; }
    }
    PG8_WAIT_V(0);
    if constexpr (!ALIGN_EPI) { if (wr == 0) PG8_BAR; }
    PG8_BAR;
    if constexpr (Epi::AFTER_DRAIN) { E.fused(acc, cur, wr, wc, fr, fq, lds, wid, lane); S.done(cur); }
#undef PG8_SA
#undef PG8_SB
#undef PG8_STAGE
#undef PG8_LDA
#undef PG8_LDB
#undef PG8_MMA
#undef PG8_CAT
#undef PG8_WAIT_V
#undef PG8_WAIT_L
#undef PG8_BAR
#undef PG8_SCHED
}
}
#ifndef PROBE_DUP
#define PROBE_DUP 0
#endif
#define REP(k) (PROBE_DUP == (k) ? 2 : 1)
#ifndef PROBE_AMP_MASK
#define PROBE_AMP_MASK 0
#endif
#ifndef PROBE_AMP_BAR
#define PROBE_AMP_BAR 0
#endif

constexpr int DM = 2048, NTOK = 16384, NCTX = 8192, CTX_T = 256, LAT_T = 4096, PAST = 512;
constexpr int DFF = 5632, NFF2 = 11264, INC = 5120, MODW = 18432, ZBC = 4096;
constexpr int ZQ = 0, ZK = 1024, ZV = 1280, ZRQ = 1536, ZRF = 2048, ZRB = 2560, ZRI = 3072, ZRG = 3584, ZCA = 4096, ZCB = 4608;
constexpr float EPS = 1e-6f;
constexpr size_t OUT_Y = 0, OUT_CK = 33554432, OUT_CV = 37748736, OUT_ST = 41943040, OUT_TOTAL = 50331648;
constexpr size_t MiB = 1u << 20;
constexpr size_t WS_RS0 = 0;
constexpr size_t WS_CTL = 1242 * MiB, WS_MOD = 1243 * MiB, CTL_ZERO_BYTES = 2 * MiB;
constexpr size_t WS_WFI = 2 * MiB;
constexpr size_t WS_WFO = 178 * MiB;
constexpr size_t WS_WIN = 266 * MiB;
constexpr size_t WS_WOUT = 306 * MiB;
constexpr size_t WS_H = 322 * MiB;
constexpr size_t WS_MIX = 386 * MiB;
constexpr size_t WS_Z = 450 * MiB;
constexpr size_t WS_LF = 578 * MiB;
constexpr size_t WS_US = 770 * MiB;
constexpr size_t WS_KP = 898 * MiB;
constexpr size_t WS_VP = 914 * MiB;
constexpr size_t WS_DEC = 1026 * MiB;
constexpr size_t WS_Q = 1028 * MiB;
constexpr size_t WS_K = 1060 * MiB;
constexpr size_t WS_V = 1068 * MiB;
constexpr size_t WS_CK = 1076 * MiB;
constexpr size_t WS_CV = 1077 * MiB;
constexpr size_t WS_GLU = 1078 * MiB;
constexpr size_t WS_ST16 = 1110 * MiB;
constexpr size_t WS_BIAS = 1238 * MiB;
constexpr size_t WS_GV = 1239 * MiB;
constexpr size_t WS_MODI = 1240 * MiB;
constexpr size_t WS_SSQ = 1241 * MiB;
constexpr size_t WS_END = 1242 * MiB;
constexpr size_t WS_W8 = 1244 * MiB;
constexpr size_t W8_STRIDE = 34 * MiB, W8O_OFF = 22 * MiB;
constexpr size_t WS_TOP = WS_W8 + 4 * W8_STRIDE;
constexpr float W8I_SC = 32.f, W8O_SC = 256.f;
#ifndef FP8_MASK
#define FP8_MASK 15
#endif
#ifndef FP8_MASK_OUT
#define FP8_MASK_OUT 15
#endif
#ifndef FFI_INT8
#define FFI_INT8 1
#endif
constexpr float I8_C = 6.5f;
constexpr float I8_WSC = 127.f / 0.1f;
constexpr bool f8on(int f) { return f >= (FFI_INT8 ? 0 : 1) && f <= 3 && ((FP8_MASK >> f) & 1); }
constexpr bool f8out(int f) { return f >= 0 && f <= 3 && ((FP8_MASK_OUT >> f) & 1); }
constexpr size_t WS_LBV = WS_MOD + 512 * 1024;
constexpr float FXM = 1073741824.f, IFXM = 1.f / 1073741824.f, FXS = 1048576.f, IFXS = 1.f / 1048576.f;
constexpr int CW_BAR = 4096;
constexpr int RING_BYTES = 131072, LDSCTL_OFF = RING_BYTES, LDS_BYTES = 147456;

#define GAS __attribute__((address_space(1)))
#define LAS __attribute__((address_space(3)))
typedef unsigned short bf16;
typedef unsigned v4u __attribute__((ext_vector_type(4)));
typedef unsigned v2u __attribute__((ext_vector_type(2)));
typedef float f32x4 __attribute__((ext_vector_type(4)));
typedef float f32x2 __attribute__((ext_vector_type(2)));
typedef short bf16x8 __attribute__((ext_vector_type(8)));
#define LDS_WAIT() asm volatile("s_waitcnt lgkmcnt(0)" ::: "memory")
#define VM_WAIT() asm volatile("s_waitcnt vmcnt(0)" ::: "memory")
#define LDS_BARRIER() do { asm volatile("s_waitcnt lgkmcnt(0)" ::: "memory"); __builtin_amdgcn_s_barrier(); asm volatile("" ::: "memory"); } while (0)
__device__ __forceinline__ unsigned pk2(float lo, float hi) { return pg8::cvt_pk_bf16(lo, hi); }
__device__ __forceinline__ float bf2f(unsigned x) { return __uint_as_float(x << 16); }
__device__ __forceinline__ int qi8(float x) { const int i = (int)__builtin_rintf(x); return i < -127 ? -127 : (i > 127 ? 127 : i); }
__device__ __forceinline__ unsigned pki8(float a, float b, float c, float d) { return (unsigned)(qi8(a) & 255) | ((unsigned)(qi8(b) & 255) << 8) | ((unsigned)(qi8(c) & 255) << 16) | ((unsigned)qi8(d) << 24); }
__device__ __forceinline__ float i8f(unsigned w, int b) { return (float)((int)(w << (24 - 8 * b)) >> 24); }
__device__ __forceinline__ unsigned pk8(float a, float b, float c, float d) { int w = __builtin_amdgcn_cvt_pk_fp8_f32(a, b, 0, false); w = __builtin_amdgcn_cvt_pk_fp8_f32(c, d, w, true); return (unsigned)w; }
__device__ __forceinline__ unsigned short f2bf(float f) { return (unsigned short)(pg8::cvt_pk_bf16(f, 0.f) & 0xffffu); }
#ifndef EMU_FP8
#define EMU_FP8 0
#endif
__device__ __forceinline__ float q8(float x) { const int w = __builtin_amdgcn_cvt_pk_fp8_f32(x, x, 0, false); return __builtin_amdgcn_cvt_f32_fp8(w, 0); }
__device__ __forceinline__ float q8s(float x, float sc, float isc) { return q8(x * sc) * isc; }
__device__ __forceinline__ float sigm(float x) { return __builtin_amdgcn_rcpf(1.f + __expf(-x)); }
__device__ __forceinline__ float siluf(float x) { return x * __builtin_amdgcn_rcpf(1.f + __expf(-x)); }
template <int CTRL> __device__ __forceinline__ float dpp_get(float v) { return __builtin_bit_cast(float, __builtin_amdgcn_update_dpp(0, __builtin_bit_cast(int, v), CTRL, 0xF, 0xF, true)); }
__device__ __forceinline__ float row_sum16(float v) {
    v += dpp_get<0xB1>(v);
    v += dpp_get<0x4E>(v);
    v += dpp_get<0x141>(v);
    v += dpp_get<0x140>(v);
    return v;
}
__device__ __forceinline__ float xrow_sum(float v) {
    { const auto r = __builtin_amdgcn_permlane16_swap(__float_as_uint(v), __float_as_uint(v), false, false); v = __uint_as_float(r[0]) + __uint_as_float(r[1]); }
    { const auto r = __builtin_amdgcn_permlane32_swap(__float_as_uint(v), __float_as_uint(v), false, false); v = __uint_as_float(r[0]) + __uint_as_float(r[1]); }
    return v;
}
__device__ __forceinline__ float wave_sum(float v) { return xrow_sum(row_sum16(v)); }
__device__ __forceinline__ float wave_max(float v) {
    v = fmaxf(v, dpp_get<0xB1>(v)); v = fmaxf(v, dpp_get<0x4E>(v)); v = fmaxf(v, dpp_get<0x141>(v)); v = fmaxf(v, dpp_get<0x140>(v));
    { const auto r = __builtin_amdgcn_permlane16_swap(__float_as_uint(v), __float_as_uint(v), false, false); v = fmaxf(__uint_as_float(r[0]), __uint_as_float(r[1])); }
    { const auto r = __builtin_amdgcn_permlane32_swap(__float_as_uint(v), __float_as_uint(v), false, false); v = fmaxf(__uint_as_float(r[0]), __uint_as_float(r[1])); }
    return v;
}

namespace pg8 {
struct EpiF32 {
    static constexpr bool PERM = false, AFTER_DRAIN = false;
    float* C; int ldc;
    __device__ __forceinline__ void operator()(const f32x4 (&acc)[2][2][4][2], const Unit& u, int wr, int wc, int fr, int fq) const {
        const int row0 = u.pm * BM + wr * 64 + fr, col0 = u.pn * BM + wc * 32 + 4 * fq;
#pragma unroll
        for (int ai = 0; ai < 2; ++ai)
#pragma unroll
            for (int m = 0; m < 4; ++m) { float* rowp = C + (size_t)(row0 + ai * HALF + m * 16) * ldc + col0;
#pragma unroll
                for (int bj = 0; bj < 2; ++bj)
#pragma unroll
                    for (int n = 0; n < 2; ++n) *(f32x4*)(rowp + bj * HALF + n * 16) = acc[ai][bj][m][n]; }
    }
};
struct EpiWin {
    static constexpr bool PERM = true, AFTER_DRAIN = false;
    unsigned char* ws; int l, slot;
    __device__ __forceinline__ void operator()(const f32x4 (&acc)[2][2][4][2], const Unit& u, int wr, int wc, int fr, int fq) const {
        bf16_t* Zb = (bf16_t*)(ws + WS_Z); float* LF = (float*)(ws + WS_LF); const float* lbv = (const float*)(ws + WS_LBV) + l * 1024; bf16_t* GLU = (bf16_t*)(ws + WS_GLU);
        const unsigned long long* ssq = (const unsigned long long*)(ws + WS_SSQ) + (size_t)slot * NTOK; const float* bias = (const float*)(ws + WS_BIAS) + (size_t)slot * 3 * NFF2;
        const int row0 = u.pm * BM + wr * 64 + fr, col0 = u.pn * BM + wc * 32 + 8 * fq;
        const int cond = u.pm < 32 ? 0 : 1 + ((u.pm - 32) >> 4);
        const bool gate = u.pn >= 8 && u.pn < 12;
        f32x4 bv[2][2], lb[2][2]; unsigned long long sq[2][4];
#pragma unroll
        for (int bj = 0; bj < 2; ++bj)
#pragma unroll
            for (int n = 0; n < 2; ++n) { bv[bj][n] = *(const f32x4*)(bias + (size_t)cond * 11264 + col0 + bj * HALF + 4 * n);
                lb[bj][n] = gate ? *(const f32x4*)(lbv + (col0 - 2048) + bj * HALF + 4 * n) : (f32x4){0.f, 0.f, 0.f, 0.f}; }
#pragma unroll
        for (int ai = 0; ai < 2; ++ai)
#pragma unroll
            for (int m = 0; m < 4; ++m) sq[ai][m] = ssq[row0 + ai * HALF + m * 16];
        asm volatile("" ::: "memory");
        if (gate) {
#pragma unroll
            for (int ai = 0; ai < 2; ++ai)
#pragma unroll
                for (int m = 0; m < 4; ++m) { const int row = row0 + ai * HALF + m * 16; const float rs = __builtin_amdgcn_rsqf((float)sq[ai][m] * (IFXS / 2048.f) + 1e-6f);
#pragma unroll
                    for (int bj = 0; bj < 2; ++bj) { float kv[8]; f32x4 lv[2];
#pragma unroll
                        for (int n = 0; n < 2; ++n)
#pragma unroll
                            for (int j = 0; j < 4; ++j) { const float z = fminf(fmaxf(acc[ai][bj][m][n][j] * rs + bv[bj][n][j], -80.f), 80.f), lbj = lb[bj][n][j], ez = __expf(-z);
                                const float sg = __builtin_amdgcn_rcpf(1.f + ez), sn = ez * sg;
                                kv[4 * n + j] = (1.f - lbj) * sn; lv[n][j] = __logf(fmaxf(lbj + (1.f - lbj) * sg, 1e-30f)); }
                        u32x4 w; w.x = cvt_pk_bf16(kv[0], kv[1]); w.y = cvt_pk_bf16(kv[2], kv[3]); w.z = cvt_pk_bf16(kv[4], kv[5]); w.w = cvt_pk_bf16(kv[6], kv[7]);
                        *(u32x4*)(Zb + (size_t)row * ZBC + col0 + bj * HALF) = w;
                        float* lp = LF + (size_t)row * 1024 + (col0 - 2048) + bj * HALF; *(f32x4*)lp = lv[0]; *(f32x4*)(lp + 4) = lv[1]; } }
        } else if (u.pn >= 16) {
            const int c0 = (u.pn - 16) * HALF + wc * 32 + 8 * fq;
#pragma unroll
            for (int ai = 0; ai < 2; ++ai)
#pragma unroll
                for (int m = 0; m < 4; ++m) { const int row = row0 + ai * HALF + m * 16; const float rs = __builtin_amdgcn_rsqf((float)sq[ai][m] * (IFXS / 2048.f) + 1e-6f);
                    float gv[8];
#pragma unroll
                    for (int n = 0; n < 2; ++n)
#pragma unroll
                        for (int j = 0; j < 4; ++j) { const float a = acc[ai][0][m][n][j] * rs + bv[0][n][j], b = acc[ai][1][m][n][j] * rs + bv[1][n][j]; gv[4 * n + j] = a * __builtin_amdgcn_rcpf(1.f + __expf(-b)); }
                    u32x4 w; w.x = cvt_pk_bf16(gv[0], gv[1]); w.y = cvt_pk_bf16(gv[2], gv[3]); w.z = cvt_pk_bf16(gv[4], gv[5]); w.w = cvt_pk_bf16(gv[6], gv[7]);
                    *(u32x4*)(GLU + (size_t)row * 512 + c0) = w; }
        } else {
#pragma unroll
            for (int ai = 0; ai < 2; ++ai)
#pragma unroll
                for (int m = 0; m < 4; ++m) { const int row = row0 + ai * HALF + m * 16; const float rs = __builtin_amdgcn_rsqf((float)sq[ai][m] * (IFXS / 2048.f) + 1e-6f);
#pragma unroll
                    for (int bj = 0; bj < 2; ++bj) { const f32x4 z0 = acc[ai][bj][m][0] * rs + bv[bj][0], z1 = acc[ai][bj][m][1] * rs + bv[bj][1];
                        u32x4 w; w.x = cvt_pk_bf16(z0[0], z0[1]); w.y = cvt_pk_bf16(z0[2], z0[3]); w.z = cvt_pk_bf16(z1[0], z1[1]); w.w = cvt_pk_bf16(z1[2], z1[3]);
                        *(u32x4*)(Zb + (size_t)row * ZBC + col0 + bj * HALF) = w; } }
        }
    }
};
template <bool O8, bool I8 = false>
struct EpiSwiGLUT {
    static constexpr bool PERM = true, AFTER_DRAIN = false;
    unsigned char* ws; int slot; float accs;
    __device__ __forceinline__ void operator()(const f32x4 (&acc)[2][2][4][2], const Unit& u, int wr, int wc, int fr, int fq) const {
        bf16_t* O = (bf16_t*)(ws + WS_Z); constexpr int ldc = DFF; const unsigned long long* ssq = (const unsigned long long*)(ws + WS_SSQ) + (size_t)slot * NTOK; const float* bias = (const float*)(ws + WS_BIAS) + (size_t)slot * 3 * NFF2;
        const int row0 = u.pm * BM + wr * 64 + fr, col0 = u.pn * HALF + wc * 32 + 8 * fq;
        const int cond = u.pm < 32 ? 0 : 1 + ((u.pm - 32) >> 4);
        const float* bp = bias + (size_t)cond * 11264 + u.pn * BM + wc * 32 + 8 * fq;
        f32x4 bA[2], bB[2];
#pragma unroll
        for (int n = 0; n < 2; ++n) { bA[n] = *(const f32x4*)(bp + 4 * n); bB[n] = *(const f32x4*)(bp + HALF + 4 * n); }
        unsigned long long sq[2][4], sqp[2][4]; float rs0[2][4];
#pragma unroll
        for (int ai = 0; ai < 2; ++ai)
#pragma unroll
            for (int m = 0; m < 4; ++m) { sq[ai][m] = ssq[row0 + ai * HALF + m * 16]; sqp[ai][m] = (I8 && slot != 0) ? (ssq - NTOK)[row0 + ai * HALF + m * 16] : 0ull; rs0[ai][m] = (I8 && slot == 0) ? ((const float*)(ws + WS_RS0))[row0 + ai * HALF + m * 16] : 0.f; }
        asm volatile("" ::: "memory");
        typedef float f32x2 __attribute__((ext_vector_type(2)));
        constexpr float NL2E = -1.4426950408889634f;
        f32x4 nbA[2];
#pragma unroll
        for (int n = 0; n < 2; ++n) nbA[n] = bA[n] * NL2E;
#pragma unroll
        for (int ai = 0; ai < 2; ++ai)
#pragma unroll
            for (int m = 0; m < 4; ++m) { const int row = row0 + ai * HALF + m * 16; bf16_t* rowp = O + (size_t)row * ldc + col0;
                const float rs = __builtin_amdgcn_rsqf((float)sq[ai][m] * (IFXS / 2048.f) + 1e-6f) * accs * (I8 ? (slot == 0 ? rs0[ai][m] : (I8_C / 127.f) * __builtin_sqrtf((float)sqp[ai][m] * (IFXS / 2048.f) + 1e-6f)) : 1.f), nrs = rs * NL2E;
                const f32x2 rs2 = {rs, rs}, nrs2 = {nrs, nrs}, one2 = {1.f, 1.f};
                f32x2 o[4];
#pragma unroll
                for (int n = 0; n < 2; ++n)
#pragma unroll
                    for (int hh = 0; hh < 2; ++hh) {
                        const f32x4 a4 = acc[ai][0][m][n], b4 = acc[ai][1][m][n];
                        const f32x2 aa = hh ? __builtin_shufflevector(a4, a4, 2, 3) : __builtin_shufflevector(a4, a4, 0, 1), bb = hh ? __builtin_shufflevector(b4, b4, 2, 3) : __builtin_shufflevector(b4, b4, 0, 1);
                        const f32x2 ba = hh ? __builtin_shufflevector(bA[n], bA[n], 2, 3) : __builtin_shufflevector(bA[n], bA[n], 0, 1), bbv = hh ? __builtin_shufflevector(bB[n], bB[n], 2, 3) : __builtin_shufflevector(bB[n], bB[n], 0, 1);
                        const f32x2 nba = hh ? __builtin_shufflevector(nbA[n], nbA[n], 2, 3) : __builtin_shufflevector(nbA[n], nbA[n], 0, 1);
                        const f32x2 za = aa * rs2 + ba, zb = bb * rs2 + bbv, t = aa * nrs2 + nba;
                        f32x2 e; e.x = __builtin_amdgcn_exp2f(t.x); e.y = __builtin_amdgcn_exp2f(t.y);
                        const f32x2 dn = e + one2; f32x2 r; r.x = __builtin_amdgcn_rcpf(dn.x); r.y = __builtin_amdgcn_rcpf(dn.y);
                        o[n * 2 + hh] = (za * zb) * r; }
                if constexpr (O8) { v2u w8; w8.x = pk8(o[0].x, o[0].y, o[1].x, o[1].y); w8.y = pk8(o[2].x, o[2].y, o[3].x, o[3].y);
                    *(v2u*)((unsigned char*)O + (size_t)row * ldc + col0) = w8; }
                else { u32x4 w; w.x = cvt_pk_bf16(o[0].x, o[0].y); w.y = cvt_pk_bf16(o[1].x, o[1].y); w.z = cvt_pk_bf16(o[2].x, o[2].y); w.w = cvt_pk_bf16(o[3].x, o[3].y);
                    __builtin_nontemporal_store(w, (u32x4*)rowp); } }
    }
};
using EpiSwiGLU = EpiSwiGLUT<false>;
template <bool H8, bool HI8 = false>
struct EpiResidNormT {
    static constexpr bool PERM = true, AFTER_DRAIN = false;
    unsigned char* ws; float* X; const float* gb; int goff, nslot; float scale;
    const float* xin_p; const float* xin_s;
    __device__ __forceinline__ void operator()(const f32x4 (&acc)[2][2][4][2], const Unit& u, int wr, int wc, int fr, int fq) const {
        const float* gm = (const float*)(ws + WS_MOD) + goff; bf16_t* H = (bf16_t*)(ws + WS_H);
        const float* gnext = nslot >= 0 ? (const float*)(ws + WS_GV) + (size_t)nslot * 3 * DM : nullptr; unsigned long long* ssq_next = (unsigned long long*)(ws + WS_SSQ) + (size_t)(nslot >= 0 ? nslot : 0) * NTOK;
        const int row0 = u.pm * BM + wr * 64 + fr, col0 = u.pn * BM + wc * 32 + 8 * fq;
        const int cond = u.pm < 32 ? 0 : 1 + ((u.pm - 32) >> 4);
        const float* g0 = gm + (size_t)cond * 2 * 18432;
        const bool nx = gnext != nullptr;
        const float* Xrd = xin_p ? (u.pm < 32 ? xin_p : xin_s - (size_t)NCTX * DM) : X;
#ifndef RN_DEPTH
#define RN_DEPTH 6
#endif
        float qsr[8];
#pragma unroll
        for (int it = 0; it < 8; ++it) qsr[it] = (H8 && HI8) ? (127.f / I8_C) * __builtin_amdgcn_rsqf((float)(ssq_next - NTOK)[row0 + (it >> 2) * HALF + (it & 3) * 16] * (IFXS / 2048.f) + 1e-6f) : 0.f;
#define RN_ADV(r, st) do { r += (((st) & 3) == 3) ? 80 : 16; asm volatile("" : "+v"(r)); } while (0)
#define RN_LOAD(st, bj) do { const float* rp_ = Xrd + (size_t)rl * 2048 + col0 + (bj) * HALF; \
            xb[(st) % RN_DEPTH][0] = *(const f32x4*)rp_; xb[(st) % RN_DEPTH][1] = *(const f32x4*)(rp_ + 4); RN_ADV(rl, st); } while (0)
#pragma unroll
        for (int bj = 0; bj < 2; ++bj) {
            const f32x4 gv0 = (*(const f32x4*)(g0 + col0 + bj * HALF) + *(const f32x4*)(gb + col0 + bj * HALF)) * scale, gv1 = (*(const f32x4*)(g0 + col0 + bj * HALF + 4) + *(const f32x4*)(gb + col0 + bj * HALF + 4)) * scale;
            const f32x4 gn0 = nx ? *(const f32x4*)(gnext + (size_t)cond * 2048 + col0 + bj * HALF) : (f32x4){0.f, 0.f, 0.f, 0.f}, gn1 = nx ? *(const f32x4*)(gnext + (size_t)cond * 2048 + col0 + bj * HALF + 4) : (f32x4){0.f, 0.f, 0.f, 0.f};
            f32x4 xb[RN_DEPTH][2];
            int rl = row0, rw = row0; asm volatile("" : "+v"(rl), "+v"(rw));
#pragma unroll
            for (int st = 0; st < RN_DEPTH; ++st) RN_LOAD(st, bj);
            asm volatile("" ::: "memory");
#pragma unroll
            for (int it = 0; it < 8; ++it) { const int ai = it >> 2, m = it & 3; f32x4* p0 = (f32x4*)(X + (size_t)rw * 2048 + col0 + bj * HALF);
                const f32x4 x0 = xb[it % RN_DEPTH][0] + gv0 * acc[ai][bj][m][0], x1 = xb[it % RN_DEPTH][1] + gv1 * acc[ai][bj][m][1];
                p0[0] = x0; p0[1] = x1;
                if (nx) { const f32x4 h0 = x0 * gn0, h1 = x1 * gn1;
                    if constexpr (H8 && HI8) { const float qs = qsr[it];
                        v2u w8; w8.x = pki8(h0[0] * qs, h0[1] * qs, h0[2] * qs, h0[3] * qs); w8.y = pki8(h1[0] * qs, h1[1] * qs, h1[2] * qs, h1[3] * qs); *(v2u*)((unsigned char*)H + (size_t)rw * 2048 + col0 + bj * HALF) = w8; }
                    else if constexpr (H8) { v2u w8; w8.x = pk8(h0[0], h0[1], h0[2], h0[3]); w8.y = pk8(h1[0], h1[1], h1[2], h1[3]); *(v2u*)((unsigned char*)H + (size_t)rw * 2048 + col0 + bj * HALF) = w8; }
                    else { u32x4 w; w.x = cvt_pk_bf16(h0[0], h0[1]); w.y = cvt_pk_bf16(h0[2], h0[3]); w.z = cvt_pk_bf16(h1[0], h1[1]); w.w = cvt_pk_bf16(h1[2], h1[3]);
                        *(u32x4*)(H + (size_t)rw * 2048 + col0 + bj * HALF) = w; }
                    float ss = (x0[0] * x0[0] + x0[1] * x0[1]) + (x0[2] * x0[2] + x0[3] * x0[3]) + (x1[0] * x1[0] + x1[1] * x1[1]) + (x1[2] * x1[2] + x1[3] * x1[3]);
                    ss = xrow_sum(ss); if (fq == 0) atomicAdd(ssq_next + rw, __float2ull_rn(ss * FXS)); }
                RN_ADV(rw, it);
                asm volatile("" ::: "memory");
                if (it + RN_DEPTH < 8) { RN_LOAD(it + RN_DEPTH, bj); asm volatile("" ::: "memory"); } }
        }
#undef RN_LOAD
#undef RN_ADV
    }
};
using EpiResidNorm = EpiResidNormT<false>;
}
#define XB_TMO      128
#define XB_XCNT(j)  (256  + 64 * (j))
#define XB_XSUB(j)  (1280 + 64 * (j))
#define XB_XGEN(j)  (2304 + 64 * (j))
#define XB_TOP      3328
#define XB_TOPGEN   3392
#define XCD_BAR_WORDS 3456
#define XB_SPIN_CAP (1u << 18)

__device__ __forceinline__ unsigned xb_ld(unsigned* p)              { return __hip_atomic_load(p, __ATOMIC_RELAXED, __HIP_MEMORY_SCOPE_AGENT); }
__device__ __forceinline__ unsigned xb_add(unsigned* p, unsigned v) { return __hip_atomic_fetch_add(p, v, __ATOMIC_RELAXED, __HIP_MEMORY_SCOPE_AGENT); }
__device__ __forceinline__ unsigned xb_xcc_id() { return (unsigned)__builtin_amdgcn_s_getreg((3 << 11) | 20) & 0xFu; }
#define XB_SPIN(cond, bar) do { unsigned _sp = 0; while (cond) { __builtin_amdgcn_s_sleep(1); \
    if ((++_sp & 255u) == 0u) { if (xb_ld(&(bar)[XB_TMO])) break; if (_sp > XB_SPIN_CAP) { atomicAdd(&(bar)[XB_TMO], 1u); break; } } } } while (0)

struct XcdBarrier {
    unsigned* bar; unsigned x;
    volatile LAS unsigned* st;
};

__device__ __forceinline__ XcdBarrier xcd_barrier_post(unsigned* bar, volatile LAS unsigned* st) {
    XcdBarrier b; b.bar = bar; b.x = xb_xcc_id(); b.st = st;
    if (threadIdx.x == 0) (void)xb_add(&bar[XB_XCNT(b.x)], 1u);
    return b;
}
__device__ __forceinline__ void xcd_barrier_complete(unsigned* bar, unsigned x, unsigned& nloc, unsigned& nx) {
    const unsigned G = gridDim.x * gridDim.y * gridDim.z;
    unsigned sum, cnt, mine, sp = 0u;
    for (;;) {
        sum = 0u; cnt = 0u; mine = 0u;
#pragma unroll
        for (unsigned j = 0; j < 16; ++j) { const unsigned c = xb_ld(&bar[XB_XCNT(j)]); sum += c; cnt += (c > 0u) ? 1u : 0u; mine = (j == x) ? c : mine; }
        if (sum == G) break;
        __builtin_amdgcn_s_sleep(1);
        if ((++sp & 255u) == 0u) { if (xb_ld(&bar[XB_TMO])) break; if (sp > XB_SPIN_CAP) { atomicAdd(&bar[XB_TMO], 1u); break; } }
    }
    nloc = mine > 0u ? mine : 1u; nx = cnt > 0u ? cnt : 1u;
}

__device__ __forceinline__ void xcd_barrier(const XcdBarrier& b) {
    asm volatile("s_waitcnt vmcnt(0)" ::: "memory");
    __syncthreads();
    if (threadIdx.x == 0) {
        unsigned* bar = b.bar;
        __builtin_amdgcn_s_waitcnt(0);
        unsigned nloc = b.st[0], nx = b.st[1];
        if (nloc == 0u) { xcd_barrier_complete(bar, b.x, nloc, nx); b.st[0] = nloc; b.st[1] = nx; }
        const unsigned old = xb_add(&bar[XB_XSUB(b.x)], 1u);
        const unsigned gen = old / nloc;
        if (old + 1u == (gen + 1u) * nloc) {
            __builtin_amdgcn_fence(__ATOMIC_RELEASE, "agent");
            asm volatile("s_waitcnt vmcnt(0)" ::: "memory");
            const unsigned og = xb_add(&bar[XB_TOP], 1u);
            const unsigned tg = og / nx;
            if (og + 1u == (tg + 1u) * nx) xb_add(&bar[XB_TOPGEN], 1u);
            else XB_SPIN(xb_ld(&bar[XB_TOPGEN]) == tg, bar);
            __builtin_amdgcn_fence(__ATOMIC_ACQUIRE, "agent");
            xb_add(&bar[XB_XGEN(b.x)], 1u);
            asm volatile("s_waitcnt vmcnt(0)" ::: "memory");
        } else {
            XB_SPIN(xb_ld(&bar[XB_XGEN(b.x)]) == gen, bar);
            __builtin_amdgcn_fence(__ATOMIC_ACQUIRE, "agent");
            asm volatile("s_waitcnt vmcnt(0)" ::: "memory");
        }
    }
    __syncthreads();
}


namespace att {
constexpr int D = 128, NW = 8, QBLK = 32, KVBLK = 64;
constexpr float SCALE = 0.088388347648318440f;
constexpr float THR = 8.f;
#ifndef ATT_SDEPTH
#define ATT_SDEPTH 1
#endif
constexpr int SDEPTH = ATT_SDEPTH;
constexpr int LDQ = 1024, LDK = 256, LDO = 2048;
constexpr size_t SHM_V = KVBLK * D * 2, SHM_K = KVBLK * D * 2, SHM_ATTN = 2 * SHM_V + 2 * SHM_K + NW * 64 * 4;
using s16x4  = __attribute__((ext_vector_type(4))) short;
using f32x16 = __attribute__((ext_vector_type(16))) float;
#define KSWZ(row, colB) ((row) * 256 + ((colB) ^ (((row) & 7) << 4)))
#define SBAR() __builtin_amdgcn_sched_barrier(0)
__device__ __forceinline__ int crow(int r, int hi) { return (r & 3) + 8 * (r >> 2) + 4 * hi; }
__device__ __forceinline__ unsigned cvtpk(float lo, float hi) { unsigned r; asm volatile("v_cvt_pk_bf16_f32 %0, %1, %2" : "=v"(r) : "v"(lo), "v"(hi)); return r; }

__device__ __forceinline__ void partialSM(f32x16& p0, f32x16& p1, float& m_reg, float& mn, float& alpha) {
  constexpr float C = SCALE * 1.4426950408889634f;
  float pmax = p0[0]; for (int r = 1; r < 16; ++r) pmax = fmaxf(pmax, p0[r]); for (int r = 0; r < 16; ++r) pmax = fmaxf(pmax, p1[r]);
  { auto rr = __builtin_amdgcn_permlane32_swap(__float_as_uint(pmax), __float_as_uint(pmax), false, false);
    pmax = fmaxf(__uint_as_float(rr[0]), __uint_as_float(rr[1])); }
  if (__builtin_expect(__all(pmax - m_reg <= THR / SCALE), 1)) { mn = m_reg; alpha = 1.f; }
  else { mn = fmaxf(m_reg, pmax); alpha = __builtin_amdgcn_exp2f((m_reg - mn) * C); m_reg = mn; }
  float mnC = -mn * C;
  for (int r = 0; r < 16; ++r) p0[r] = fmaf(p0[r], C, mnC); for (int r = 0; r < 16; ++r) p1[r] = fmaf(p1[r], C, mnC);
  for (int r = 0; r < 16; ++r) p0[r] = __builtin_amdgcn_exp2f(p0[r]);
}
__device__ __forceinline__ void finishSM(f32x16& p0, f32x16& p1, float alpha, float& l_reg, bf16x8& pa0, bf16x8& pa1, bf16x8& pa2, bf16x8& pa3) {
  for (int r = 0; r < 16; ++r) p1[r] = __builtin_amdgcn_exp2f(p1[r]);
  float ps = 0; for (int r = 0; r < 16; ++r) ps += p0[r]; for (int r = 0; r < 16; ++r) ps += p1[r];
  { auto rr = __builtin_amdgcn_permlane32_swap(__float_as_uint(ps), __float_as_uint(ps), false, false);
    ps = __uint_as_float(rr[0]) + __uint_as_float(rr[1]); }
  l_reg = l_reg * alpha + ps;
#define PK4(P, BASE, OUT) do { unsigned a0 = cvtpk(P[BASE + 0], P[BASE + 1]), a1 = cvtpk(P[BASE + 2], P[BASE + 3]);   \
    unsigned b0 = cvtpk(P[BASE + 4], P[BASE + 5]), b1 = cvtpk(P[BASE + 6], P[BASE + 7]);                              \
    auto r0 = __builtin_amdgcn_permlane32_swap(a0, b0, false, false); auto r1 = __builtin_amdgcn_permlane32_swap(a1, b1, false, false); \
    v4u w = {r0[0], r1[0], r0[1], r1[1]}; OUT = *reinterpret_cast<bf16x8*>(&w); } while (0)
  PK4(p0, 0, pa0); PK4(p0, 8, pa1); PK4(p1, 0, pa2); PK4(p1, 8, pa3);
#undef PK4
}
__device__ __forceinline__ void qkt(f32x16& p0, f32x16& p1, const bf16* Ks, const bf16x8* qr, int r32, int hi) {
  p0 = f32x16{}; p1 = f32x16{};
  for (int d0 = 0; d0 < 8; ++d0) { int cb = (d0 * 16 + hi * 8) * 2;
    bf16x8 b0 = *reinterpret_cast<const bf16x8*>((const char*)Ks + KSWZ(r32, cb));
    bf16x8 b1 = *reinterpret_cast<const bf16x8*>((const char*)Ks + KSWZ(32 + r32, cb));
    p0 = __builtin_amdgcn_mfma_f32_32x32x16_bf16(b0, qr[d0], p0, 0, 0, 0);
    p1 = __builtin_amdgcn_mfma_f32_32x32x16_bf16(b1, qr[d0], p1, 0, 0, 0); }
}
__device__ __forceinline__ int v_st(int k, int c) { const int kk = (k & ~0xC) | ((k & 4) << 1) | ((k & 8) >> 1); return ((kk >> 3) * 4 + (c >> 5)) * 512 + ((kk & 7) * 32 + (c & 31)) * 2; }
__device__ __forceinline__ int v_rd_base(int lane) { return ((lane & 3) << 3) | (((lane >> 2) & 3) << 6) | (((lane >> 4) & 1) << 5) | (((lane >> 5) & 1) << 8); }
constexpr int v_rd_off(int d0, int ks, int half) { return d0 * 512 + ks * 4096 + half * 2048; }
template <int OFF> __device__ __forceinline__ s16x4 tr_read(int vb) {
  s16x4 r; asm volatile("ds_read_b64_tr_b16 %0, %1 offset:%2" : "=&v"(r) : "v"(vb), "i"(OFF) : "memory"); return r;
}
template <int D0> __device__ __forceinline__ void pv_one(f32x16& od, int vb, bf16x8 pa0, bf16x8 pa1, bf16x8 pa2, bf16x8 pa3) {
  const s16x4 l0 = tr_read<v_rd_off(D0, 0, 0)>(vb), h0 = tr_read<v_rd_off(D0, 0, 1)>(vb), l1 = tr_read<v_rd_off(D0, 1, 0)>(vb), h1 = tr_read<v_rd_off(D0, 1, 1)>(vb);
  const s16x4 l2 = tr_read<v_rd_off(D0, 2, 0)>(vb), h2 = tr_read<v_rd_off(D0, 2, 1)>(vb), l3 = tr_read<v_rd_off(D0, 3, 0)>(vb), h3 = tr_read<v_rd_off(D0, 3, 1)>(vb);
  asm volatile("s_waitcnt lgkmcnt(0)" ::: "memory"); SBAR();
#define PK(L, H) (bf16x8){L[0], L[1], L[2], L[3], H[0], H[1], H[2], H[3]}
  od = __builtin_amdgcn_mfma_f32_32x32x16_bf16(pa0, PK(l0, h0), od, 0, 0, 0);
  od = __builtin_amdgcn_mfma_f32_32x32x16_bf16(pa1, PK(l1, h1), od, 0, 0, 0);
  od = __builtin_amdgcn_mfma_f32_32x32x16_bf16(pa2, PK(l2, h2), od, 0, 0, 0);
  od = __builtin_amdgcn_mfma_f32_32x32x16_bf16(pa3, PK(l3, h3), od, 0, 0, 0);
#undef PK
}
__device__ __forceinline__ void pv_d0(f32x16* o, int vb, bf16x8 pa0, bf16x8 pa1, bf16x8 pa2, bf16x8 pa3) {
  pv_one<0>(o[0], vb, pa0, pa1, pa2, pa3); pv_one<1>(o[1], vb, pa0, pa1, pa2, pa3); pv_one<2>(o[2], vb, pa0, pa1, pa2, pa3); pv_one<3>(o[3], vb, pa0, pa1, pa2, pa3);
}
struct KVSrc { const bf16* Kl; const bf16* Vl; const bf16* Kc; const bf16* Vc; int nloc, kstart, nrows; };

__device__ __forceinline__ void attn_body(const bf16* __restrict__ Qb, const KVSrc src, bf16* __restrict__ Ob, int NT, float sink_raw, int qpos0, char* lds) {
  int tid_ = threadIdx.x; asm volatile("" : "+v"(tid_)); const int tid = tid_, wid = __builtin_amdgcn_readfirstlane(tid >> 6), lane = tid & 63, r32 = lane & 31, hi = lane >> 5;
  bf16* V_lds = (bf16*)lds; bf16* K_lds = (bf16*)(lds + 2 * SHM_V);
  float* ws = (float*)(lds + 2 * SHM_V + 2 * SHM_K) + wid * 64; float* li_l = ws; float* al_l = ws + 32;
  float m_reg = sink_raw, l_reg = 1.f; f32x16 o[4] = {}; bf16x8 qr[8];
  const bf16* Qw = Qb + (long)(wid * QBLK + r32) * LDQ + hi * 8;
#pragma unroll
  for (int d0 = 0; d0 < 8; ++d0) qr[d0] = *reinterpret_cast<const bf16x8*>(Qw + d0 * 16);
  const int sr = tid >> 4, sc = (tid & 15) * 8, vst0 = v_st(sr, sc), vst1 = v_st(32 + sr, sc);
  const int vb0 = (int)(uintptr_t)V_lds + v_rd_base(lane);
  const int qpos = qpos0 + wid * QBLK + r32;
  struct { bf16x8 vs0, vs1, ks0, ks1; } sr_[SDEPTH];
#define SLOAD(i, t) do { const bf16 *kp_, *vp_; int r0_, r1_; const int t_ = (t);                                                      \
    if (t_ < src.nloc) { const int k0_ = src.kstart + t_ * KVBLK; r0_ = k0_ + sr; r1_ = k0_ + 32 + sr;                                   \
      r0_ = r0_ < 0 ? 0 : (r0_ >= src.nrows ? src.nrows - 1 : r0_); r1_ = r1_ < 0 ? 0 : (r1_ >= src.nrows ? src.nrows - 1 : r1_); kp_ = src.Kl; vp_ = src.Vl; } \
    else { const int k0_ = (t_ - src.nloc) * KVBLK; r0_ = k0_ + sr; r1_ = k0_ + 32 + sr; kp_ = src.Kc; vp_ = src.Vc; }                  \
    sr_[i].vs0 = *reinterpret_cast<const bf16x8*>(vp_ + (long)r0_ * LDK + sc); sr_[i].vs1 = *reinterpret_cast<const bf16x8*>(vp_ + (long)r1_ * LDK + sc); \
    sr_[i].ks0 = *reinterpret_cast<const bf16x8*>(kp_ + (long)r0_ * LDK + sc); sr_[i].ks1 = *reinterpret_cast<const bf16x8*>(kp_ + (long)r1_ * LDK + sc); } while (0)
#define SWRITE(b, i) do { *(bf16x8*)((char*)V_lds + (b) * SHM_V + vst0) = sr_[i].vs0;          \
    *(bf16x8*)((char*)V_lds + (b) * SHM_V + vst1) = sr_[i].vs1; int kc = sc * 2;               \
    *(bf16x8*)((char*)K_lds + (b) * SHM_K + KSWZ(sr, kc)) = sr_[i].ks0;                       \
    *(bf16x8*)((char*)K_lds + (b) * SHM_K + KSWZ(32 + sr, kc)) = sr_[i].ks1; } while (0)
#define SWAIT() do { if constexpr (SDEPTH == 2) asm volatile("s_waitcnt vmcnt(4)" ::: "memory"); else asm volatile("s_waitcnt vmcnt(0)" ::: "memory"); } while (0)
#define RESC(a) do { if (__any((a) < 1.f)) { if (hi == 0) al_l[r32] = (a); asm volatile("s_waitcnt lgkmcnt(0)" ::: "memory"); \
    for (int d = 0; d < 4; ++d) for (int r = 0; r < 16; ++r) o[d][r] *= al_l[crow(r, hi)]; } } while (0)
#define MASK(P0, P1, t) do { const int t_ = (t); if (t_ < src.nloc) { const int kb_ = src.kstart + t_ * KVBLK;                           \
    _Pragma("unroll") for (int r = 0; r < 16; ++r) { const int k0_ = kb_ + crow(r, hi), k1_ = k0_ + 32;                                  \
      const int d0_ = qpos - k0_, d1_ = qpos - k1_;                                                                                     \
      const bool v0_ = (k0_ >= 0) && (k0_ < src.nrows) && (d0_ <= 128) && (d0_ >= -128);                                                 \
      const bool v1_ = (k1_ >= 0) && (k1_ < src.nrows) && (d1_ <= 128) && (d1_ >= -128);                                                 \
      P0[r] = v0_ ? P0[r] : -1e30f; P1[r] = v1_ ? P1[r] : -1e30f; } } } while (0)
  f32x16 pA0, pA1, pB0, pB1; float mnA, mnB, alA = 1.f, alB = 1.f; bf16x8 pa0, pa1, pa2, pa3;
  const int qw_lo = qpos0 + wid * QBLK - 128, qw_hi = qpos0 + wid * QBLK + QBLK - 1 + 128;
#define ACT(t) ((t) >= src.nloc || !(src.kstart + (t) * KVBLK + KVBLK - 1 < qw_lo || src.kstart + (t) * KVBLK > qw_hi || src.kstart + (t) * KVBLK + KVBLK - 1 < 0 || src.kstart + (t) * KVBLK >= src.nrows))
  constexpr int SE = 0, SO = SDEPTH - 1;
  SLOAD(SE, 0); asm volatile("s_waitcnt vmcnt(0)" ::: "memory"); SWRITE(0, SE); LDS_BARRIER();
  bool actA = ACT(0), actB = false;
  if (actA) { qkt(pA0, pA1, K_lds, qr, r32, hi); MASK(pA0, pA1, 0); partialSM(pA0, pA1, m_reg, mnA, alA); }
  SLOAD(SO, 1); if constexpr (SDEPTH == 2) { if (2 < NT) SLOAD(SE, 2); }
  SWAIT(); SWRITE(1, SO); LDS_BARRIER();
  for (int j = 1; j + 1 < NT; j += 2) {
    actB = ACT(j);
    SBAR(); if (actB) qkt(pB0, pB1, (bf16*)((char*)K_lds + SHM_K), qr, r32, hi);
    if (actA) finishSM(pA0, pA1, alA, l_reg, pa0, pa1, pa2, pa3); SBAR();
    SLOAD(SO, j + SDEPTH); SBAR();
    if (actA) pv_d0(o, vb0, pa0, pa1, pa2, pa3); alB = 1.f; if (actB) { MASK(pB0, pB1, j); partialSM(pB0, pB1, m_reg, mnB, alB); }
    LDS_BARRIER(); SWAIT(); SWRITE(0, SE);
    RESC(alB); LDS_BARRIER();
    actA = ACT(j + 1);
    SBAR(); if (actA) qkt(pA0, pA1, K_lds, qr, r32, hi);
    if (actB) finishSM(pB0, pB1, alB, l_reg, pa0, pa1, pa2, pa3); SBAR();
    if (SDEPTH == 1 || j + 3 < NT) SLOAD(SE, j + 1 + SDEPTH); SBAR();
    if (actB) pv_d0(o, vb0 + (int)SHM_V, pa0, pa1, pa2, pa3); alA = 1.f; if (actA) { MASK(pA0, pA1, j + 1); partialSM(pA0, pA1, m_reg, mnA, alA); }
    LDS_BARRIER(); SWAIT(); SWRITE(1, SO);
    RESC(alA); LDS_BARRIER();
  }
  actB = ACT(NT - 1);
  SBAR(); if (actB) qkt(pB0, pB1, (bf16*)((char*)K_lds + SHM_K), qr, r32, hi);
  if (actA) finishSM(pA0, pA1, alA, l_reg, pa0, pa1, pa2, pa3); SBAR();
  if (actA) pv_d0(o, vb0, pa0, pa1, pa2, pa3); alB = 1.f; if (actB) { MASK(pB0, pB1, NT - 1); partialSM(pB0, pB1, m_reg, mnB, alB); }
  LDS_BARRIER(); RESC(alB);
  if (actB) { finishSM(pB0, pB1, alB, l_reg, pa0, pa1, pa2, pa3); SBAR();
  pv_d0(o, vb0 + (int)SHM_V, pa0, pa1, pa2, pa3); }
#undef ACT
  if (hi == 0) li_l[r32] = l_reg; asm volatile("s_waitcnt lgkmcnt(0)" ::: "memory");
  float rli[16];
#pragma unroll
  for (int r = 0; r < 16; ++r) rli[r] = __builtin_amdgcn_rcpf(li_l[crow(r, hi)]);
  bf16* Ow = Ob + (long)(wid * QBLK) * LDO;
#pragma unroll
  for (int r = 0; r < 16; ++r) { int orow = crow(r, hi);
    for (int d0 = 0; d0 < 4; ++d0) Ow[(long)orow * LDO + d0 * 32 + r32] = f2bf(o[d0][r] * rli[r]); }
  LDS_BARRIER();
#undef SLOAD
#undef SWRITE
#undef SWAIT
#undef RESC
#undef MASK
}
}


struct Args { const float* in[23]; float* out; unsigned char* ws; int ph_lo, ph_hi; };
enum { I_XP = 0, I_XS, I_CK, I_CV, I_ST, I_C, I_CCTX, I_WADA, I_BADA, I_NG, I_WFI, I_WFO, I_WIN, I_WOUT, I_QG, I_KG, I_SINK, I_LB, I_RG, I_CW, I_CB, I_CLG, I_CLB };

__device__ __forceinline__ void transpose_item(const float* W, int K, int N, bf16* WT, LAS float* scr, int item, int lane, int mode, unsigned char* W8 = nullptr, float sc8 = 1.f) {
    const int nblk = N / 32, kb = item / nblk, nb = item % nblk, k0 = 64 * kb, n0 = 32 * nb;
    int dn0 = n0;
    if (mode == 1) { const int hh = n0 >= DFF ? 1 : 0, m = n0 - hh * DFF; dn0 = 256 * (m >> 7) + 128 * hh + (m & 127); }
    if (mode == 2 && n0 >= ZCA) { const int hh = n0 >= ZCB ? 1 : 0, m = n0 - ZCA - hh * 512; dn0 = ZCA + 256 * (m >> 7) + 128 * hh + (m & 127); }
#pragma unroll 8
    for (int i = 0; i < 32; ++i) { const int kk = 2 * i + (lane >> 5); scr[kk * 33 + (lane & 31)] = W[(size_t)(k0 + kk) * N + n0 + (lane & 31)]; }
    LDS_WAIT(); asm volatile("" ::: "memory");
    const int c = lane & 7;
#pragma unroll
    for (int j = 0; j < 4; ++j) { const int n = (lane >> 3) + 8 * j; const LAS float* s = scr + (8 * c) * 33 + n;
        float t[8];
#pragma unroll
        for (int q = 0; q < 8; ++q) { t[q] = s[q * 33]; if (EMU_FP8 >= 1 && mode == 1) t[q] = q8s(t[q], 32.f, 1.f / 32.f); if (EMU_FP8 >= 2 && mode == 3) t[q] = q8s(t[q], 64.f, 1.f / 64.f); }
        v4u o; o.x = pk2(t[0], t[1]); o.y = pk2(t[2], t[3]); o.z = pk2(t[4], t[5]); o.w = pk2(t[6], t[7]);
        if (!W8) *(v4u*)(WT + (size_t)(dn0 + n) * K + k0 + 8 * c) = o;
        if (W8) { v2u o8; if (FFI_INT8 && mode == 1) { o8.x = pki8(t[0] * I8_WSC, t[1] * I8_WSC, t[2] * I8_WSC, t[3] * I8_WSC); o8.y = pki8(t[4] * I8_WSC, t[5] * I8_WSC, t[6] * I8_WSC, t[7] * I8_WSC); }
            else { o8.x = pk8(t[0] * sc8, t[1] * sc8, t[2] * sc8, t[3] * sc8); o8.y = pk8(t[4] * sc8, t[5] * sc8, t[6] * sc8, t[7] * sc8); } *(v2u*)(W8 + (size_t)(dn0 + n) * K + k0 + 8 * c) = o8; } }
    LDS_WAIT(); asm volatile("" ::: "memory");
}

__device__ __forceinline__ void phase_p0(const Args& a, LAS unsigned char* lds, int vcu, int G) {
    int tid_ = threadIdx.x; asm volatile("" : "+v"(tid_)); const int tid = tid_, lane = tid & 63, wave = tid >> 6;
    unsigned char* ws = a.ws;
    {
        LAS float* scr = (LAS float*)(lds + wave * 16384);
        const int gw = vcu * 8 + wave, NGW = G * 8;
        constexpr int I_FI = 32 * 352, I_FO = 88 * 64, I_IN = 32 * 160, I_OUT = 32 * 64, I_LAYER = 2 * I_FI + 2 * I_FO + I_IN + I_OUT;
        for (int rp = 0; rp < REP(8); ++rp)
        for (int it0 = gw; it0 < 2 * I_LAYER; it0 += NGW) {
            const int it = 2 * I_LAYER - 1 - it0;
            const int l = it / I_LAYER; int r = it % I_LAYER;
            if (r < 2 * I_FI) { const int s = r / I_FI; r -= s * I_FI;
                transpose_item(a.in[I_WFI] + (size_t)(l * 2 + s) * DM * NFF2, DM, NFF2, (bf16*)(ws + WS_WFI) + (size_t)(l * 2 + s) * NFF2 * DM, scr, r, lane, 1, f8on(l * 2 + s) ? ws + WS_W8 + (size_t)(l * 2 + s) * W8_STRIDE : nullptr, W8I_SC); continue; }
            r -= 2 * I_FI;
            if (r < 2 * I_FO) { const int s = r / I_FO; r -= s * I_FO;
                transpose_item(a.in[I_WFO] + (size_t)(l * 2 + s) * DFF * DM, DFF, DM, (bf16*)(ws + WS_WFO) + (size_t)(l * 2 + s) * DM * DFF, scr, r, lane, 3, f8out(l * 2 + s) ? ws + WS_W8 + (size_t)(l * 2 + s) * W8_STRIDE + W8O_OFF : nullptr, W8O_SC); continue; }
            r -= 2 * I_FO;
            if (r < I_IN) { transpose_item(a.in[I_WIN] + (size_t)l * DM * INC, DM, INC, (bf16*)(ws + WS_WIN) + (size_t)l * INC * DM, scr, r, lane, 2); continue; }
            r -= I_IN;
            transpose_item(a.in[I_WOUT] + (size_t)l * DM * DM, DM, DM, (bf16*)(ws + WS_WOUT) + (size_t)l * DM * DM, scr, r, lane, 0);
        }
    }
    __syncthreads();
    {
        LAS float* scs = (LAS float*)lds;
        for (int i = tid; i < 3 * DM; i += 512) { const int cond = i / DM, k = i % DM; const float v = cond == 0 ? a.in[I_CCTX][k] : a.in[I_C][(cond - 1) * DM + k]; scs[i] = siluf(v); }
        __syncthreads();
        unsigned long long* modi = (unsigned long long*)(ws + WS_MODI);
        const int NIT = 18 * 128, it0 = (int)(((long)vcu * NIT) / G), it1 = (int)(((long)(vcu + 1) * NIT) / G);
        int cur = -1; float acc[3][4];
#pragma unroll
        for (int c = 0; c < 3; ++c)
#pragma unroll
            for (int j = 0; j < 4; ++j) acc[c][j] = 0.f;
        for (int it = it0; it <= it1; ++it) {
            const int lc = it < it1 ? it / 128 : -2;
            if (lc != cur) {
                if (cur >= 0) { const int l = cur / 9, cr = cur % 9;
#pragma unroll
                    for (int c = 0; c < 3; ++c)
#pragma unroll
                        for (int j = 0; j < 4; ++j) { atomicAdd(modi + (size_t)(c * 2 + l) * MODW + cr * 2048 + 4 * tid + j, (unsigned long long)__float2ll_rn(acc[c][j] * FXM)); acc[c][j] = 0.f; } }
                cur = lc;
            }
            if (it == it1) break;
            const int l = lc / 9, cr = lc % 9, ks = it % 128;
            const float* Wp = a.in[I_WADA] + ((size_t)l * DM + ks * 16) * MODW + cr * 2048 + 4 * tid;
#pragma unroll
            for (int kk = 0; kk < 16; ++kk) { const f32x4 w = *(const f32x4*)(Wp + (size_t)kk * MODW); const int k = ks * 16 + kk;
                const float s0 = scs[k], s1 = scs[DM + k], s2 = scs[2 * DM + k];
#pragma unroll
                for (int j = 0; j < 4; ++j) { acc[0][j] += s0 * w[j]; acc[1][j] += s1 * w[j]; acc[2][j] += s2 * w[j]; } }
        }
    }
    {
        const int gt = vcu * 512 + tid, NGT = G * 512;
        for (int i = gt; i < 2 * 65536; i += NGT) { const int which = i >> 16, g8 = i & 65535;
            const int dg = g8 & 15, pos = (g8 >> 4) & 511, kvh = (g8 >> 13) & 1, bl = g8 >> 14;
            const float* src = a.in[which ? I_CV : I_CK] + (size_t)g8 * 8;
            const f32x4 x0 = *(const f32x4*)src, x1 = *(const f32x4*)(src + 4);
            v4u o; o.x = pk2(x0[0], x0[1]); o.y = pk2(x0[2], x0[3]); o.z = pk2(x1[0], x1[1]); o.w = pk2(x1[2], x1[3]);
            *(v4u*)((bf16*)(ws + (which ? WS_CV : WS_CK)) + ((size_t)bl * 512 + pos) * 256 + kvh * 128 + dg * 8) = o; }
        if (gt < 2048) { const int l = gt >> 10, j = gt & 1023; float v = 0.f; if (l) { const float a0 = a.in[I_LB][j], a1 = a.in[I_LB][1024 + j]; v = 1.f / (1.f + expf(a0 - a1)); } ((float*)(ws + WS_LBV))[gt] = v; }
    }
}

__device__ __forceinline__ void phase_p1(const Args& a, LAS unsigned char* lds, int vcu, int G) {
    int tid_ = threadIdx.x; asm volatile("" : "+v"(tid_)); const int tid = tid_, lane = tid & 63, wave = tid >> 6;
    unsigned char* ws = a.ws;
    const long long* modi = (const long long*)(ws + WS_MODI);
#define MODV(idx) ((float)modi[(idx)] * IFXM)
    const int gt = vcu * 512 + tid, NGT = G * 512, gw = vcu * 8 + wave, NGW = G * 8;
    for (int i = gt; i < 6 * MODW; i += NGT) ((float*)(ws + WS_MOD))[i] = MODV(i);
    for (int i = gt; i < 6 * 3 * DM; i += NGT) { const int k = i % DM, c = (i / DM) % 3, slot = i / (3 * DM), l = slot / 3, sidx = slot % 3;
        const float sc = MODV((size_t)(c * 2 + l) * MODW + (3 * sidx + 1) * DM + k) + a.in[I_BADA][(size_t)l * MODW + (3 * sidx + 1) * DM + k];
        ((float*)(ws + WS_GV))[i] = a.in[I_NG][(size_t)slot * DM + k] * (1.f + sc); }
    LAS float* SH = (LAS float*)lds;
    for (int slot = 0; slot < 6; ++slot) {
        const int l = slot / 3, sidx = slot % 3;
        for (int i = tid; i < 3 * DM; i += 512) { const int c = i / DM, k = i % DM;
            SH[i] = MODV((size_t)(c * 2 + l) * MODW + (3 * sidx) * DM + k) + a.in[I_BADA][(size_t)l * MODW + (3 * sidx) * DM + k]; }
        __syncthreads();
        const int N = sidx == 1 ? INC : NFF2;
        const bf16* Wt = sidx == 1 ? (const bf16*)(ws + WS_WIN) + (size_t)l * INC * DM : (const bf16*)(ws + WS_WFI) + (size_t)(l * 2 + (sidx >> 1)) * NFF2 * DM;
        float* bo = (float*)(ws + WS_BIAS) + (size_t)slot * 3 * NFF2;
        const bool w8 = sidx != 1 && f8on(2 * l + (sidx >> 1));
        if (w8 && gw < N) {
            const unsigned char* W8p = ws + WS_W8 + (size_t)(2 * l + (sidx >> 1)) * W8_STRIDE;
            const int nl = gw + ((N - 1 - gw) / NGW) * NGW;
            for (int n0 = gw; n0 <= nl; n0 += 3 * NGW) {
                int nr[3]; v4u w[3][2];
#pragma unroll
                for (int r = 0; r < 3; ++r) { const int n = n0 + r * NGW; nr[r] = n < nl ? n : nl;
#pragma unroll
                    for (int j = 0; j < 2; ++j) w[r][j] = *(const v4u*)(W8p + (size_t)nr[r] * DM + 32 * lane + 16 * j); }
                float d[3][3];
#pragma unroll
                for (int r = 0; r < 3; ++r) { d[r][0] = 0.f; d[r][1] = 0.f; d[r][2] = 0.f; }
#pragma unroll
                for (int j = 0; j < 2; ++j)
#pragma unroll
                    for (int q = 0; q < 4; ++q) {
#define P1_F8B(B) { const int k = 32 * lane + 16 * j + 4 * q + B; const float s0 = SH[k], s1 = SH[DM + k], s2 = SH[2 * DM + k]; \
                        _Pragma("unroll") for (int r = 0; r < 3; ++r) { const float wf = FFI_INT8 ? i8f(w[r][j][q], B) : __builtin_amdgcn_cvt_f32_fp8((int)w[r][j][q], B); d[r][0] += wf * s0; d[r][1] += wf * s1; d[r][2] += wf * s2; } }
                        P1_F8B(0) P1_F8B(1) P1_F8B(2) P1_F8B(3)
#undef P1_F8B
                    }
#pragma unroll
                for (int r = 0; r < 3; ++r) { constexpr float WSI = FFI_INT8 ? 1.f / I8_WSC : 1.f / W8I_SC; const float e0 = wave_sum(d[r][0]) * WSI, e1 = wave_sum(d[r][1]) * WSI, e2 = wave_sum(d[r][2]) * WSI;
                    if (lane == 0) { bo[nr[r]] = e0; bo[NFF2 + nr[r]] = e1; bo[2 * NFF2 + nr[r]] = e2; } }
            }
        }
        if (!w8 && gw < N) {
            const int nl = gw + ((N - 1 - gw) / NGW) * NGW;
            for (int n0 = gw; n0 <= nl; n0 += 3 * NGW) {
                int nr[3]; v4u w[3][4];
#pragma unroll
                for (int r = 0; r < 3; ++r) { const int n = n0 + r * NGW; nr[r] = n < nl ? n : nl;
#pragma unroll
                    for (int j = 0; j < 4; ++j) w[r][j] = *(const v4u*)(Wt + (size_t)nr[r] * DM + 8 * lane + 512 * j); }
                float d[3][3];
#pragma unroll
                for (int r = 0; r < 3; ++r) { d[r][0] = 0.f; d[r][1] = 0.f; d[r][2] = 0.f; }
#pragma unroll
                for (int j = 0; j < 4; ++j) { const int k = 8 * lane + 512 * j;
#pragma unroll
                    for (int q = 0; q < 8; ++q) { const float s0 = SH[k + q], s1 = SH[DM + k + q], s2 = SH[2 * DM + k + q];
#pragma unroll
                        for (int r = 0; r < 3; ++r) { const unsigned u = w[r][j][q >> 1]; const float wf = (q & 1) ? __uint_as_float(u & 0xffff0000u) : __uint_as_float(u << 16);
                            d[r][0] += wf * s0; d[r][1] += wf * s1; d[r][2] += wf * s2; } } }
#pragma unroll
                for (int r = 0; r < 3; ++r) { const float e0 = wave_sum(d[r][0]), e1 = wave_sum(d[r][1]), e2 = wave_sum(d[r][2]);
                    if (lane == 0) { bo[nr[r]] = e0; bo[NFF2 + nr[r]] = e1; bo[2 * NFF2 + nr[r]] = e2; } }
            }
        }
        __syncthreads();
    }
    {
        LAS float* G0 = (LAS float*)lds;
        for (int i = tid; i < 3 * DM; i += 512) { const int c = i / DM, k = i % DM; G0[i] = a.in[I_NG][k] * (1.f + MODV((size_t)(c * 2) * MODW + DM + k) + a.in[I_BADA][DM + k]); }
        __syncthreads();
        float* X = a.out; bf16* H = (bf16*)(ws + WS_H); unsigned long long* ssq0 = (unsigned long long*)(ws + WS_SSQ);
        if (gw < NTOK) {
            const int rl = gw + ((NTOK - 1 - gw) / NGW) * NGW;
            f32x4 nv[8];
#define P1_LOAD(rw) do { const int rw_ = (rw); const float* xin_ = rw_ < NCTX ? a.in[I_XP] + (size_t)rw_ * DM : a.in[I_XS] + (size_t)(rw_ - NCTX) * DM; \
                _Pragma("unroll") for (int j = 0; j < 8; ++j) nv[j] = ((const f32x4*)xin_ + lane)[64 * j]; } while (0)
            P1_LOAD(gw);
            for (int row = gw; row <= rl; row += NGW) {
                const int cond = row < NCTX ? 0 : 1 + ((row - NCTX) >> 12);
                f32x4 v[8]; float ss = 0.f;
#pragma unroll
                for (int j = 0; j < 8; ++j) { v[j] = nv[j]; ss += (v[j].x * v[j].x + v[j].y * v[j].y) + (v[j].z * v[j].z + v[j].w * v[j].w); }
                P1_LOAD(row + NGW < rl ? row + NGW : rl);
                ss = wave_sum(ss);
                v2u* o8 = (v2u*)(H + (size_t)row * DM) + lane;
                float am = 0.f;
#pragma unroll
                for (int j = 0; j < 8; ++j) { const int col = 4 * lane + 256 * j;
                    const f32x4 g = *(const LAS f32x4*)(G0 + cond * DM + col);
                    v[j] = v[j] * g; am = fmaxf(fmaxf(am, fmaxf(fabsf(v[j].x), fabsf(v[j].y))), fmaxf(fabsf(v[j].z), fabsf(v[j].w))); }
                am = fmaxf(wave_max(am), 1e-20f); const float qs0 = 127.f / am;
#pragma unroll
                for (int j = 0; j < 8; ++j) { const f32x4 h = v[j];
                    if (f8on(0)) ((unsigned*)((unsigned char*)H + (size_t)row * DM) + lane)[64 * j] = pki8(h.x * qs0, h.y * qs0, h.z * qs0, h.w * qs0);
                    else { v2u w; w.x = pk2(h.x, h.y); w.y = pk2(h.z, h.w); o8[64 * j] = w; } }
                if (lane == 0) { ssq0[row] = __float2ull_rn(ss * FXS); ((float*)(ws + WS_RS0))[row] = am * (1.f / 127.f); }
            }
#undef P1_LOAD
        }
    }
}

__device__ __forceinline__ void phase_prep(const Args& a, int l, int vcu, int G) {
    int tid_ = threadIdx.x; asm volatile("" : "+v"(tid_)); const int tid = tid_, lane = tid & 63, wave = tid >> 6;
    const bf16* Zb = (const bf16*)(a.ws + WS_Z);
    bf16* Qb = (bf16*)(a.ws + WS_Q); bf16* Kb = (bf16*)(a.ws + WS_K); bf16* Vb = (bf16*)(a.ws + WS_V);
    const int hf = lane >> 5, j = lane & 31, e1 = 64 * hf + j, e2 = e1 + 32;
    const float invf = exp2f(-(float)j * (13.287712379549449f / 32.f));
    const float qg1 = a.in[I_QG][l * 128 + e1], qg2 = a.in[I_QG][l * 128 + e2], kg1 = a.in[I_KG][l * 128 + e1], kg2 = a.in[I_KG][l * 128 + e2];
    unsigned nx1[10], nx2[10]; v2u nvv;
#define PREP_LOAD(r) do { const bf16* z_ = Zb + (size_t)(r) * ZBC; \
        _Pragma("unroll") for (int hd = 0; hd < 10; ++hd) { const int base = hd < 8 ? ZQ + hd * 128 : ZK + (hd - 8) * 128; nx1[hd] = z_[base + e1]; nx2[hd] = z_[base + e2]; } \
        nvv = *(const v2u*)(z_ + ZV + 4 * lane); } while (0)
    const int rstart = vcu * 8 + wave, rstep = G * 8;
    if (rstart < NTOK) PREP_LOAD(rstart);
    for (int row = rstart; row < NTOK; row += rstep) {
        const bool lat = row >= NCTX;
        float cx1[10], cx2[10];
#pragma unroll
        for (int hd = 0; hd < 10; ++hd) { cx1[hd] = bf2f(nx1[hd]); cx2[hd] = bf2f(nx2[hd]); }
        const v2u vr = nvv; const f32x4 v = {__uint_as_float(vr.x << 16), __uint_as_float(vr.x & 0xffff0000u), __uint_as_float(vr.y << 16), __uint_as_float(vr.y & 0xffff0000u)};
        if (row + rstep < NTOK) PREP_LOAD(row + rstep);
        float cs = 1.f, sn = 0.f;
        if (lat) { const int p = (row - NCTX) & 4095; const int pos = hf ? (p & 63) : (p >> 6); const float ang = (float)pos * invf; cs = cosf(ang); sn = sinf(ang); }
#pragma unroll
        for (int hd = 0; hd < 10; ++hd) {
            const float x1 = cx1[hd], x2 = cx2[hd];
            const float rstd = 1.0f / sqrtf(wave_sum(x1 * x1 + x2 * x2) * (1.f / 128.f) + EPS);
            float y1 = x1 * rstd * (hd < 8 ? qg1 : kg1), y2 = x2 * rstd * (hd < 8 ? qg2 : kg2);
            if (!lat && hd >= 8) { const int b = row >> 8, pos = row & 255; float* ck = a.out + OUT_CK + ((((size_t)b * 2 + l) * 2 + (hd - 8)) * 256 + pos) * 128; ck[e1] = y1; ck[e2] = y2; }
            if (lat) { const float r1 = y1 * cs - y2 * sn, r2 = y1 * sn + y2 * cs; y1 = r1; y2 = r2; }
            if (hd < 8) { bf16* q = Qb + (size_t)row * 1024 + hd * 128; q[e1] = f2bf(y1); q[e2] = f2bf(y2); }
            else { bf16* k = Kb + (size_t)row * 256 + (hd - 8) * 128; k[e1] = f2bf(y1); k[e2] = f2bf(y2); }
        }
        *((v2u*)(Vb + (size_t)row * 256) + lane) = vr;
        if (!lat) { const int b = row >> 8, pos = row & 255, kvh = lane >> 5; *(f32x4*)(a.out + OUT_CV + ((((size_t)b * 2 + l) * 2 + kvh) * 256 + pos) * 128 + ((4 * lane) & 127)) = v; }
    }
}

__device__ __forceinline__ void phase_hgrn_a(const Args& a, LAS unsigned char* lds, int l, int vcu, int G) {
    int tid_ = threadIdx.x; asm volatile("" : "+v"(tid_)); const int tid = tid_, lane = tid & 63, wave = tid >> 6, fr = lane & 15, fq = lane >> 4;
    const bf16* Zb = (const bf16*)(a.ws + WS_Z); const float* LF = (const float*)(a.ws + WS_LF);
    bf16* KP = (bf16*)(a.ws + WS_KP); bf16* VP = (bf16*)(a.ws + WS_VP); float* DEC = (float*)(a.ws + WS_DEC);
    LAS unsigned char* KT = lds;
    LAS unsigned char* VT = lds + 20480;
    LAS float* TOT = (LAS float*)(lds + 30720);
    const int d = tid & 127, h = (tid >> 7) & 1, dir = tid >> 8, pq = tid >> 7;
    unsigned nk[16], nv[8]; float nc[16];
#define HA_LOAD(it) do { const int gb_ = (it) >> 2, hd_ = (it) & 3, r0_ = gb_ * 32; const bf16* zk_ = Zb + (size_t)r0_ * ZBC + ZRF + dir * 512 + hd_ * 128 + d; const float* lf_ = LF + (size_t)r0_ * 1024 + dir * 512 + hd_ * 128 + d; \
        _Pragma("unroll") for (int j = 0; j < 16; ++j) { const int i = 16 * h + j, p = dir ? 31 - i : i; nk[j] = zk_[(size_t)p * ZBC]; nc[j] = lf_[(size_t)p * 1024]; } \
        _Pragma("unroll") for (int j = 0; j < 8; ++j) nv[j] = Zb[(size_t)(r0_ + 8 * pq + j) * ZBC + ZRI + hd_ * 128 + d]; } while (0)
    if (vcu < 2048) HA_LOAD(vcu);
    for (int item = vcu; item < 2048; item += G) {
        const int gb = item >> 2, head = item & 3;
        float kk[16], c[16]; float run = 0.f;
#pragma unroll
        for (int j = 0; j < 16; ++j) { kk[j] = bf2f(nk[j]); c[j] = nc[j]; }
        { v4u w; w.x = nv[0] | (nv[1] << 16); w.y = nv[2] | (nv[3] << 16); w.z = nv[4] | (nv[5] << 16); w.w = nv[6] | (nv[7] << 16); *(LAS v4u*)(VT + d * 80 + pq * 16) = w; }
#pragma unroll
        for (int j = 0; j < 16; ++j) { run += c[j]; c[j] = run; }
        TOT[(dir * 2 + h) * 128 + d] = run;
        LDS_BARRIER();
        const float other = TOT[(dir * 2 + (1 - h)) * 128 + d];
        const float base = h ? run : run + other;
#pragma unroll
        for (int j = 0; j < 16; j += 2) { const float va = kk[j] * __expf(base - c[j]), vb = kk[j + 1] * __expf(base - c[j + 1]);
            const int i = 16 * h + j, p = dir ? 30 - i : i;
            *(LAS unsigned*)(KT + (dir * 128 + d) * 80 + p * 2) = pk2(dir ? vb : va, dir ? va : vb); }
        if (h == 0) DEC[((size_t)(dir * 512 + gb) * 4 + head) * 128 + d] = __expf(run + other);
        if (item + G < 2048) HA_LOAD(item + G);
        LDS_BARRIER();
        if (gb < 256) {
            for (int q = tid; q < 1024; q += 512) { const int dr = q >> 9, rr = (q >> 2) & 127, c4 = q & 3;
                *(v4u*)(KP + ((size_t)((dr * 256 + gb) * 4 + head) * 128 + rr) * 32 + c4 * 8) = *(const LAS v4u*)(KT + (dr * 128 + rr) * 80 + c4 * 16); }
            { const int rr = tid >> 2, c4 = tid & 3; *(v4u*)(VP + ((size_t)(gb * 4 + head) * 128 + rr) * 32 + c4 * 8) = *(const LAS v4u*)(VT + rr * 80 + c4 * 16); }
        } else {
            bf16* U16 = (bf16*)(a.ws + WS_US);
            const bf16x8 vf = *(const LAS bf16x8*)(VT + (wave * 16 + fr) * 80 + fq * 16);
#pragma unroll
            for (int dr = 0; dr < 2; ++dr) {
                bf16* Ub = U16 + ((size_t)(dr * 512 + gb) * 4 + head) * 16384 + (wave * 16 + fr) * 128 + 8 * fq;
                f32x4 acc[4][2];
#pragma unroll
                for (int dp = 0; dp < 4; ++dp)
#pragma unroll
                    for (int j = 0; j < 2; ++j) {
                        const bf16x8 kf = *(const LAS bf16x8*)(KT + (dr * 128 + 32 * dp + 8 * (fr >> 2) + 4 * j + (fr & 3)) * 80 + fq * 16);
                        acc[dp][j] = (f32x4){0.f, 0.f, 0.f, 0.f};
                        acc[dp][j] = __builtin_amdgcn_mfma_f32_16x16x32_bf16(kf, vf, acc[dp][j], 0, 0, 0); }
                asm volatile("s_nop 7\n\ts_nop 7\n\ts_nop 7" : "+v"(acc[0][0]), "+v"(acc[0][1]), "+v"(acc[1][0]), "+v"(acc[1][1]), "+v"(acc[2][0]), "+v"(acc[2][1]), "+v"(acc[3][0]), "+v"(acc[3][1]));
#pragma unroll
                for (int dp = 0; dp < 4; ++dp) {
                    v4u w; w.x = pk2(acc[dp][0][0], acc[dp][0][1]); w.y = pk2(acc[dp][0][2], acc[dp][0][3]); w.z = pk2(acc[dp][1][0], acc[dp][1][1]); w.w = pk2(acc[dp][1][2], acc[dp][1][3]);
                    *(v4u*)(Ub + 32 * dp) = w; }
            }
        }
        LDS_BARRIER();
    }
}

__device__ __forceinline__ void phase_conv(const Args& a, LAS unsigned char* lds, int l, int vcu, int G) {
    int tid_ = threadIdx.x; asm volatile("" : "+v"(tid_)); const int tid = tid_, lane = tid & 63, wave = tid >> 6, ch = tid;
    const bf16* GL = (const bf16*)(a.ws + WS_GLU); bf16* MIX = (bf16*)(a.ws + WS_MIX);
    LAS float* OB = (LAS float*)lds;
    LAS float* STS = (LAS float*)(lds + 65536);
    float w[31];
#pragma unroll
    for (int j = 0; j < 31; ++j) w[j] = a.in[I_CW][(size_t)(l * 31 + j) * 512 + ch];
    const float bias = a.in[I_CB][l * 512 + ch], lg = a.in[I_CLG][l * 512 + ch], lbb = a.in[I_CLB][l * 512 + ch];
    for (int gb = vcu; gb < 512; gb += G) {
        const int row0 = gb * 32;
        int s0, T; if (row0 < NCTX) { s0 = row0 & ~255; T = 256; } else { s0 = NCTX + ((row0 - NCTX) & ~4095); T = 4096; }
        float h[62];
#pragma unroll
        for (int i = 0; i < 62; ++i) { const int r = row0 - 15 + i; h[i] = (r >= s0 && r < s0 + T) ? bf2f(GL[(size_t)r * 512 + ch]) : 0.f; }
        float o[32];
#pragma unroll
        for (int p = 0; p < 32; ++p) { float acc = bias;
#pragma unroll
            for (int j = 0; j < 31; ++j) acc += w[j] * h[p + j];
            o[p] = acc; OB[p * 512 + ch] = acc; }
        LDS_BARRIER();
#pragma unroll
        for (int t = 0; t < 4; ++t) { const int p = wave * 4 + t;
            const f32x4 x0 = *(const LAS f32x4*)(OB + p * 512 + lane * 8), x1 = *(const LAS f32x4*)(OB + p * 512 + lane * 8 + 4);
            const float s1 = wave_sum((x0.x + x0.y) + (x0.z + x0.w) + (x1.x + x1.y) + (x1.z + x1.w));
            const float s2 = wave_sum((x0.x * x0.x + x0.y * x0.y) + (x0.z * x0.z + x0.w * x0.w) + (x1.x * x1.x + x1.y * x1.y) + (x1.z * x1.z + x1.w * x1.w));
            const float mu = s1 * (1.f / 512.f), var = fmaxf(s2 * (1.f / 512.f) - mu * mu, 0.f);
            if (lane == 0) { STS[p * 2] = mu; STS[p * 2 + 1] = 1.0f / sqrtf(var + EPS); } }
        LDS_BARRIER();
#pragma unroll
        for (int p = 0; p < 32; ++p) { const float y = (o[p] - STS[p * 2]) * STS[p * 2 + 1] * lg + lbb;
            MIX[(size_t)(row0 + p) * DM + 1536 + ch] = f2bf(siluf(y)); }
        LDS_BARRIER();
    }
}

__device__ __forceinline__ void phase_attn(const Args& a, unsigned char* lds_generic, int l, int vcu, int G) {
    const bf16* Qb = (const bf16*)(a.ws + WS_Q); const bf16* Kb = (const bf16*)(a.ws + WS_K); const bf16* Vb = (const bf16*)(a.ws + WS_V);
    bf16* MIX = (bf16*)(a.ws + WS_MIX);
    for (int item = vcu; item < 512; item += G) {
        if (item < 256) {
            const int b = item >> 3, h = item & 7, kvh = h >> 2; const size_t r0 = (size_t)b * 256;
            att::KVSrc src; src.Kl = nullptr; src.Vl = nullptr; src.Kc = Kb + r0 * 256 + kvh * 128; src.Vc = Vb + r0 * 256 + kvh * 128; src.nloc = 0; src.kstart = 0; src.nrows = 1;
            att::attn_body(Qb + r0 * 1024 + h * 128, src, MIX + r0 * DM + h * 128, 4, a.in[I_SINK][l * 8 + h] * (1.0f / att::SCALE), 0, (char*)lds_generic);
        } else {
            const int it = item - 256, b2 = it >> 7, h = (it >> 4) & 7, qi = it & 15, kvh = h >> 2; const size_t rb = (size_t)NCTX + (size_t)b2 * 4096;
            att::KVSrc src; src.Kl = Kb + rb * 256 + kvh * 128; src.Vl = Vb + rb * 256 + kvh * 128;
            src.Kc = (const bf16*)(a.ws + WS_CK) + ((size_t)(b2 * 2 + l) * 512) * 256 + kvh * 128; src.Vc = (const bf16*)(a.ws + WS_CV) + ((size_t)(b2 * 2 + l) * 512) * 256 + kvh * 128;
            src.nloc = 8; src.kstart = 256 * qi - 128; src.nrows = 4096;
            att::attn_body(Qb + (rb + 256 * qi) * 1024 + h * 128, src, MIX + (rb + 256 * qi) * DM + h * 128, 16, a.in[I_SINK][l * 8 + h] * (1.0f / att::SCALE), 256 * qi, (char*)lds_generic);
        }
    }
}

__device__ __forceinline__ void phase_hgrn_b(const Args& a, LAS unsigned char* lds, int l, int vcu, int G) {
    int tid_ = threadIdx.x; asm volatile("" : "+v"(tid_)); const int tid = tid_, lane = tid & 63, wave = tid >> 6, fr = lane & 15, fq = lane >> 4;
    const bf16* __restrict__ U16 = (const bf16*)(a.ws + WS_US); const bf16* __restrict__ KP = (const bf16*)(a.ws + WS_KP); const bf16* __restrict__ VP = (const bf16*)(a.ws + WS_VP);
    const float* __restrict__ DEC = (const float*)(a.ws + WS_DEC);
    bf16* __restrict__ ST = (bf16*)(a.ws + WS_ST16);
    LAS float* TR = (LAS float*)lds;
    LAS unsigned char* LK = lds;
    LAS unsigned char* LV = lds + 40960;
    LAS float* LD = (LAS float*)(lds + 81920);
    for (int item = vcu; item < 256; item += G) {
        const int b = item >> 3, head = (item >> 1) & 3, dir = item & 1;
        f32x4 S[4][2];
#pragma unroll
        for (int dp = 0; dp < 4; ++dp) { S[dp][0] = (f32x4){0.f, 0.f, 0.f, 0.f}; S[dp][1] = (f32x4){0.f, 0.f, 0.f, 0.f}; }
#pragma unroll
        for (int half = 0; half < 2; ++half) {
            for (int q = tid; q < 2048; q += 512) { const int ci = q >> 9, rr = (q >> 2) & 127, c4 = q & 3, i = 4 * half + ci, gb = b * 8 + (dir ? 7 - i : i);
                *(LAS v4u*)(LK + (ci * 128 + rr) * 80 + c4 * 16) = *(const v4u*)(KP + ((size_t)((dir * 256 + gb) * 4 + head) * 128 + rr) * 32 + c4 * 8);
                *(LAS v4u*)(LV + (ci * 128 + rr) * 80 + c4 * 16) = *(const v4u*)(VP + ((size_t)(gb * 4 + head) * 128 + rr) * 32 + c4 * 8); }
            if (tid < 128) { const int ci = tid >> 5, c = tid & 31, i = 4 * half + ci, gb = b * 8 + (dir ? 7 - i : i);
                *(LAS f32x4*)(LD + ci * 128 + 4 * c) = *(const f32x4*)(DEC + ((size_t)(dir * 512 + gb) * 4 + head) * 128 + 4 * c); }
            LDS_BARRIER();
#pragma unroll
            for (int ci = 0; ci < 4; ++ci) { const int i = 4 * half + ci, gb = b * 8 + (dir ? 7 - i : i); const size_t cb = ((size_t)(dir * 512 + gb) * 4 + head);
                const bf16x8 vB = *(const LAS bf16x8*)(LV + (ci * 128 + wave * 16 + fr) * 80 + fq * 16);
                bf16* So = ST + cb * 16384 + (wave * 16 + fr) * 128 + 8 * fq;
#pragma unroll
                for (int dp = 0; dp < 4; ++dp) {
                    v4u w; w.x = pk2(S[dp][0][0], S[dp][0][1]); w.y = pk2(S[dp][0][2], S[dp][0][3]); w.z = pk2(S[dp][1][0], S[dp][1][1]); w.w = pk2(S[dp][1][2], S[dp][1][3]);
                    *(v4u*)(So + 32 * dp) = w;
#pragma unroll
                    for (int j = 0; j < 2; ++j) {
                        const bf16x8 kA = *(const LAS bf16x8*)(LK + (ci * 128 + 32 * dp + 8 * (fr >> 2) + 4 * j + (fr & 3)) * 80 + fq * 16);
                        const f32x4 dc = *(const LAS f32x4*)(LD + ci * 128 + 32 * dp + 8 * fq + 4 * j);
                        S[dp][j] = __builtin_amdgcn_mfma_f32_16x16x32_bf16(kA, vB, S[dp][j] * dc, 0, 0, 0); } } }
            LDS_BARRIER();
        }
#pragma unroll
        for (int dp = 0; dp < 4; ++dp)
#pragma unroll
            for (int j = 0; j < 2; ++j)
#pragma unroll
                for (int i = 0; i < 4; ++i) TR[(wave * 16 + fr) * 129 + 32 * dp + 8 * fq + 4 * j + i] = S[dp][j][i];
        LDS_BARRIER();
        float* O = a.out + OUT_ST + ((((size_t)b * 2 + l) * 2 + dir) * 4 + head) * 16384;
#pragma unroll
        for (int j = 0; j < 8; ++j) { const int idx = tid + 512 * j, dd = idx >> 5, e4 = (idx & 31) * 4;
            f32x4 v; v.x = TR[e4 * 129 + dd]; v.y = TR[(e4 + 1) * 129 + dd]; v.z = TR[(e4 + 2) * 129 + dd]; v.w = TR[(e4 + 3) * 129 + dd];
            *(f32x4*)(O + dd * 128 + e4) = v; }
        LDS_BARRIER();
    }
    for (int item = vcu; item < 256; item += G) {
        const int combo = item >> 4, part = item & 15, b2 = combo >> 3, dir = (combo >> 2) & 1, head = combo & 3;
        const int flat = part * 1024 + tid * 2, e = flat >> 7, d0 = flat & 127;
        const float* Sin = a.in[I_ST] + ((((size_t)b2 * 2 + l) * 2 + dir) * 4 + head) * 16384;
        f32x2 S; S.x = Sin[d0 * 128 + e]; S.y = Sin[(d0 + 1) * 128 + e];
        const int gb0 = 256 + b2 * 128;
#pragma unroll 16
        for (int i = 0; i < 128; ++i) { const int cc = dir ? 127 - i : i, gb = gb0 + cc; const size_t cb = ((size_t)(dir * 512 + gb) * 4 + head);
            const unsigned ur = *(const unsigned*)(U16 + cb * 16384 + flat); const f32x2 u = {__uint_as_float(ur << 16), __uint_as_float(ur & 0xffff0000u)}, dd = *(const f32x2*)(DEC + cb * 128 + d0);
            *(unsigned*)(ST + cb * 16384 + flat) = pk2(S.x, S.y);
            S = S * dd + u; }
    }
}

__device__ __forceinline__ void phase_hgrn_c(const Args& a, LAS unsigned char* lds, int l, int vcu, int G) {
    int tid_ = threadIdx.x; asm volatile("" : "+v"(tid_)); const int tid = tid_, lane = tid & 63, wave = tid >> 6, fr = lane & 15, fq = lane >> 4;
    const bf16* Zb = (const bf16*)(a.ws + WS_Z); const float* LF = (const float*)(a.ws + WS_LF); const bf16* ST = (const bf16*)(a.ws + WS_ST16); bf16* MIX = (bf16*)(a.ws + WS_MIX);
    constexpr int QP = 272;
    constexpr int O_QX = 0, O_KX = 17408, O_QI = 34816, O_VT = 52224, O_AM = 62464, O_TOT = 67584, O_RED = 69632;
    LAS unsigned char* QX = lds + O_QX;
    LAS unsigned char* KX = lds + O_KX;
    LAS unsigned char* QI = lds + O_QI;
    LAS unsigned char* VT = lds + O_VT;
    LAS unsigned char* AM = lds + O_AM;
    LAS float* TOT = (LAS float*)(lds + O_TOT);
    LAS float* RED = (LAS float*)(lds + O_RED);
    const int d = tid & 127, h = (tid >> 7) & 1, dir = tid >> 8, pq = tid >> 7;
    unsigned nk[16], nq[16], nv[8]; float nc[16];
#define HC_LOAD(it) do { const int gb_ = (it) >> 2, hd_ = (it) & 3, r0_ = gb_ * 32; const bf16* zk_ = Zb + (size_t)r0_ * ZBC + ZRF + dir * 512 + hd_ * 128 + d; const bf16* zq_ = Zb + (size_t)r0_ * ZBC + ZRQ + hd_ * 128 + d; \
        const float* lf_ = LF + (size_t)r0_ * 1024 + dir * 512 + hd_ * 128 + d; \
        _Pragma("unroll") for (int j = 0; j < 16; ++j) { const int i = 16 * h + j, p = dir ? 31 - i : i; nk[j] = zk_[(size_t)p * ZBC]; nc[j] = lf_[(size_t)p * 1024]; nq[j] = zq_[(size_t)p * ZBC]; } \
        _Pragma("unroll") for (int j = 0; j < 8; ++j) nv[j] = Zb[(size_t)(r0_ + 8 * pq + j) * ZBC + ZRI + hd_ * 128 + d]; } while (0)
    unsigned nrg[8];
#define HC_LOADG(it) do { const int gb_ = (it) >> 2, hd_ = (it) & 3, r0_ = gb_ * 32; \
        _Pragma("unroll") for (int mt = 0; mt < 2; ++mt) _Pragma("unroll") for (int i = 0; i < 4; ++i) nrg[mt * 4 + i] = Zb[(size_t)(r0_ + mt * 16 + 4 * fq + i) * ZBC + ZRG + hd_ * 128 + wave * 16 + fr]; } while (0)
    if (vcu < 2048) HC_LOAD(vcu);
    for (int item = vcu; item < 2048; item += G) {
        const int gb = item >> 2, head = item & 3, row0 = gb * 32;
        bf16x8 sB[2][4];
#pragma unroll
        for (int dr = 0; dr < 2; ++dr)
#pragma unroll
            for (int kt = 0; kt < 4; ++kt) sB[dr][kt] = *(const bf16x8*)(ST + ((size_t)(dr * 512 + gb) * 4 + head) * 16384 + (wave * 16 + fr) * 128 + (4 * kt + fq) * 8);
        float kk[16], c[16], qq[16]; float run = 0.f;
#pragma unroll
        for (int j = 0; j < 16; ++j) { kk[j] = bf2f(nk[j]); c[j] = nc[j]; qq[j] = bf2f(nq[j]); }
        { v4u w; w.x = nv[0] | (nv[1] << 16); w.y = nv[2] | (nv[3] << 16); w.z = nv[4] | (nv[5] << 16); w.w = nv[6] | (nv[7] << 16); *(LAS v4u*)(VT + d * 80 + pq * 16) = w; }
        HC_LOADG(item); const float gn = a.in[I_RG][(size_t)(l * 4 + head) * 128 + wave * 16 + fr];
#pragma unroll
        for (int j = 0; j < 16; ++j) { run += c[j]; c[j] = run; }
        TOT[(dir * 2 + h) * 128 + d] = run;
        LDS_BARRIER();
        const float other = TOT[(dir * 2 + (1 - h)) * 128 + d];
        const float xo = h ? 0.f : -run;
        const float io = h ? other : 0.f;
#pragma unroll
        for (int j = 0; j < 16; ++j) { const int i = 16 * h + j, p = dir ? 31 - i : i; const int off = (dir * 32 + p) * QP + d * 2;
            const float ex = __expf(c[j] + xo);
            *(LAS bf16*)(QX + off) = f2bf(qq[j] * ex);
            *(LAS bf16*)(KX + off) = f2bf(kk[j] * __builtin_amdgcn_rcpf(ex));
            *(LAS bf16*)(QI + off) = f2bf(qq[j] * __expf(c[j] + io)); }
        LDS_BARRIER();
        if (item + G < 2048) HC_LOAD(item + G);
        {
            const int dr = wave >> 2, mt = (wave >> 1) & 1, nt = wave & 1;
            f32x4 acc = {0.f, 0.f, 0.f, 0.f};
#pragma unroll
            for (int kt = 0; kt < 4; ++kt) {
                const bf16x8 af = *(const LAS bf16x8*)(QX + (dr * 32 + mt * 16 + fr) * QP + kt * 64 + fq * 16);
                const bf16x8 bfv = *(const LAS bf16x8*)(KX + (dr * 32 + nt * 16 + fr) * QP + kt * 64 + fq * 16);
                acc = __builtin_amdgcn_mfma_f32_16x16x32_bf16(af, bfv, acc, 0, 0, 0); }
#pragma unroll
            for (int i = 0; i < 4; ++i) { const int p = mt * 16 + 4 * fq + i, pp = nt * 16 + fr; const bool keep = dr ? (pp >= p) : (pp <= p);
                *(LAS bf16*)(AM + (dr * 32 + p) * 80 + pp * 2) = f2bf(keep ? acc[i] : 0.f); }
        }
        LDS_BARRIER();
        f32x4 o[2];
#pragma unroll
        for (int mt = 0; mt < 2; ++mt) { o[mt] = (f32x4){0.f, 0.f, 0.f, 0.f};
#pragma unroll
            for (int dr = 0; dr < 2; ++dr) {
#pragma unroll
                for (int kt = 0; kt < 4; ++kt) {
                    const bf16x8 af = *(const LAS bf16x8*)(QI + (dr * 32 + mt * 16 + fr) * QP + kt * 64 + fq * 16);
                    o[mt] = __builtin_amdgcn_mfma_f32_16x16x32_bf16(af, sB[dr][kt], o[mt], 0, 0, 0); }
                const bf16x8 af = *(const LAS bf16x8*)(AM + (dr * 32 + mt * 16 + fr) * 80 + fq * 16);
                const bf16x8 bfv = *(const LAS bf16x8*)(VT + (wave * 16 + fr) * 80 + fq * 16);
                o[mt] = __builtin_amdgcn_mfma_f32_16x16x32_bf16(af, bfv, o[mt], 0, 0, 0);
            } }
#pragma unroll
        for (int mt = 0; mt < 2; ++mt)
#pragma unroll
            for (int i = 0; i < 4; ++i) { float ss = row_sum16(o[mt][i] * o[mt][i]);
                if (fr == 0) RED[wave * 32 + mt * 16 + 4 * fq + i] = ss; }
        LDS_BARRIER();
        const int e = wave * 16 + fr;
#pragma unroll
        for (int mt = 0; mt < 2; ++mt)
#pragma unroll
            for (int i = 0; i < 4; ++i) { const int p = mt * 16 + 4 * fq + i; float ss = 0.f;
#pragma unroll
                for (int wv = 0; wv < 8; ++wv) ss += RED[wv * 32 + p];
                const float rstd = 1.0f / sqrtf(ss * (1.f / 128.f) + EPS);
                const float rg = bf2f(nrg[mt * 4 + i]);
                MIX[(size_t)(row0 + p) * DM + 1024 + head * 128 + e] = f2bf(o[mt][i] * rstd * gn * siluf(rg)); }
        LDS_BARRIER();
    }
}


constexpr int N_PHASES = 20;
#if MK_N_LAUNCHES == 1
#define IN(k) true
#else
#define IN(k) (lo <= (k) && (k) < hi)
#endif
#if PROBE_AMP_MASK || PROBE_AMP_BAR
#define SPIN(dur) do { const unsigned long long s_ = __builtin_amdgcn_s_memrealtime(), d_ = (dur); while (__builtin_amdgcn_s_memrealtime() - s_ < d_) __builtin_amdgcn_s_sleep(1); } while (0)
#define SEAM(k) do { if ((k) + 1 < N_PHASES && IN(k) && IN((k) + 1)) { const unsigned long long ta_ = __builtin_amdgcn_s_memrealtime(); xcd_barrier(bar); const unsigned long long te_ = __builtin_amdgcn_s_memrealtime(); \
        if ((PROBE_AMP_MASK >> (k)) & 1) SPIN(te_ - t_ph); if (PROBE_AMP_BAR) SPIN(te_ - ta_); t_ph = __builtin_amdgcn_s_memrealtime(); } } while (0)
#else
#define SEAM(k) do { if ((k) + 1 < N_PHASES && IN(k) && IN((k) + 1)) xcd_barrier(bar); } while (0)
#endif

template <int L>
__device__ __forceinline__ void layer_phases(const Args& args, LAS unsigned char* lds, unsigned char* lds_raw, const XcdBarrier& bar, int vcu, int G, int bx, int lo, int hi, unsigned long long& t_ph) {
    constexpr int l = L;
    unsigned char* ws = args.ws; float* X = args.out;
        const int pb = 2 + 9 * l;
        const float* bada = args.in[I_BADA] + (size_t)l * MODW;
        constexpr bool F8A = f8on(2 * l), F8B = f8on(2 * l + 1), F8N = l == 0 && f8on(2), F8AO = f8out(2 * l), F8BO = f8out(2 * l + 1), I8A = FFI_INT8 && F8A, I8B = FFI_INT8 && F8B, I8N = FFI_INT8 && F8N;
        if (IN(pb + 0)) {
            pg8::Gemm g{(const bf16*)(ws + WS_H), F8A ? (const bf16*)(ws + WS_W8 + (size_t)(2 * l) * W8_STRIDE) : (const bf16*)(ws + WS_WFI) + (size_t)(l * 2 + 0) * NFF2 * DM, NTOK, NFF2, F8A ? DM / 2 : DM}; pg8::StaticOrder S; S.init(NTOK, NFF2, G, bx);
            pg8::EpiSwiGLUT<F8AO, I8A> E{ws, 3 * l, I8A ? 1.0f / I8_WSC : (F8A ? 1.0f / W8I_SC : 1.0f)};
            pg8::gemm_phase<pg8::EpiSwiGLUT<F8AO, I8A>, pg8::StaticOrder, true, true, F8A && !I8A, I8A>(lds, g, S, E);
            SEAM(pb + 0);
        }
        if (IN(pb + 1)) {
            pg8::Gemm g{(const bf16*)(ws + WS_Z), F8AO ? (const bf16*)(ws + WS_W8 + (size_t)(2 * l) * W8_STRIDE + W8O_OFF) : (const bf16*)(ws + WS_WFO) + (size_t)(l * 2 + 0) * DM * DFF, NTOK, DM, F8AO ? DFF / 2 : DFF}; pg8::StaticOrder S; S.init(NTOK, DM, G, bx);
            pg8::EpiResidNorm E{ws, X, bada + 2 * DM, l * MODW + 2 * DM, 3 * l + 1, F8AO ? 0.5f / W8O_SC : 0.5f, l == 0 ? args.in[I_XP] : nullptr, l == 0 ? args.in[I_XS] : nullptr};
            pg8::gemm_phase<pg8::EpiResidNorm, pg8::StaticOrder, true, true, F8AO>(lds, g, S, E);
            SEAM(pb + 1);
        }
        if (IN(pb + 2)) {
            pg8::Gemm g{(const bf16*)(ws + WS_H), (const bf16*)(ws + WS_WIN) + (size_t)l * INC * DM, NTOK, INC, DM}; pg8::StaticOrder S; S.init(NTOK, INC, G, bx);
            pg8::EpiWin E{ws, l, 3 * l + 1};
            pg8::gemm_phase<pg8::EpiWin, pg8::StaticOrder, true, true>(lds, g, S, E);
            SEAM(pb + 2);
        }
        if (IN(pb + 3)) { phase_prep(args, l, vcu, G); phase_hgrn_a(args, lds, l, vcu, G); phase_conv(args, lds, l, vcu, G); SEAM(pb + 3); }
        if (IN(pb + 4)) { phase_attn(args, lds_raw, l, vcu, G); phase_hgrn_b(args, lds, l, vcu, G); SEAM(pb + 4); }
        if (IN(pb + 5)) { phase_hgrn_c(args, lds, l, vcu, G); SEAM(pb + 5); }
        if (IN(pb + 6)) {
            pg8::Gemm g{(const bf16*)(ws + WS_MIX), (const bf16*)(ws + WS_WOUT) + (size_t)l * DM * DM, NTOK, DM, DM}; pg8::StaticOrder S; S.init(NTOK, DM, G, bx);
            pg8::EpiResidNormT<F8B, I8B> E{ws, X, bada + 5 * DM, l * MODW + 5 * DM, 3 * l + 2, 1.0f, nullptr, nullptr};
            pg8::gemm_phase<pg8::EpiResidNormT<F8B, I8B>, pg8::StaticOrder, true, true>(lds, g, S, E);
            SEAM(pb + 6);
        }
        if (IN(pb + 7)) {
            pg8::Gemm g{(const bf16*)(ws + WS_H), F8B ? (const bf16*)(ws + WS_W8 + (size_t)(2 * l + 1) * W8_STRIDE) : (const bf16*)(ws + WS_WFI) + (size_t)(l * 2 + 1) * NFF2 * DM, NTOK, NFF2, F8B ? DM / 2 : DM}; pg8::StaticOrder S; S.init(NTOK, NFF2, G, bx);
            pg8::EpiSwiGLUT<F8BO, I8B> E{ws, 3 * l + 2, I8B ? 1.0f / I8_WSC : (F8B ? 1.0f / W8I_SC : 1.0f)};
            pg8::gemm_phase<pg8::EpiSwiGLUT<F8BO, I8B>, pg8::StaticOrder, true, true, F8B && !I8B, I8B>(lds, g, S, E);
            SEAM(pb + 7);
        }
        if (IN(pb + 8)) {
            pg8::Gemm g{(const bf16*)(ws + WS_Z), F8BO ? (const bf16*)(ws + WS_W8 + (size_t)(2 * l + 1) * W8_STRIDE + W8O_OFF) : (const bf16*)(ws + WS_WFO) + (size_t)(l * 2 + 1) * DM * DFF, NTOK, DM, F8BO ? DFF / 2 : DFF}; pg8::StaticOrder S; S.init(NTOK, DM, G, bx);
            pg8::EpiResidNormT<F8N, I8N> E{ws, X, bada + 8 * DM, l * MODW + 8 * DM, l == 0 ? 3 : -1, F8BO ? 0.5f / W8O_SC : 0.5f, nullptr, nullptr};
            pg8::gemm_phase<pg8::EpiResidNormT<F8N, I8N>, pg8::StaticOrder, true, true, F8BO>(lds, g, S, E);
            SEAM(pb + 8);
        }
}

__global__ void __launch_bounds__(512, 2) mega_fwd(Args args) {
    extern __shared__ __attribute__((aligned(16))) unsigned char lds_raw[];
    LAS unsigned char* lds = (LAS unsigned char*)lds_raw;
    const int tid = threadIdx.x;
    const int G = gridDim.x; const int bx = blockIdx.x; const int vcu = (G % 8 == 0) ? (bx % 8) * (G / 8) + bx / 8 : bx;
    for (int u = tid; u < (LDS_BYTES - LDSCTL_OFF) / 4; u += 512) ((LAS unsigned*)(lds + LDSCTL_OFF))[u] = 0u;
    __syncthreads();
    const int lo = args.ph_lo, hi = args.ph_hi; unsigned long long t_ph = 0;
#if PROBE_AMP_MASK || PROBE_AMP_BAR
    t_ph = __builtin_amdgcn_s_memrealtime();
#endif
    XcdBarrier bar; bar.bar = (unsigned*)(args.ws + WS_CTL) + CW_BAR; bar.x = 0; bar.st = nullptr;
    if (MK_N_LAUNCHES == 1 || hi - lo > 1) bar = xcd_barrier_post((unsigned*)(args.ws + WS_CTL) + CW_BAR, (volatile LAS unsigned*)(lds + LDSCTL_OFF + 64));
    unsigned char* ws = args.ws;
    float* X = args.out;

    if (IN(0)) { phase_p0(args, lds, vcu, G); SEAM(0); }
    if (IN(1)) { phase_p1(args, lds, vcu, G); SEAM(1); }

    layer_phases<0>(args, lds, lds_raw, bar, vcu, G, bx, lo, hi, t_ph);
    layer_phases<1>(args, lds, lds_raw, bar, vcu, G, bx, lo, hi, t_ph);
    (void)lo; (void)hi; (void)t_ph;
#undef IN
#undef SEAM
}

extern "C" void kernel_launch(void* const* d_in, const int* in_sizes, int n_in, void* d_out, int out_size, void* d_ws, size_t ws_size, hipStream_t stream) {
    static int grid = 0;
    if (grid == 0) {
        if (n_in != 23 || (size_t)out_size != OUT_TOTAL || ws_size < WS_TOP) { fprintf(stderr, "kernel_launch: shape mismatch: n_in %d out %d ws %zu (need >= %zu); nothing launched\n", n_in, out_size, ws_size, (size_t)WS_TOP); grid = -1; return; }
        int dev = 0, cus = 0, per_cu = 0;
        if (hipGetDevice(&dev) != hipSuccess || hipDeviceGetAttribute(&cus, hipDeviceAttributeMultiprocessorCount, dev) != hipSuccess) { grid = -1; return; }
        if (hipFuncSetAttribute((const void*)mega_fwd, hipFuncAttributeMaxDynamicSharedMemorySize, LDS_BYTES) != hipSuccess) { fprintf(stderr, "kernel_launch: hipFuncSetAttribute failed\n"); grid = -1; return; }
        if (hipOccupancyMaxActiveBlocksPerMultiprocessor(&per_cu, (const void*)mega_fwd, 512, LDS_BYTES) != hipSuccess || per_cu < 1) { fprintf(stderr, "kernel_launch: occupancy query says %d\n", per_cu); }
        (void)hipGetLastError();
        grid = cus;
    }
    if (grid < 0) return;
    static_assert(WS_CTL == WS_END && WS_W8 == WS_CTL + CTL_ZERO_BYTES, "the zeroed regions must be contiguous");
    (void)hipMemsetAsync((char*)d_ws + WS_MODI, 0, WS_CTL + CTL_ZERO_BYTES - WS_MODI, stream);
    Args a{};
    for (int i = 0; i < 23; ++i) a.in[i] = (const float*)d_in[i];
    a.out = (float*)d_out; a.ws = (unsigned char*)d_ws;
#if MK_N_LAUNCHES == 1
    a.ph_lo = 0; a.ph_hi = N_PHASES;
    hipLaunchKernelGGL(mega_fwd, dim3(grid), dim3(512), LDS_BYTES, stream, a);
#else
    for (int p = 0; p < N_PHASES; ++p) { a.ph_lo = p; a.ph_hi = p + 1; hipLaunchKernelGGL(mega_fwd, dim3(grid), dim3(512), LDS_BYTES, stream, a); }
#endif
}
```

```cpp
#include <hip/hip_runtime.h>
#include <cstdio>
#include <cstdint>
#ifndef MK_N_LAUNCHES
#define MK_N_LAUNCHES 1
#endif
namespace pg8 {
#define PG8_LAS __attribute__((address_space(3)))
typedef unsigned short bf16_t;
typedef short bf16x8 __attribute__((ext_vector_type(8)));
typedef float f32x4 __attribute__((ext_vector_type(4)));
typedef unsigned u32x4 __attribute__((ext_vector_type(4)));
constexpr int BM = 256, BK = 64, HALF = 128, HTB = HALF * BK * 2  , STAGE_BYTES = 8 * HTB, NXCD = 8, WGM = 8;

__host__ __device__ __forceinline__ int lds_byte(int r, int c) { const int st = (r >> 4) * 2 + (c >> 5), rr = r & 15, cc = c & 31, ob = rr * 64 + cc * 2; return st * 1024 + (ob ^ (((ob >> 9) & 1) << 5)); }
__host__ __device__ __forceinline__ void stage_rc(int b, int& R, int& C) { const int st = b / 1024, sb = b % 1024, swz = sb ^ (((sb >> 9) & 1) << 5); R = (st >> 1) * 16 + swz / 64; C = (st & 1) * 32 + (swz % 64) / 2; }
__host__ __device__ __forceinline__ int perm32(int rho) { const int n = rho >> 4, i = rho & 15; return 8 * (i >> 2) + 4 * n + (i & 3); }

struct Unit { int pm, pn; };
struct Gemm { const bf16_t* A; const bf16_t* Bt; int M, N, K; };

struct StaticOrder {
    int nM, nN, nwg, G, c;
    __host__ __device__ void init(int M, int N, int G_, int c_) { nM = M / BM; nN = N / BM; nwg = nM * nN; G = G_; c = c_; }
    __host__ __device__ bool next(int i, Unit& u) const {
        const long L = (long)i * G + c; if (L >= nwg) return false;
        int wgid = (int)L; { const int q = nwg / NXCD, r = nwg % NXCD, xcd = wgid % NXCD, off = wgid / NXCD; wgid = (xcd < r ? xcd * (q + 1) : r * (q + 1) + (xcd - r) * q) + off; }
        const int nig = WGM * nN, gid = wgid / nig, fm = gid * WGM, gsz = (nM - fm) < WGM ? (nM - fm) : WGM;
        u.pm = fm + ((wgid % nig) % gsz); u.pn = (wgid % nig) / gsz; return true;
    }
    __device__ __forceinline__ void a_ready(const Unit&) const {}
    __device__ __forceinline__ void done(const Unit&) const {}
};
__device__ __forceinline__ unsigned cvt_pk_bf16(float lo, float hi) { unsigned r; asm volatile("v_cvt_pk_bf16_f32 %0, %1, %2" : "=v"(r) : "v"(lo), "v"(hi)); return r; }
typedef int i32x8 __attribute__((ext_vector_type(8)));
typedef short s16x16 __attribute__((ext_vector_type(16)));
typedef int i32x4 __attribute__((ext_vector_type(4)));
template <class Epi, class Sched, bool ALIGN_EPI = false, bool SP2 = false, bool F8 = false, bool I8 = false>
__device__ __forceinline__ void gemm_phase(PG8_LAS unsigned char* lds, const Gemm g, const Sched& S, const Epi& E) {
    int tid_ = threadIdx.x; asm volatile("" : "+v"(tid_)); const int tid = tid_, wid = __builtin_amdgcn_readfirstlane(tid >> 6), lane = tid & 63, wr = wid >> 2, wc = wid & 3, fr = lane & 15, fq = lane >> 4;
    const int K = g.K, nt = K / BK;
    unsigned voffA[2], voffB[2];
#pragma unroll
    for (int i = 0; i < 2; ++i) { int R, C; stage_rc(tid * 16 + i * 8192, R, C); const int Rb = Epi::PERM ? ((R & ~31) + perm32(R & 31)) : R;
        voffA[i] = (unsigned)(R * K + C) * 2u; voffB[i] = (unsigned)(Rb * K + C) * 2u; }
    const size_t kstep = (size_t)(BK * 2);
    const size_t hstep = (size_t)HALF * K * 2;
    const size_t tstep = 2 * hstep;
    const unsigned ldsw = (unsigned)wid * 1024u;
    const int aoff = lds_byte(wr * 64 + fr, fq * 8), boff = lds_byte(wc * 32 + fr, fq * 8);
#define PG8_SA(b, h) (((b) * 2 + (h)) * HTB)
#define PG8_SB(b, h) ((4 + (b) * 2 + (h)) * HTB)
#define PG8_STAGE(bufoff, gbase, voff) do { _Pragma("unroll") for (int _i = 0; _i < 2; ++_i) \
        __builtin_amdgcn_global_load_lds((const unsigned*)((const char*)(gbase) + (voff)[_i]), (PG8_LAS unsigned*)(lds + (bufoff) + ldsw + _i * 8192), 16, 0, 0); } while (0)
#define PG8_LDA(dst, b, h) do { if constexpr (F8) { _Pragma("unroll") for (int m = 0; m < 4; ++m) dst##8[m] = PG8_CAT(*(const PG8_LAS bf16x8*)(lds + PG8_SA(b, h) + aoff + m * 2048), *(const PG8_LAS bf16x8*)(lds + PG8_SA(b, h) + aoff + m * 2048 + 1024)); } \
        else { _Pragma("unroll") for (int m = 0; m < 4; ++m) _Pragma("unroll") for (int k = 0; k < 2; ++k) dst[m][k] = *(const PG8_LAS bf16x8*)(lds + PG8_SA(b, h) + aoff + m * 2048 + k * 1024); } } while (0)
#define PG8_LDB(dst, b, h) do { if constexpr (F8) { _Pragma("unroll") for (int n = 0; n < 2; ++n) dst##8[n] = PG8_CAT(*(const PG8_LAS bf16x8*)(lds + PG8_SB(b, h) + boff + n * 2048), *(const PG8_LAS bf16x8*)(lds + PG8_SB(b, h) + boff + n * 2048 + 1024)); } \
        else { _Pragma("unroll") for (int n = 0; n < 2; ++n) _Pragma("unroll") for (int k = 0; k < 2; ++k) dst[n][k] = *(const PG8_LAS bf16x8*)(lds + PG8_SB(b, h) + boff + n * 2048 + k * 1024); } } while (0)
#define PG8_CAT(lo, hi) __builtin_bit_cast(i32x8, __builtin_shufflevector(lo, hi, 0, 1, 2, 3, 4, 5, 6, 7, 8, 9, 10, 11, 12, 13, 14, 15))
#define PG8_MMA(ai, bj, At, Bt) do { __builtin_amdgcn_s_setprio(1); _Pragma("unroll") for (int m = 0; m < 4; ++m) _Pragma("unroll") for (int n = 0; n < 2; ++n) { \
        if constexpr (F8) asm volatile("v_mfma_scale_f32_16x16x128_f8f6f4 %0, %1, %2, %0, %3, %3 op_sel_hi:[0,0,0]" : "+v"(acc[ai][bj][m][n]) : "v"(Bt##8[n]), "v"(At##8[m]), "v"(f8scale)); \
        else if constexpr (I8) { _Pragma("unroll") for (int k = 0; k < 2; ++k) acc[ai][bj][m][n] = __builtin_bit_cast(f32x4, __builtin_amdgcn_mfma_i32_16x16x64_i8(__builtin_bit_cast(i32x4, Bt[n][k]), __builtin_bit_cast(i32x4, At[m][k]), __builtin_bit_cast(i32x4, acc[ai][bj][m][n]), 0, 0, 0)); } \
        else { _Pragma("unroll") for (int k = 0; k < 2; ++k) acc[ai][bj][m][n] = __builtin_amdgcn_mfma_f32_16x16x32_bf16(Bt[n][k], At[m][k], acc[ai][bj][m][n], 0, 0, 0); } } \
        __builtin_amdgcn_s_setprio(0); } while (0)
#define PG8_WAIT_V(n) asm volatile("s_waitcnt vmcnt(" #n ")" ::: "memory")
#define PG8_WAIT_L(n) asm volatile("s_waitcnt lgkmcnt(" #n ")" ::: "memory")
#define PG8_BAR __builtin_amdgcn_s_barrier()
#define PG8_SCHED __builtin_amdgcn_sched_barrier(0)
    Unit cur, nxt; int ui = 0;
    if (!S.next(0, cur)) return;
    f32x4 acc[2][2][4][2];
#pragma unroll
    for (int a = 0; a < 2; ++a)
#pragma unroll
        for (int b = 0; b < 2; ++b)
#pragma unroll
            for (int m = 0; m < 4; ++m)
#pragma unroll
                for (int n = 0; n < 2; ++n) acc[a][b][m][n] = (f32x4){0.f, 0.f, 0.f, 0.f};
    bf16x8 At[4][2], B0[2][2], B1[2][2]; i32x8 At8[4], B08[2], B18[2];
    int f8scale = 0x7f7f7f7f; asm volatile("" : "+v"(f8scale));
    const char* cA = (const char*)g.A + (size_t)cur.pm * tstep; const char* cB = (const char*)g.Bt + (size_t)cur.pn * tstep;
    S.a_ready(cur);
    if constexpr (SP2) {
        PG8_STAGE(PG8_SB(0, 0), cB, voffB); PG8_STAGE(PG8_SB(0, 1), cB + hstep, voffB); PG8_STAGE(PG8_SA(0, 0), cA, voffA); PG8_STAGE(PG8_SA(0, 1), cA + hstep, voffA);
        if (wr == 1) PG8_BAR;
        PG8_WAIT_V(2); PG8_BAR;
        PG8_STAGE(PG8_SB(1, 0), cB + kstep, voffB); PG8_STAGE(PG8_SA(1, 0), cA + kstep, voffA); PG8_STAGE(PG8_SB(1, 1), cB + hstep + kstep, voffB);
        PG8_WAIT_V(6); PG8_BAR;
    } else {
        PG8_STAGE(PG8_SB(0, 0), cB, voffB); PG8_STAGE(PG8_SA(0, 0), cA, voffA); PG8_STAGE(PG8_SB(0, 1), cB + hstep, voffB); PG8_STAGE(PG8_SA(0, 1), cA + hstep, voffA);
        if (wr == 1) PG8_BAR;
        PG8_WAIT_V(4); PG8_BAR;
        PG8_STAGE(PG8_SB(1, 0), cB + kstep, voffB); PG8_STAGE(PG8_SA(1, 0), cA + kstep, voffA); PG8_STAGE(PG8_SB(1, 1), cB + hstep + kstep, voffB);
        PG8_WAIT_V(6); PG8_BAR;
    }
    for (;;) {
        const bool has_next = S.next(ui + 1, nxt);
        const char* nA = has_next ? (const char*)g.A + (size_t)nxt.pm * tstep : cA; const char* nB = has_next ? (const char*)g.Bt + (size_t)nxt.pn * tstep : cB;
        for (int t = 0; t < nt; t += 2) {
            const bool last = (t == nt - 2);
            const char* a1 = cA + (size_t)(t + 1) * kstep;
            const char* a2 = last ? nA : cA + (size_t)(t + 2) * kstep; const char* b2 = last ? nB : cB + (size_t)(t + 2) * kstep;
            const char* a3 = a2 + kstep; const char* b3 = b2 + kstep;
            if (last && has_next) S.a_ready(nxt);
            if constexpr (SP2) {
            PG8_LDB(B0, 0, 0); PG8_LDB(B1, 0, 1); PG8_SCHED; PG8_LDA(At, 0, 0); PG8_STAGE(PG8_SA(1, 1), a1 + hstep, voffA);
            PG8_WAIT_V(8); PG8_WAIT_L(0); PG8_BAR; PG8_MMA(0, 0, At, B0); PG8_MMA(0, 1, At, B1); PG8_BAR; PG8_SCHED;
            PG8_LDA(At, 0, 1); PG8_STAGE(PG8_SB(0, 0), b2, voffB); PG8_STAGE(PG8_SB(0, 1), b2 + hstep, voffB); PG8_STAGE(PG8_SA(0, 0), a2, voffA);
            PG8_WAIT_V(8); PG8_WAIT_L(0); PG8_BAR; PG8_MMA(1, 0, At, B0); PG8_MMA(1, 1, At, B1); PG8_BAR; PG8_SCHED;
            PG8_LDB(B0, 1, 0); PG8_LDB(B1, 1, 1); PG8_SCHED; PG8_LDA(At, 1, 0); PG8_STAGE(PG8_SA(0, 1), a2 + hstep, voffA);
            PG8_WAIT_V(8); PG8_WAIT_L(0); PG8_BAR; PG8_MMA(0, 0, At, B0); PG8_MMA(0, 1, At, B1); PG8_BAR; PG8_SCHED;
            PG8_LDA(At, 1, 1); PG8_STAGE(PG8_SB(1, 0), b3, voffB); PG8_STAGE(PG8_SB(1, 1), b3 + hstep, voffB); PG8_STAGE(PG8_SA(1, 0), a3, voffA);
            PG8_WAIT_V(8); PG8_WAIT_L(0); PG8_BAR; PG8_MMA(1, 0, At, B0); PG8_MMA(1, 1, At, B1); PG8_BAR; PG8_SCHED;
            } else {
            PG8_LDB(B0, 0, 0); PG8_SCHED; PG8_LDA(At, 0, 0); PG8_STAGE(PG8_SA(1, 1), a1 + hstep, voffA);
            PG8_WAIT_L(8); PG8_BAR; PG8_WAIT_L(0); PG8_MMA(0, 0, At, B0); PG8_BAR; PG8_SCHED;
            PG8_LDB(B1, 0, 1); PG8_STAGE(PG8_SB(0, 0), b2, voffB);
            PG8_BAR; PG8_WAIT_L(0); PG8_MMA(0, 1, At, B1); PG8_BAR;
            PG8_LDA(At, 0, 1); PG8_STAGE(PG8_SA(0, 0), a2, voffA);
            PG8_BAR; PG8_WAIT_L(0); PG8_MMA(1, 0, At, B0); PG8_BAR; PG8_SCHED;
            PG8_STAGE(PG8_SB(0, 1), b2 + hstep, voffB);
            PG8_WAIT_V(6); PG8_BAR; PG8_MMA(1, 1, At, B1); PG8_BAR;
            PG8_LDB(B0, 1, 0); PG8_SCHED; PG8_LDA(At, 1, 0); PG8_STAGE(PG8_SA(0, 1), a2 + hstep, voffA);
            PG8_WAIT_L(8); PG8_BAR; PG8_WAIT_L(0); PG8_MMA(0, 0, At, B0); PG8_BAR; PG8_SCHED;
            PG8_LDB(B1, 1, 1); PG8_STAGE(PG8_SB(1, 0), b3, voffB);
            PG8_BAR; PG8_WAIT_L(0); PG8_MMA(0, 1, At, B1); PG8_BAR;
            PG8_LDA(At, 1, 1); PG8_STAGE(PG8_SA(1, 0), a3, voffA);
            PG8_BAR; PG8_WAIT_L(0); PG8_MMA(1, 0, At, B0); PG8_BAR; PG8_SCHED;
            PG8_STAGE(PG8_SB(1, 1), b3 + hstep, voffB);
            PG8_WAIT_V(6); PG8_BAR; PG8_MMA(1, 1, At, B1); PG8_BAR;
            }
        }
        if constexpr (F8) asm volatile("s_nop 7\n\ts_nop 7\n\ts_nop 7" ::: "memory");
        if constexpr (I8) {
#pragma unroll
            for (int a = 0; a < 2; ++a)
#pragma unroll
                for (int b = 0; b < 2; ++b)
#pragma unroll
                    for (int m = 0; m < 4; ++m)
#pragma unroll
                        for (int n = 0; n < 2; ++n) { const i32x4 iv = __builtin_bit_cast(i32x4, acc[a][b][m][n]); acc[a][b][m][n] = (f32x4){(float)iv[0], (float)iv[1], (float)iv[2], (float)iv[3]}; }
        }
        if constexpr (ALIGN_EPI) { if (wr == 0) PG8_BAR; }
#if defined(PROBE_EPI) && PROBE_EPI
        { const unsigned long long te0_ = __builtin_amdgcn_s_memrealtime();
          if constexpr (!Epi::AFTER_DRAIN) { E(acc, cur, wr, wc, fr, fq); S.done(cur); }
          const unsigned long long ted_ = __builtin_amdgcn_s_memrealtime() - te0_, ts_ = __builtin_amdgcn_s_memrealtime();
          while (__builtin_amdgcn_s_memrealtime() - ts_ < ted_) __builtin_amdgcn_s_sleep(1); }
#else
        if constexpr (!Epi::AFTER_DRAIN) { E(acc, cur, wr, wc, fr, fq); S.done(cur); }
#endif
        if (!has_next) break;
#pragma unroll
        for (int a = 0; a < 2; ++a)
#pragma unroll
            for (int b = 0; b < 2; ++b)
#pragma unroll
                for (int m = 0; m < 4; ++m)
#pragma unroll
                    for (int n = 0; n < 2; ++n) acc[a][b][m][n] = (f32x4){0.f, 0.f, 0.f, 0.f};
        cur = nxt; cA = nA; cB = nB; ++ui;
        if constexpr (ALIGN_EPI) { if (wr == 1) PG8_BAR; }
    }
    PG8_WAIT_V(0);
    if constexpr (!ALIGN_EPI) { if (wr == 0) PG8_BAR; }
    PG8_BAR;
    if constexpr (Epi::AFTER_DRAIN) { E.fused(acc, cur, wr, wc, fr, fq, lds, wid, lane); S.done(cur); }
#undef PG8_SA
#undef PG8_SB
#undef PG8_STAGE
#undef PG8_LDA
#undef PG8_LDB
#undef PG8_MMA
#undef PG8_CAT
#undef PG8_WAIT_V
#undef PG8_WAIT_L
#undef PG8_BAR
#undef PG8_SCHED
}
}
#ifndef PROBE_DUP
#define PROBE_DUP 0
#endif
#define REP(k) (PROBE_DUP == (k) ? 2 : 1)
#ifndef PROBE_AMP_MASK
#define PROBE_AMP_MASK 0
#endif
#ifndef PROBE_AMP_BAR
#define PROBE_AMP_BAR 0
#endif

constexpr int DM = 2048, NTOK = 16384, NCTX = 8192, CTX_T = 256, LAT_T = 4096, PAST = 512;
constexpr int DFF = 5632, NFF2 = 11264, INC = 5120, MODW = 18432, ZBC = 4096;
constexpr int ZQ = 0, ZK = 1024, ZV = 1280, ZRQ = 1536, ZRF = 2048, ZRB = 2560, ZRI = 3072, ZRG = 3584, ZCA = 4096, ZCB = 4608;
constexpr float EPS = 1e-6f;
constexpr size_t OUT_Y = 0, OUT_CK = 33554432, OUT_CV = 37748736, OUT_ST = 41943040, OUT_TOTAL = 50331648;
constexpr size_t MiB = 1u << 20;
constexpr size_t WS_RS0 = 0;
constexpr size_t WS_CTL = 1242 * MiB, WS_MOD = 1243 * MiB, CTL_ZERO_BYTES = 2 * MiB;
constexpr size_t WS_WFI = 2 * MiB;
constexpr size_t WS_WFO = 178 * MiB;
constexpr size_t WS_WIN = 266 * MiB;
constexpr size_t WS_WOUT = 306 * MiB;
constexpr size_t WS_H = 322 * MiB;
constexpr size_t WS_MIX = 386 * MiB;
constexpr size_t WS_Z = 450 * MiB;
constexpr size_t WS_LF = 578 * MiB;
constexpr size_t WS_US = 770 * MiB;
constexpr size_t WS_KP = 898 * MiB;
constexpr size_t WS_VP = 914 * MiB;
constexpr size_t WS_DEC = 1026 * MiB;
constexpr size_t WS_Q = 1028 * MiB;
constexpr size_t WS_K = 1060 * MiB;
constexpr size_t WS_V = 1068 * MiB;
constexpr size_t WS_CK = 1076 * MiB;
constexpr size_t WS_CV = 1077 * MiB;
constexpr size_t WS_GLU = 1078 * MiB;
constexpr size_t WS_ST16 = 1110 * MiB;
constexpr size_t WS_BIAS = 1238 * MiB;
constexpr size_t WS_GV = 1239 * MiB;
constexpr size_t WS_MODI = 1240 * MiB;
constexpr size_t WS_SSQ = 1241 * MiB;
constexpr size_t WS_END = 1242 * MiB;
constexpr size_t WS_W8 = 1244 * MiB;
constexpr size_t W8_STRIDE = 34 * MiB, W8O_OFF = 22 * MiB;
constexpr size_t WS_TOP = WS_W8 + 4 * W8_STRIDE;
constexpr float W8I_SC = 32.f, W8O_SC = 256.f;
#ifndef FP8_MASK
#define FP8_MASK 15
#endif
#ifndef FP8_MASK_OUT
#define FP8_MASK_OUT 15
#endif
#ifndef FFI_INT8
#define FFI_INT8 1
#endif
constexpr float I8_C = 6.5f;
constexpr float I8_WSC = 127.f / 0.1f;
constexpr bool f8on(int f) { return f >= (FFI_INT8 ? 0 : 1) && f <= 3 && ((FP8_MASK >> f) & 1); }
constexpr bool f8out(int f) { return f >= 0 && f <= 3 && ((FP8_MASK_OUT >> f) & 1); }
constexpr size_t WS_LBV = WS_MOD + 512 * 1024;
constexpr float FXM = 1073741824.f, IFXM = 1.f / 1073741824.f, FXS = 1048576.f, IFXS = 1.f / 1048576.f;
constexpr int CW_BAR = 4096;
constexpr int RING_BYTES = 131072, LDSCTL_OFF = RING_BYTES, LDS_BYTES = 147456;

#define GAS __attribute__((address_space(1)))
#define LAS __attribute__((address_space(3)))
typedef unsigned short bf16;
typedef unsigned v4u __attribute__((ext_vector_type(4)));
typedef unsigned v2u __attribute__((ext_vector_type(2)));
typedef float f32x4 __attribute__((ext_vector_type(4)));
typedef float f32x2 __attribute__((ext_vector_type(2)));
typedef short bf16x8 __attribute__((ext_vector_type(8)));
#define LDS_WAIT() asm volatile("s_waitcnt lgkmcnt(0)" ::: "memory")
#define VM_WAIT() asm volatile("s_waitcnt vmcnt(0)" ::: "memory")
#define LDS_BARRIER() do { asm volatile("s_waitcnt lgkmcnt(0)" ::: "memory"); __builtin_amdgcn_s_barrier(); asm volatile("" ::: "memory"); } while (0)
__device__ __forceinline__ unsigned pk2(float lo, float hi) { return pg8::cvt_pk_bf16(lo, hi); }
__device__ __forceinline__ float bf2f(unsigned x) { return __uint_as_float(x << 16); }
__device__ __forceinline__ int qi8(float x) { const int i = (int)__builtin_rintf(x); return i < -127 ? -127 : (i > 127 ? 127 : i); }
__device__ __forceinline__ unsigned pki8(float a, float b, float c, float d) { return (unsigned)(qi8(a) & 255) | ((unsigned)(qi8(b) & 255) << 8) | ((unsigned)(qi8(c) & 255) << 16) | ((unsigned)qi8(d) << 24); }
__device__ __forceinline__ float i8f(unsigned w, int b) { return (float)((int)(w << (24 - 8 * b)) >> 24); }
__device__ __forceinline__ unsigned pk8(float a, float b, float c, float d) { int w = __builtin_amdgcn_cvt_pk_fp8_f32(a, b, 0, false); w = __builtin_amdgcn_cvt_pk_fp8_f32(c, d, w, true); return (unsigned)w; }
__device__ __forceinline__ unsigned short f2bf(float f) { return (unsigned short)(pg8::cvt_pk_bf16(f, 0.f) & 0xffffu); }
#ifndef EMU_FP8
#define EMU_FP8 0
#endif
__device__ __forceinline__ float q8(float x) { const int w = __builtin_amdgcn_cvt_pk_fp8_f32(x, x, 0, false); return __builtin_amdgcn_cvt_f32_fp8(w, 0); }
__device__ __forceinline__ float q8s(float x, float sc, float isc) { return q8(x * sc) * isc; }
__device__ __forceinline__ float sigm(float x) { return __builtin_amdgcn_rcpf(1.f + __expf(-x)); }
__device__ __forceinline__ float siluf(float x) { return x * __builtin_amdgcn_rcpf(1.f + __expf(-x)); }
template <int CTRL> __device__ __forceinline__ float dpp_get(float v) { return __builtin_bit_cast(float, __builtin_amdgcn_update_dpp(0, __builtin_bit_cast(int, v), CTRL, 0xF, 0xF, true)); }
__device__ __forceinline__ float row_sum16(float v) {
    v += dpp_get<0xB1>(v);
    v += dpp_get<0x4E>(v);
    v += dpp_get<0x141>(v);
    v += dpp_get<0x140>(v);
    return v;
}
__device__ __forceinline__ float xrow_sum(float v) {
    { const auto r = __builtin_amdgcn_permlane16_swap(__float_as_uint(v), __float_as_uint(v), false, false); v = __uint_as_float(r[0]) + __uint_as_float(r[1]); }
    { const auto r = __builtin_amdgcn_permlane32_swap(__float_as_uint(v), __float_as_uint(v), false, false); v = __uint_as_float(r[0]) + __uint_as_float(r[1]); }
    return v;
}
__device__ __forceinline__ float wave_sum(float v) { return xrow_sum(row_sum16(v)); }
__device__ __forceinline__ float wave_max(float v) {
    v = fmaxf(v, dpp_get<0xB1>(v)); v = fmaxf(v, dpp_get<0x4E>(v)); v = fmaxf(v, dpp_get<0x141>(v)); v = fmaxf(v, dpp_get<0x140>(v));
    { const auto r = __builtin_amdgcn_permlane16_swap(__float_as_uint(v), __float_as_uint(v), false, false); v = fmaxf(__uint_as_float(r[0]), __uint_as_float(r[1])); }
    { const auto r = __builtin_amdgcn_permlane32_swap(__float_as_uint(v), __float_as_uint(v), false, false); v = fmaxf(__uint_as_float(r[0]), __uint_as_float(r[1])); }
    return v;
}

namespace pg8 {
struct EpiF32 {
    static constexpr bool PERM = false, AFTER_DRAIN = false;
    float* C; int ldc;
    __device__ __forceinline__ void operator()(const f32x4 (&acc)[2][2][4][2], const Unit& u, int wr, int wc, int fr, int fq) const {
        const int row0 = u.pm * BM + wr * 64 + fr, col0 = u.pn * BM + wc * 32 + 4 * fq;
#pragma unroll
        for (int ai = 0; ai < 2; ++ai)
#pragma unroll
            for (int m = 0; m < 4; ++m) { float* rowp = C + (size_t)(row0 + ai * HALF + m * 16) * ldc + col0;
#pragma unroll
                for (int bj = 0; bj < 2; ++bj)
#pragma unroll
                    for (int n = 0; n < 2; ++n) *(f32x4*)(rowp + bj * HALF + n * 16) = acc[ai][bj][m][n]; }
    }
};
struct EpiWin {
    static constexpr bool PERM = true, AFTER_DRAIN = false;
    unsigned char* ws; int l, slot;
    __device__ __forceinline__ void operator()(const f32x4 (&acc)[2][2][4][2], const Unit& u, int wr, int wc, int fr, int fq) const {
        bf16_t* Zb = (bf16_t*)(ws + WS_Z); float* LF = (float*)(ws + WS_LF); const float* lbv = (const float*)(ws + WS_LBV) + l * 1024; bf16_t* GLU = (bf16_t*)(ws + WS_GLU);
        const unsigned long long* ssq = (const unsigned long long*)(ws + WS_SSQ) + (size_t)slot * NTOK; const float* bias = (const float*)(ws + WS_BIAS) + (size_t)slot * 3 * NFF2;
        const int row0 = u.pm * BM + wr * 64 + fr, col0 = u.pn * BM + wc * 32 + 8 * fq;
        const int cond = u.pm < 32 ? 0 : 1 + ((u.pm - 32) >> 4);
        const bool gate = u.pn >= 8 && u.pn < 12;
        f32x4 bv[2][2], lb[2][2]; unsigned long long sq[2][4];
#pragma unroll
        for (int bj = 0; bj < 2; ++bj)
#pragma unroll
            for (int n = 0; n < 2; ++n) { bv[bj][n] = *(const f32x4*)(bias + (size_t)cond * 11264 + col0 + bj * HALF + 4 * n);
                lb[bj][n] = gate ? *(const f32x4*)(lbv + (col0 - 2048) + bj * HALF + 4 * n) : (f32x4){0.f, 0.f, 0.f, 0.f}; }
#pragma unroll
        for (int ai = 0; ai < 2; ++ai)
#pragma unroll
            for (int m = 0; m < 4; ++m) sq[ai][m] = ssq[row0 + ai * HALF + m * 16];
        asm volatile("" ::: "memory");
        if (gate) {
#pragma unroll
            for (int ai = 0; ai < 2; ++ai)
#pragma unroll
                for (int m = 0; m < 4; ++m) { const int row = row0 + ai * HALF + m * 16; const float rs = __builtin_amdgcn_rsqf((float)sq[ai][m] * (IFXS / 2048.f) + 1e-6f);
#pragma unroll
                    for (int bj = 0; bj < 2; ++bj) { float kv[8]; f32x4 lv[2];
#pragma unroll
                        for (int n = 0; n < 2; ++n)
#pragma unroll
                            for (int j = 0; j < 4; ++j) { const float z = fminf(fmaxf(acc[ai][bj][m][n][j] * rs + bv[bj][n][j], -80.f), 80.f), lbj = lb[bj][n][j], ez = __expf(-z);
                                const float sg = __builtin_amdgcn_rcpf(1.f + ez), sn = ez * sg;
                                kv[4 * n + j] = (1.f - lbj) * sn; lv[n][j] = __logf(fmaxf(lbj + (1.f - lbj) * sg, 1e-30f)); }
                        u32x4 w; w.x = cvt_pk_bf16(kv[0], kv[1]); w.y = cvt_pk_bf16(kv[2], kv[3]); w.z = cvt_pk_bf16(kv[4], kv[5]); w.w = cvt_pk_bf16(kv[6], kv[7]);
                        *(u32x4*)(Zb + (size_t)row * ZBC + col0 + bj * HALF) = w;
                        float* lp = LF + (size_t)row * 1024 + (col0 - 2048) + bj * HALF; *(f32x4*)lp = lv[0]; *(f32x4*)(lp + 4) = lv[1]; } }
        } else if (u.pn >= 16) {
            const int c0 = (u.pn - 16) * HALF + wc * 32 + 8 * fq;
#pragma unroll
            for (int ai = 0; ai < 2; ++ai)
#pragma unroll
                for (int m = 0; m < 4; ++m) { const int row = row0 + ai * HALF + m * 16; const float rs = __builtin_amdgcn_rsqf((float)sq[ai][m] * (IFXS / 2048.f) + 1e-6f);
                    float gv[8];
#pragma unroll
                    for (int n = 0; n < 2; ++n)
#pragma unroll
                        for (int j = 0; j < 4; ++j) { const float a = acc[ai][0][m][n][j] * rs + bv[0][n][j], b = acc[ai][1][m][n][j] * rs + bv[1][n][j]; gv[4 * n + j] = a * __builtin_amdgcn_rcpf(1.f + __expf(-b)); }
                    u32x4 w; w.x = cvt_pk_bf16(gv[0], gv[1]); w.y = cvt_pk_bf16(gv[2], gv[3]); w.z = cvt_pk_bf16(gv[4], gv[5]); w.w = cvt_pk_bf16(gv[6], gv[7]);
                    *(u32x4*)(GLU + (size_t)row * 512 + c0) = w; }
        } else {
#pragma unroll
            for (int ai = 0; ai < 2; ++ai)
#pragma unroll
                for (int m = 0; m < 4; ++m) { const int row = row0 + ai * HALF + m * 16; const float rs = __builtin_amdgcn_rsqf((float)sq[ai][m] * (IFXS / 2048.f) + 1e-6f);
#pragma unroll
                    for (int bj = 0; bj < 2; ++bj) { const f32x4 z0 = acc[ai][bj][m][0] * rs + bv[bj][0], z1 = acc[ai][bj][m][1] * rs + bv[bj][1];
                        u32x4 w; w.x = cvt_pk_bf16(z0[0], z0[1]); w.y = cvt_pk_bf16(z0[2], z0[3]); w.z = cvt_pk_bf16(z1[0], z1[1]); w.w = cvt_pk_bf16(z1[2], z1[3]);
                        *(u32x4*)(Zb + (size_t)row * ZBC + col0 + bj * HALF) = w; } }
        }
    }
};
template <bool O8, bool I8 = false>
struct EpiSwiGLUT {
    static constexpr bool PERM = true, AFTER_DRAIN = false;
    unsigned char* ws; int slot; float accs;
    __device__ __forceinline__ void operator()(const f32x4 (&acc)[2][2][4][2], const Unit& u, int wr, int wc, int fr, int fq) const {
        bf16_t* O = (bf16_t*)(ws + WS_Z); constexpr int ldc = DFF; const unsigned long long* ssq = (const unsigned long long*)(ws + WS_SSQ) + (size_t)slot * NTOK; const float* bias = (const float*)(ws + WS_BIAS) + (size_t)slot * 3 * NFF2;
        const int row0 = u.pm * BM + wr * 64 + fr, col0 = u.pn * HALF + wc * 32 + 8 * fq;
        const int cond = u.pm < 32 ? 0 : 1 + ((u.pm - 32) >> 4);
        const float* bp = bias + (size_t)cond * 11264 + u.pn * BM + wc * 32 + 8 * fq;
        f32x4 bA[2], bB[2];
#pragma unroll
        for (int n = 0; n < 2; ++n) { bA[n] = *(const f32x4*)(bp + 4 * n); bB[n] = *(const f32x4*)(bp + HALF + 4 * n); }
        unsigned long long sq[2][4], sqp[2][4]; float rs0[2][4];
#pragma unroll
        for (int ai = 0; ai < 2; ++ai)
#pragma unroll
            for (int m = 0; m < 4; ++m) { sq[ai][m] = ssq[row0 + ai * HALF + m * 16]; sqp[ai][m] = (I8 && slot != 0) ? (ssq - NTOK)[row0 + ai * HALF + m * 16] : 0ull; rs0[ai][m] = (I8 && slot == 0) ? ((const float*)(ws + WS_RS0))[row0 + ai * HALF + m * 16] : 0.f; }
        asm volatile("" ::: "memory");
        typedef float f32x2 __attribute__((ext_vector_type(2)));
        constexpr float NL2E = -1.4426950408889634f;
        f32x4 nbA[2];
#pragma unroll
        for (int n = 0; n < 2; ++n) nbA[n] = bA[n] * NL2E;
#pragma unroll
        for (int ai = 0; ai < 2; ++ai)
#pragma unroll
            for (int m = 0; m < 4; ++m) { const int row = row0 + ai * HALF + m * 16; bf16_t* rowp = O + (size_t)row * ldc + col0;
                const float rs = __builtin_amdgcn_rsqf((float)sq[ai][m] * (IFXS / 2048.f) + 1e-6f) * accs * (I8 ? (slot == 0 ? rs0[ai][m] : (I8_C / 127.f) * __builtin_sqrtf((float)sqp[ai][m] * (IFXS / 2048.f) + 1e-6f)) : 1.f), nrs = rs * NL2E;
                const f32x2 rs2 = {rs, rs}, nrs2 = {nrs, nrs}, one2 = {1.f, 1.f};
                f32x2 o[4];
#pragma unroll
                for (int n = 0; n < 2; ++n)
#pragma unroll
                    for (int hh = 0; hh < 2; ++hh) {
                        const f32x4 a4 = acc[ai][0][m][n], b4 = acc[ai][1][m][n];
                        const f32x2 aa = hh ? __builtin_shufflevector(a4, a4, 2, 3) : __builtin_shufflevector(a4, a4, 0, 1), bb = hh ? __builtin_shufflevector(b4, b4, 2, 3) : __builtin_shufflevector(b4, b4, 0, 1);
                        const f32x2 ba = hh ? __builtin_shufflevector(bA[n], bA[n], 2, 3) : __builtin_shufflevector(bA[n], bA[n], 0, 1), bbv = hh ? __builtin_shufflevector(bB[n], bB[n], 2, 3) : __builtin_shufflevector(bB[n], bB[n], 0, 1);
                        const f32x2 nba = hh ? __builtin_shufflevector(nbA[n], nbA[n], 2, 3) : __builtin_shufflevector(nbA[n], nbA[n], 0, 1);
                        const f32x2 za = aa * rs2 + ba, zb = bb * rs2 + bbv, t = aa * nrs2 + nba;
                        f32x2 e; e.x = __builtin_amdgcn_exp2f(t.x); e.y = __builtin_amdgcn_exp2f(t.y);
                        const f32x2 dn = e + one2; f32x2 r; r.x = __builtin_amdgcn_rcpf(dn.x); r.y = __builtin_amdgcn_rcpf(dn.y);
                        o[n * 2 + hh] = (za * zb) * r; }
                if constexpr (O8) { v2u w8; w8.x = pk8(o[0].x, o[0].y, o[1].x, o[1].y); w8.y = pk8(o[2].x, o[2].y, o[3].x, o[3].y);
                    *(v2u*)((unsigned char*)O + (size_t)row * ldc + col0) = w8; }
                else { u32x4 w; w.x = cvt_pk_bf16(o[0].x, o[0].y); w.y = cvt_pk_bf16(o[1].x, o[1].y); w.z = cvt_pk_bf16(o[2].x, o[2].y); w.w = cvt_pk_bf16(o[3].x, o[3].y);
                    __builtin_nontemporal_store(w, (u32x4*)rowp); } }
    }
};
using EpiSwiGLU = EpiSwiGLUT<false>;
template <bool H8, bool HI8 = false>
struct EpiResidNormT {
    static constexpr bool PERM = true, AFTER_DRAIN = false;
    unsigned char* ws; float* X; const float* gb; int goff, nslot; float scale;
    const float* xin_p; const float* xin_s;
    __device__ __forceinline__ void operator()(const f32x4 (&acc)[2][2][4][2], const Unit& u, int wr, int wc, int fr, int fq) const {
        const float* gm = (const float*)(ws + WS_MOD) + goff; bf16_t* H = (bf16_t*)(ws + WS_H);
        const float* gnext = nslot >= 0 ? (const float*)(ws + WS_GV) + (size_t)nslot * 3 * DM : nullptr; unsigned long long* ssq_next = (unsigned long long*)(ws + WS_SSQ) + (size_t)(nslot >= 0 ? nslot : 0) * NTOK;
        const int row0 = u.pm * BM + wr * 64 + fr, col0 = u.pn * BM + wc * 32 + 8 * fq;
        const int cond = u.pm < 32 ? 0 : 1 + ((u.pm - 32) >> 4);
        const float* g0 = gm + (size_t)cond * 2 * 18432;
        const bool nx = gnext != nullptr;
        const float* Xrd = xin_p ? (u.pm < 32 ? xin_p : xin_s - (size_t)NCTX * DM) : X;
#ifndef RN_DEPTH
#define RN_DEPTH 6
#endif
        float qsr[8];
#pragma unroll
        for (int it = 0; it < 8; ++it) qsr[it] = (H8 && HI8) ? (127.f / I8_C) * __builtin_amdgcn_rsqf((float)(ssq_next - NTOK)[row0 + (it >> 2) * HALF + (it & 3) * 16] * (IFXS / 2048.f) + 1e-6f) : 0.f;
#define RN_ADV(r, st) do { r += (((st) & 3) == 3) ? 80 : 16; asm volatile("" : "+v"(r)); } while (0)
#define RN_LOAD(st, bj) do { const float* rp_ = Xrd + (size_t)rl * 2048 + col0 + (bj) * HALF; \
            xb[(st) % RN_DEPTH][0] = *(const f32x4*)rp_; xb[(st) % RN_DEPTH][1] = *(const f32x4*)(rp_ + 4); RN_ADV(rl, st); } while (0)
#pragma unroll
        for (int bj = 0; bj < 2; ++bj) {
            const f32x4 gv0 = (*(const f32x4*)(g0 + col0 + bj * HALF) + *(const f32x4*)(gb + col0 + bj * HALF)) * scale, gv1 = (*(const f32x4*)(g0 + col0 + bj * HALF + 4) + *(const f32x4*)(gb + col0 + bj * HALF + 4)) * scale;
            const f32x4 gn0 = nx ? *(const f32x4*)(gnext + (size_t)cond * 2048 + col0 + bj * HALF) : (f32x4){0.f, 0.f, 0.f, 0.f}, gn1 = nx ? *(const f32x4*)(gnext + (size_t)cond * 2048 + col0 + bj * HALF + 4) : (f32x4){0.f, 0.f, 0.f, 0.f};
            f32x4 xb[RN_DEPTH][2];
            int rl = row0, rw = row0; asm volatile("" : "+v"(rl), "+v"(rw));
#pragma unroll
            for (int st = 0; st < RN_DEPTH; ++st) RN_LOAD(st, bj);
            asm volatile("" ::: "memory");
#pragma unroll
            for (int it = 0; it < 8; ++it) { const int ai = it >> 2, m = it & 3; f32x4* p0 = (f32x4*)(X + (size_t)rw * 2048 + col0 + bj * HALF);
                const f32x4 x0 = xb[it % RN_DEPTH][0] + gv0 * acc[ai][bj][m][0], x1 = xb[it % RN_DEPTH][1] + gv1 * acc[ai][bj][m][1];
                p0[0] = x0; p0[1] = x1;
                if (nx) { const f32x4 h0 = x0 * gn0, h1 = x1 * gn1;
                    if constexpr (H8 && HI8) { const float qs = qsr[it];
                        v2u w8; w8.x = pki8(h0[0] * qs, h0[1] * qs, h0[2] * qs, h0[3] * qs); w8.y = pki8(h1[0] * qs, h1[1] * qs, h1[2] * qs, h1[3] * qs); *(v2u*)((unsigned char*)H + (size_t)rw * 2048 + col0 + bj * HALF) = w8; }
                    else if constexpr (H8) { v2u w8; w8.x = pk8(h0[0], h0[1], h0[2], h0[3]); w8.y = pk8(h1[0], h1[1], h1[2], h1[3]); *(v2u*)((unsigned char*)H + (size_t)rw * 2048 + col0 + bj * HALF) = w8; }
                    else { u32x4 w; w.x = cvt_pk_bf16(h0[0], h0[1]); w.y = cvt_pk_bf16(h0[2], h0[3]); w.z = cvt_pk_bf16(h1[0], h1[1]); w.w = cvt_pk_bf16(h1[2], h1[3]);
                        *(u32x4*)(H + (size_t)rw * 2048 + col0 + bj * HALF) = w; }
                    float ss = (x0[0] * x0[0] + x0[1] * x0[1]) + (x0[2] * x0[2] + x0[3] * x0[3]) + (x1[0] * x1[0] + x1[1] * x1[1]) + (x1[2] * x1[2] + x1[3] * x1[3]);
                    ss = xrow_sum(ss); if (fq == 0) atomicAdd(ssq_next + rw, __float2ull_rn(ss * FXS)); }
                RN_ADV(rw, it);
                asm volatile("" ::: "memory");
                if (it + RN_DEPTH < 8) { RN_LOAD(it + RN_DEPTH, bj); asm volatile("" ::: "memory"); } }
        }
#undef RN_LOAD
#undef RN_ADV
    }
};
using EpiResidNorm = EpiResidNormT<false>;
}
#define XB_TMO      128
#define XB_XCNT(j)  (256  + 64 * (j))
#define XB_XSUB(j)  (1280 + 64 * (j))
#define XB_XGEN(j)  (2304 + 64 * (j))
#define XB_TOP      3328
#define XB_TOPGEN   3392
#define XCD_BAR_WORDS 3456
#define XB_SPIN_CAP (1u << 18)

__device__ __forceinline__ unsigned xb_ld(unsigned* p)              { return __hip_atomic_load(p, __ATOMIC_RELAXED, __HIP_MEMORY_SCOPE_AGENT); }
__device__ __forceinline__ unsigned xb_add(unsigned* p, unsigned v) { return __hip_atomic_fetch_add(p, v, __ATOMIC_RELAXED, __HIP_MEMORY_SCOPE_AGENT); }
__device__ __forceinline__ unsigned xb_xcc_id() { return (unsigned)__builtin_amdgcn_s_getreg((3 << 11) | 20) & 0xFu; }
#define XB_SPIN(cond, bar) do { unsigned _sp = 0; while (cond) { __builtin_amdgcn_s_sleep(1); \
    if ((++_sp & 255u) == 0u) { if (xb_ld(&(bar)[XB_TMO])) break; if (_sp > XB_SPIN_CAP) { atomicAdd(&(bar)[XB_TMO], 1u); break; } } } } while (0)

struct XcdBarrier {
    unsigned* bar; unsigned x;
    volatile LAS unsigned* st;
};

__device__ __forceinline__ XcdBarrier xcd_barrier_post(unsigned* bar, volatile LAS unsigned* st) {
    XcdBarrier b; b.bar = bar; b.x = xb_xcc_id(); b.st = st;
    if (threadIdx.x == 0) (void)xb_add(&bar[XB_XCNT(b.x)], 1u);
    return b;
}
__device__ __forceinline__ void xcd_barrier_complete(unsigned* bar, unsigned x, unsigned& nloc, unsigned& nx) {
    const unsigned G = gridDim.x * gridDim.y * gridDim.z;
    unsigned sum, cnt, mine, sp = 0u;
    for (;;) {
        sum = 0u; cnt = 0u; mine = 0u;
#pragma unroll
        for (unsigned j = 0; j < 16; ++j) { const unsigned c = xb_ld(&bar[XB_XCNT(j)]); sum += c; cnt += (c > 0u) ? 1u : 0u; mine = (j == x) ? c : mine; }
        if (sum == G) break;
        __builtin_amdgcn_s_sleep(1);
        if ((++sp & 255u) == 0u) { if (xb_ld(&bar[XB_TMO])) break; if (sp > XB_SPIN_CAP) { atomicAdd(&bar[XB_TMO], 1u); break; } }
    }
    nloc = mine > 0u ? mine : 1u; nx = cnt > 0u ? cnt : 1u;
}

__device__ __forceinline__ void xcd_barrier(const XcdBarrier& b) {
    asm volatile("s_waitcnt vmcnt(0)" ::: "memory");
    __syncthreads();
    if (threadIdx.x == 0) {
        unsigned* bar = b.bar;
        __builtin_amdgcn_s_waitcnt(0);
        unsigned nloc = b.st[0], nx = b.st[1];
        if (nloc == 0u) { xcd_barrier_complete(bar, b.x, nloc, nx); b.st[0] = nloc; b.st[1] = nx; }
        const unsigned old = xb_add(&bar[XB_XSUB(b.x)], 1u);
        const unsigned gen = old / nloc;
        if (old + 1u == (gen + 1u) * nloc) {
            __builtin_amdgcn_fence(__ATOMIC_RELEASE, "agent");
            asm volatile("s_waitcnt vmcnt(0)" ::: "memory");
            const unsigned og = xb_add(&bar[XB_TOP], 1u);
            const unsigned tg = og / nx;
            if (og + 1u == (tg + 1u) * nx) xb_add(&bar[XB_TOPGEN], 1u);
            else XB_SPIN(xb_ld(&bar[XB_TOPGEN]) == tg, bar);
            __builtin_amdgcn_fence(__ATOMIC_ACQUIRE, "agent");
            xb_add(&bar[XB_XGEN(b.x)], 1u);
            asm volatile("s_waitcnt vmcnt(0)" ::: "memory");
        } else {
            XB_SPIN(xb_ld(&bar[XB_XGEN(b.x)]) == gen, bar);
            __builtin_amdgcn_fence(__ATOMIC_ACQUIRE, "agent");
            asm volatile("s_waitcnt vmcnt(0)" ::: "memory");
        }
    }
    __syncthreads();
}


namespace att {
constexpr int D = 128, NW = 8, QBLK = 32, KVBLK = 64;
constexpr float SCALE = 0.088388347648318440f;
constexpr float THR = 8.f;
#ifndef ATT_SDEPTH
#define ATT_SDEPTH 1
#endif
constexpr int SDEPTH = ATT_SDEPTH;
constexpr int LDQ = 1024, LDK = 256, LDO = 2048;
constexpr size_t SHM_V = KVBLK * D * 2, SHM_K = KVBLK * D * 2, SHM_ATTN = 2 * SHM_V + 2 * SHM_K + NW * 64 * 4;
using s16x4  = __attribute__((ext_vector_type(4))) short;
using f32x16 = __attribute__((ext_vector_type(16))) float;
#define KSWZ(row, colB) ((row) * 256 + ((colB) ^ (((row) & 7) << 4)))
#define SBAR() __builtin_amdgcn_sched_barrier(0)
__device__ __forceinline__ int crow(int r, int hi) { return (r & 3) + 8 * (r >> 2) + 4 * hi; }
__device__ __forceinline__ unsigned cvtpk(float lo, float hi) { unsigned r; asm volatile("v_cvt_pk_bf16_f32 %0, %1, %2" : "=v"(r) : "v"(lo), "v"(hi)); return r; }

__device__ __forceinline__ void partialSM(f32x16& p0, f32x16& p1, float& m_reg, float& mn, float& alpha) {
  constexpr float C = SCALE * 1.4426950408889634f;
  float pmax = p0[0]; for (int r = 1; r < 16; ++r) pmax = fmaxf(pmax, p0[r]); for (int r = 0; r < 16; ++r) pmax = fmaxf(pmax, p1[r]);
  { auto rr = __builtin_amdgcn_permlane32_swap(__float_as_uint(pmax), __float_as_uint(pmax), false, false);
    pmax = fmaxf(__uint_as_float(rr[0]), __uint_as_float(rr[1])); }
  if (__builtin_expect(__all(pmax - m_reg <= THR / SCALE), 1)) { mn = m_reg; alpha = 1.f; }
  else { mn = fmaxf(m_reg, pmax); alpha = __builtin_amdgcn_exp2f((m_reg - mn) * C); m_reg = mn; }
  float mnC = -mn * C;
  for (int r = 0; r < 16; ++r) p0[r] = fmaf(p0[r], C, mnC); for (int r = 0; r < 16; ++r) p1[r] = fmaf(p1[r], C, mnC);
  for (int r = 0; r < 16; ++r) p0[r] = __builtin_amdgcn_exp2f(p0[r]);
}
__device__ __forceinline__ void finishSM(f32x16& p0, f32x16& p1, float alpha, float& l_reg, bf16x8& pa0, bf16x8& pa1, bf16x8& pa2, bf16x8& pa3) {
  for (int r = 0; r < 16; ++r) p1[r] = __builtin_amdgcn_exp2f(p1[r]);
  float ps = 0; for (int r = 0; r < 16; ++r) ps += p0[r]; for (int r = 0; r < 16; ++r) ps += p1[r];
  { auto rr = __builtin_amdgcn_permlane32_swap(__float_as_uint(ps), __float_as_uint(ps), false, false);
    ps = __uint_as_float(rr[0]) + __uint_as_float(rr[1]); }
  l_reg = l_reg * alpha + ps;
#define PK4(P, BASE, OUT) do { unsigned a0 = cvtpk(P[BASE + 0], P[BASE + 1]), a1 = cvtpk(P[BASE + 2], P[BASE + 3]);   \
    unsigned b0 = cvtpk(P[BASE + 4], P[BASE + 5]), b1 = cvtpk(P[BASE + 6], P[BASE + 7]);                              \
    auto r0 = __builtin_amdgcn_permlane32_swap(a0, b0, false, false); auto r1 = __builtin_amdgcn_permlane32_swap(a1, b1, false, false); \
    v4u w = {r0[0], r1[0], r0[1], r1[1]}; OUT = *reinterpret_cast<bf16x8*>(&w); } while (0)
  PK4(p0, 0, pa0); PK4(p0, 8, pa1); PK4(p1, 0, pa2); PK4(p1, 8, pa3);
#undef PK4
}
__device__ __forceinline__ void qkt(f32x16& p0, f32x16& p1, const bf16* Ks, const bf16x8* qr, int r32, int hi) {
  p0 = f32x16{}; p1 = f32x16{};
  for (int d0 = 0; d0 < 8; ++d0) { int cb = (d0 * 16 + hi * 8) * 2;
    bf16x8 b0 = *reinterpret_cast<const bf16x8*>((const char*)Ks + KSWZ(r32, cb));
    bf16x8 b1 = *reinterpret_cast<const bf16x8*>((const char*)Ks + KSWZ(32 + r32, cb));
    p0 = __builtin_amdgcn_mfma_f32_32x32x16_bf16(b0, qr[d0], p0, 0, 0, 0);
    p1 = __builtin_amdgcn_mfma_f32_32x32x16_bf16(b1, qr[d0], p1, 0, 0, 0); }
}
__device__ __forceinline__ int v_st(int k, int c) { const int kk = (k & ~0xC) | ((k & 4) << 1) | ((k & 8) >> 1); return ((kk >> 3) * 4 + (c >> 5)) * 512 + ((kk & 7) * 32 + (c & 31)) * 2; }
__device__ __forceinline__ int v_rd_base(int lane) { return ((lane & 3) << 3) | (((lane >> 2) & 3) << 6) | (((lane >> 4) & 1) << 5) | (((lane >> 5) & 1) << 8); }
constexpr int v_rd_off(int d0, int ks, int half) { return d0 * 512 + ks * 4096 + half * 2048; }
template <int OFF> __device__ __forceinline__ s16x4 tr_read(int vb) {
  s16x4 r; asm volatile("ds_read_b64_tr_b16 %0, %1 offset:%2" : "=&v"(r) : "v"(vb), "i"(OFF) : "memory"); return r;
}
template <int D0> __device__ __forceinline__ void pv_one(f32x16& od, int vb, bf16x8 pa0, bf16x8 pa1, bf16x8 pa2, bf16x8 pa3) {
  const s16x4 l0 = tr_read<v_rd_off(D0, 0, 0)>(vb), h0 = tr_read<v_rd_off(D0, 0, 1)>(vb), l1 = tr_read<v_rd_off(D0, 1, 0)>(vb), h1 = tr_read<v_rd_off(D0, 1, 1)>(vb);
  const s16x4 l2 = tr_read<v_rd_off(D0, 2, 0)>(vb), h2 = tr_read<v_rd_off(D0, 2, 1)>(vb), l3 = tr_read<v_rd_off(D0, 3, 0)>(vb), h3 = tr_read<v_rd_off(D0, 3, 1)>(vb);
  asm volatile("s_waitcnt lgkmcnt(0)" ::: "memory"); SBAR();
#define PK(L, H) (bf16x8){L[0], L[1], L[2], L[3], H[0], H[1], H[2], H[3]}
  od = __builtin_amdgcn_mfma_f32_32x32x16_bf16(pa0, PK(l0, h0), od, 0, 0, 0);
  od = __builtin_amdgcn_mfma_f32_32x32x16_bf16(pa1, PK(l1, h1), od, 0, 0, 0);
  od = __builtin_amdgcn_mfma_f32_32x32x16_bf16(pa2, PK(l2, h2), od, 0, 0, 0);
  od = __builtin_amdgcn_mfma_f32_32x32x16_bf16(pa3, PK(l3, h3), od, 0, 0, 0);
#undef PK
}
__device__ __forceinline__ void pv_d0(f32x16* o, int vb, bf16x8 pa0, bf16x8 pa1, bf16x8 pa2, bf16x8 pa3) {
  pv_one<0>(o[0], vb, pa0, pa1, pa2, pa3); pv_one<1>(o[1], vb, pa0, pa1, pa2, pa3); pv_one<2>(o[2], vb, pa0, pa1, pa2, pa3); pv_one<3>(o[3], vb, pa0, pa1, pa2, pa3);
}
struct KVSrc { const bf16* Kl; const bf16* Vl; const bf16* Kc; const bf16* Vc; int nloc, kstart, nrows; };

__device__ __forceinline__ void attn_body(const bf16* __restrict__ Qb, const KVSrc src, bf16* __restrict__ Ob, int NT, float sink_raw, int qpos0, char* lds) {
  int tid_ = threadIdx.x; asm volatile("" : "+v"(tid_)); const int tid = tid_, wid = __builtin_amdgcn_readfirstlane(tid >> 6), lane = tid & 63, r32 = lane & 31, hi = lane >> 5;
  bf16* V_lds = (bf16*)lds; bf16* K_lds = (bf16*)(lds + 2 * SHM_V);
  float* ws = (float*)(lds + 2 * SHM_V + 2 * SHM_K) + wid * 64; float* li_l = ws; float* al_l = ws + 32;
  float m_reg = sink_raw, l_reg = 1.f; f32x16 o[4] = {}; bf16x8 qr[8];
  const bf16* Qw = Qb + (long)(wid * QBLK + r32) * LDQ + hi * 8;
#pragma unroll
  for (int d0 = 0; d0 < 8; ++d0) qr[d0] = *reinterpret_cast<const bf16x8*>(Qw + d0 * 16);
  const int sr = tid >> 4, sc = (tid & 15) * 8, vst0 = v_st(sr, sc), vst1 = v_st(32 + sr, sc);
  const int vb0 = (int)(uintptr_t)V_lds + v_rd_base(lane);
  const int qpos = qpos0 + wid * QBLK + r32;
  struct { bf16x8 vs0, vs1, ks0, ks1; } sr_[SDEPTH];
#define SLOAD(i, t) do { const bf16 *kp_, *vp_; int r0_, r1_; const int t_ = (t);                                                      \
    if (t_ < src.nloc) { const int k0_ = src.kstart + t_ * KVBLK; r0_ = k0_ + sr; r1_ = k0_ + 32 + sr;                                   \
      r0_ = r0_ < 0 ? 0 : (r0_ >= src.nrows ? src.nrows - 1 : r0_); r1_ = r1_ < 0 ? 0 : (r1_ >= src.nrows ? src.nrows - 1 : r1_); kp_ = src.Kl; vp_ = src.Vl; } \
    else { const int k0_ = (t_ - src.nloc) * KVBLK; r0_ = k0_ + sr; r1_ = k0_ + 32 + sr; kp_ = src.Kc; vp_ = src.Vc; }                  \
    sr_[i].vs0 = *reinterpret_cast<const bf16x8*>(vp_ + (long)r0_ * LDK + sc); sr_[i].vs1 = *reinterpret_cast<const bf16x8*>(vp_ + (long)r1_ * LDK + sc); \
    sr_[i].ks0 = *reinterpret_cast<const bf16x8*>(kp_ + (long)r0_ * LDK + sc); sr_[i].ks1 = *reinterpret_cast<const bf16x8*>(kp_ + (long)r1_ * LDK + sc); } while (0)
#define SWRITE(b, i) do { *(bf16x8*)((char*)V_lds + (b) * SHM_V + vst0) = sr_[i].vs0;          \
    *(bf16x8*)((char*)V_lds + (b) * SHM_V + vst1) = sr_[i].vs1; int kc = sc * 2;               \
    *(bf16x8*)((char*)K_lds + (b) * SHM_K + KSWZ(sr, kc)) = sr_[i].ks0;                       \
    *(bf16x8*)((char*)K_lds + (b) * SHM_K + KSWZ(32 + sr, kc)) = sr_[i].ks1; } while (0)
#define SWAIT() do { if constexpr (SDEPTH == 2) asm volatile("s_waitcnt vmcnt(4)" ::: "memory"); else asm volatile("s_waitcnt vmcnt(0)" ::: "memory"); } while (0)
#define RESC(a) do { if (__any((a) < 1.f)) { if (hi == 0) al_l[r32] = (a); asm volatile("s_waitcnt lgkmcnt(0)" ::: "memory"); \
    for (int d = 0; d < 4; ++d) for (int r = 0; r < 16; ++r) o[d][r] *= al_l[crow(r, hi)]; } } while (0)
#define MASK(P0, P1, t) do { const int t_ = (t); if (t_ < src.nloc) { const int kb_ = src.kstart + t_ * KVBLK;                           \
    _Pragma("unroll") for (int r = 0; r < 16; ++r) { const int k0_ = kb_ + crow(r, hi), k1_ = k0_ + 32;                                  \
      const int d0_ = qpos - k0_, d1_ = qpos - k1_;                                                                                     \
      const bool v0_ = (k0_ >= 0) && (k0_ < src.nrows) && (d0_ <= 128) && (d0_ >= -128);                                                 \
      const bool v1_ = (k1_ >= 0) && (k1_ < src.nrows) && (d1_ <= 128) && (d1_ >= -128);                                                 \
      P0[r] = v0_ ? P0[r] : -1e30f; P1[r] = v1_ ? P1[r] : -1e30f; } } } while (0)
  f32x16 pA0, pA1, pB0, pB1; float mnA, mnB, alA = 1.f, alB = 1.f; bf16x8 pa0, pa1, pa2, pa3;
  const int qw_lo = qpos0 + wid * QBLK - 128, qw_hi = qpos0 + wid * QBLK + QBLK - 1 + 128;
#define ACT(t) ((t) >= src.nloc || !(src.kstart + (t) * KVBLK + KVBLK - 1 < qw_lo || src.kstart + (t) * KVBLK > qw_hi || src.kstart + (t) * KVBLK + KVBLK - 1 < 0 || src.kstart + (t) * KVBLK >= src.nrows))
  constexpr int SE = 0, SO = SDEPTH - 1;
  SLOAD(SE, 0); asm volatile("s_waitcnt vmcnt(0)" ::: "memory"); SWRITE(0, SE); LDS_BARRIER();
  bool actA = ACT(0), actB = false;
  if (actA) { qkt(pA0, pA1, K_lds, qr, r32, hi); MASK(pA0, pA1, 0); partialSM(pA0, pA1, m_reg, mnA, alA); }
  SLOAD(SO, 1); if constexpr (SDEPTH == 2) { if (2 < NT) SLOAD(SE, 2); }
  SWAIT(); SWRITE(1, SO); LDS_BARRIER();
  for (int j = 1; j + 1 < NT; j += 2) {
    actB = ACT(j);
    SBAR(); if (actB) qkt(pB0, pB1, (bf16*)((char*)K_lds + SHM_K), qr, r32, hi);
    if (actA) finishSM(pA0, pA1, alA, l_reg, pa0, pa1, pa2, pa3); SBAR();
    SLOAD(SO, j + SDEPTH); SBAR();
    if (actA) pv_d0(o, vb0, pa0, pa1, pa2, pa3); alB = 1.f; if (actB) { MASK(pB0, pB1, j); partialSM(pB0, pB1, m_reg, mnB, alB); }
    LDS_BARRIER(); SWAIT(); SWRITE(0, SE);
    RESC(alB); LDS_BARRIER();
    actA = ACT(j + 1);
    SBAR(); if (actA) qkt(pA0, pA1, K_lds, qr, r32, hi);
    if (actB) finishSM(pB0, pB1, alB, l_reg, pa0, pa1, pa2, pa3); SBAR();
    if (SDEPTH == 1 || j + 3 < NT) SLOAD(SE, j + 1 + SDEPTH); SBAR();
    if (actB) pv_d0(o, vb0 + (int)SHM_V, pa0, pa1, pa2, pa3); alA = 1.f; if (actA) { MASK(pA0, pA1, j + 1); partialSM(pA0, pA1, m_reg, mnA, alA); }
    LDS_BARRIER(); SWAIT(); SWRITE(1, SO);
    RESC(alA); LDS_BARRIER();
  }
  actB = ACT(NT - 1);
  SBAR(); if (actB) qkt(pB0, pB1, (bf16*)((char*)K_lds + SHM_K), qr, r32, hi);
  if (actA) finishSM(pA0, pA1, alA, l_reg, pa0, pa1, pa2, pa3); SBAR();
  if (actA) pv_d0(o, vb0, pa0, pa1, pa2, pa3); alB = 1.f; if (actB) { MASK(pB0, pB1, NT - 1); partialSM(pB0, pB1, m_reg, mnB, alB); }
  LDS_BARRIER(); RESC(alB);
  if (actB) { finishSM(pB0, pB1, alB, l_reg, pa0, pa1, pa2, pa3); SBAR();
  pv_d0(o, vb0 + (int)SHM_V, pa0, pa1, pa2, pa3); }
#undef ACT
  if (hi == 0) li_l[r32] = l_reg; asm volatile("s_waitcnt lgkmcnt(0)" ::: "memory");
  float rli[16];
#pragma unroll
  for (int r = 0; r < 16; ++r) rli[r] = __builtin_amdgcn_rcpf(li_l[crow(r, hi)]);
  bf16* Ow = Ob + (long)(wid * QBLK) * LDO;
#pragma unroll
  for (int r = 0; r < 16; ++r) { int orow = crow(r, hi);
    for (int d0 = 0; d0 < 4; ++d0) Ow[(long)orow * LDO + d0 * 32 + r32] = f2bf(o[d0][r] * rli[r]); }
  LDS_BARRIER();
#undef SLOAD
#undef SWRITE
#undef SWAIT
#undef RESC
#undef MASK
}
}


struct Args { const float* in[23]; float* out; unsigned char* ws; int ph_lo, ph_hi; };
enum { I_XP = 0, I_XS, I_CK, I_CV, I_ST, I_C, I_CCTX, I_WADA, I_BADA, I_NG, I_WFI, I_WFO, I_WIN, I_WOUT, I_QG, I_KG, I_SINK, I_LB, I_RG, I_CW, I_CB, I_CLG, I_CLB };

__device__ __forceinline__ void transpose_item(const float* W, int K, int N, bf16* WT, LAS float* scr, int item, int lane, int mode, unsigned char* W8 = nullptr, float sc8 = 1.f) {
    const int nblk = N / 32, kb = item / nblk, nb = item % nblk, k0 = 64 * kb, n0 = 32 * nb;
    int dn0 = n0;
    if (mode == 1) { const int hh = n0 >= DFF ? 1 : 0, m = n0 - hh * DFF; dn0 = 256 * (m >> 7) + 128 * hh + (m & 127); }
    if (mode == 2 && n0 >= ZCA) { const int hh = n0 >= ZCB ? 1 : 0, m = n0 - ZCA - hh * 512; dn0 = ZCA + 256 * (m >> 7) + 128 * hh + (m & 127); }
#pragma unroll 8
    for (int i = 0; i < 32; ++i) { const int kk = 2 * i + (lane >> 5); scr[kk * 33 + (lane & 31)] = __builtin_nontemporal_load(W + (size_t)(k0 + kk) * N + n0 + (lane & 31)); }
    LDS_WAIT(); asm volatile("" ::: "memory");
    const int c = lane & 7;
#pragma unroll
    for (int j = 0; j < 4; ++j) { const int n = (lane >> 3) + 8 * j; const LAS float* s = scr + (8 * c) * 33 + n;
        float t[8];
#pragma unroll
        for (int q = 0; q < 8; ++q) { t[q] = s[q * 33]; if (EMU_FP8 >= 1 && mode == 1) t[q] = q8s(t[q], 32.f, 1.f / 32.f); if (EMU_FP8 >= 2 && mode == 3) t[q] = q8s(t[q], 64.f, 1.f / 64.f); }
        v4u o; o.x = pk2(t[0], t[1]); o.y = pk2(t[2], t[3]); o.z = pk2(t[4], t[5]); o.w = pk2(t[6], t[7]);
        if (!W8) *(v4u*)(WT + (size_t)(dn0 + n) * K + k0 + 8 * c) = o;
        if (W8) { v2u o8; if (FFI_INT8 && mode == 1) { o8.x = pki8(t[0] * I8_WSC, t[1] * I8_WSC, t[2] * I8_WSC, t[3] * I8_WSC); o8.y = pki8(t[4] * I8_WSC, t[5] * I8_WSC, t[6] * I8_WSC, t[7] * I8_WSC); }
            else { o8.x = pk8(t[0] * sc8, t[1] * sc8, t[2] * sc8, t[3] * sc8); o8.y = pk8(t[4] * sc8, t[5] * sc8, t[6] * sc8, t[7] * sc8); } *(v2u*)(W8 + (size_t)(dn0 + n) * K + k0 + 8 * c) = o8; } }
    LDS_WAIT(); asm volatile("" ::: "memory");
}

__device__ __forceinline__ void phase_p0(const Args& a, LAS unsigned char* lds, int vcu, int G) {
    int tid_ = threadIdx.x; asm volatile("" : "+v"(tid_)); const int tid = tid_, lane = tid & 63, wave = tid >> 6;
    unsigned char* ws = a.ws;
    {
        LAS float* scr = (LAS float*)(lds + wave * 16384);
        const int gw = vcu * 8 + wave, NGW = G * 8;
        constexpr int I_FI = 32 * 352, I_FO = 88 * 64, I_IN = 32 * 160, I_OUT = 32 * 64, I_LAYER = 2 * I_FI + 2 * I_FO + I_IN + I_OUT;
        for (int rp = 0; rp < REP(8); ++rp)
        for (int it0 = gw; it0 < 2 * I_LAYER; it0 += NGW) {
            const int it = 2 * I_LAYER - 1 - it0;
            const int l = it / I_LAYER; int r = it % I_LAYER;
            if (r < 2 * I_FI) { const int s = r / I_FI; r -= s * I_FI;
                transpose_item(a.in[I_WFI] + (size_t)(l * 2 + s) * DM * NFF2, DM, NFF2, (bf16*)(ws + WS_WFI) + (size_t)(l * 2 + s) * NFF2 * DM, scr, r, lane, 1, f8on(l * 2 + s) ? ws + WS_W8 + (size_t)(l * 2 + s) * W8_STRIDE : nullptr, W8I_SC); continue; }
            r -= 2 * I_FI;
            if (r < 2 * I_FO) { const int s = r / I_FO; r -= s * I_FO;
                transpose_item(a.in[I_WFO] + (size_t)(l * 2 + s) * DFF * DM, DFF, DM, (bf16*)(ws + WS_WFO) + (size_t)(l * 2 + s) * DM * DFF, scr, r, lane, 3, f8out(l * 2 + s) ? ws + WS_W8 + (size_t)(l * 2 + s) * W8_STRIDE + W8O_OFF : nullptr, W8O_SC); continue; }
            r -= 2 * I_FO;
            if (r < I_IN) { transpose_item(a.in[I_WIN] + (size_t)l * DM * INC, DM, INC, (bf16*)(ws + WS_WIN) + (size_t)l * INC * DM, scr, r, lane, 2); continue; }
            r -= I_IN;
            transpose_item(a.in[I_WOUT] + (size_t)l * DM * DM, DM, DM, (bf16*)(ws + WS_WOUT) + (size_t)l * DM * DM, scr, r, lane, 0);
        }
    }
    __syncthreads();
    {
        LAS float* scs = (LAS float*)lds;
        for (int i = tid; i < 3 * DM; i += 512) { const int cond = i / DM, k = i % DM; const float v = cond == 0 ? a.in[I_CCTX][k] : a.in[I_C][(cond - 1) * DM + k]; scs[i] = siluf(v); }
        __syncthreads();
        unsigned long long* modi = (unsigned long long*)(ws + WS_MODI);
        const int NIT = 18 * 128, it0 = (int)(((long)vcu * NIT) / G), it1 = (int)(((long)(vcu + 1) * NIT) / G);
        int cur = -1; float acc[3][4];
#pragma unroll
        for (int c = 0; c < 3; ++c)
#pragma unroll
            for (int j = 0; j < 4; ++j) acc[c][j] = 0.f;
        for (int it = it0; it <= it1; ++it) {
            const int lc = it < it1 ? it / 128 : -2;
            if (lc != cur) {
                if (cur >= 0) { const int l = cur / 9, cr = cur % 9;
#pragma unroll
                    for (int c = 0; c < 3; ++c)
#pragma unroll
                        for (int j = 0; j < 4; ++j) { atomicAdd(modi + (size_t)(c * 2 + l) * MODW + cr * 2048 + 4 * tid + j, (unsigned long long)__float2ll_rn(acc[c][j] * FXM)); acc[c][j] = 0.f; } }
                cur = lc;
            }
            if (it == it1) break;
            const int l = lc / 9, cr = lc % 9, ks = it % 128;
            const float* Wp = a.in[I_WADA] + ((size_t)l * DM + ks * 16) * MODW + cr * 2048 + 4 * tid;
#pragma unroll
            for (int kk = 0; kk < 16; ++kk) { const f32x4 w = __builtin_nontemporal_load((const f32x4*)(Wp + (size_t)kk * MODW)); const int k = ks * 16 + kk;
                const float s0 = scs[k], s1 = scs[DM + k], s2 = scs[2 * DM + k];
#pragma unroll
                for (int j = 0; j < 4; ++j) { acc[0][j] += s0 * w[j]; acc[1][j] += s1 * w[j]; acc[2][j] += s2 * w[j]; } }
        }
    }
    {
        const int gt = vcu * 512 + tid, NGT = G * 512;
        for (int i = gt; i < 2 * 65536; i += NGT) { const int which = i >> 16, g8 = i & 65535;
            const int dg = g8 & 15, pos = (g8 >> 4) & 511, kvh = (g8 >> 13) & 1, bl = g8 >> 14;
            const float* src = a.in[which ? I_CV : I_CK] + (size_t)g8 * 8;
            const f32x4 x0 = *(const f32x4*)src, x1 = *(const f32x4*)(src + 4);
            v4u o; o.x = pk2(x0[0], x0[1]); o.y = pk2(x0[2], x0[3]); o.z = pk2(x1[0], x1[1]); o.w = pk2(x1[2], x1[3]);
            *(v4u*)((bf16*)(ws + (which ? WS_CV : WS_CK)) + ((size_t)bl * 512 + pos) * 256 + kvh * 128 + dg * 8) = o; }
        if (gt < 2048) { const int l = gt >> 10, j = gt & 1023; float v = 0.f; if (l) { const float a0 = a.in[I_LB][j], a1 = a.in[I_LB][1024 + j]; v = 1.f / (1.f + expf(a0 - a1)); } ((float*)(ws + WS_LBV))[gt] = v; }
    }
}

__device__ __forceinline__ void phase_p1(const Args& a, LAS unsigned char* lds, int vcu, int G) {
    int tid_ = threadIdx.x; asm volatile("" : "+v"(tid_)); const int tid = tid_, lane = tid & 63, wave = tid >> 6;
    unsigned char* ws = a.ws;
    const long long* modi = (const long long*)(ws + WS_MODI);
#define MODV(idx) ((float)modi[(idx)] * IFXM)
    const int gt = vcu * 512 + tid, NGT = G * 512, gw = vcu * 8 + wave, NGW = G * 8;
    for (int i = gt; i < 6 * MODW; i += NGT) ((float*)(ws + WS_MOD))[i] = MODV(i);
    for (int i = gt; i < 6 * 3 * DM; i += NGT) { const int k = i % DM, c = (i / DM) % 3, slot = i / (3 * DM), l = slot / 3, sidx = slot % 3;
        const float sc = MODV((size_t)(c * 2 + l) * MODW + (3 * sidx + 1) * DM + k) + a.in[I_BADA][(size_t)l * MODW + (3 * sidx + 1) * DM + k];
        ((float*)(ws + WS_GV))[i] = a.in[I_NG][(size_t)slot * DM + k] * (1.f + sc); }
    LAS float* SH = (LAS float*)lds;
    for (int slot = 0; slot < 6; ++slot) {
        const int l = slot / 3, sidx = slot % 3;
        for (int i = tid; i < 3 * DM; i += 512) { const int c = i / DM, k = i % DM;
            SH[i] = MODV((size_t)(c * 2 + l) * MODW + (3 * sidx) * DM + k) + a.in[I_BADA][(size_t)l * MODW + (3 * sidx) * DM + k]; }
        __syncthreads();
        const int N = sidx == 1 ? INC : NFF2;
        const bf16* Wt = sidx == 1 ? (const bf16*)(ws + WS_WIN) + (size_t)l * INC * DM : (const bf16*)(ws + WS_WFI) + (size_t)(l * 2 + (sidx >> 1)) * NFF2 * DM;
        float* bo = (float*)(ws + WS_BIAS) + (size_t)slot * 3 * NFF2;
        const bool w8 = sidx != 1 && f8on(2 * l + (sidx >> 1));
        if (w8 && gw < N) {
            const unsigned char* W8p = ws + WS_W8 + (size_t)(2 * l + (sidx >> 1)) * W8_STRIDE;
            const int nl = gw + ((N - 1 - gw) / NGW) * NGW;
            for (int n0 = gw; n0 <= nl; n0 += 3 * NGW) {
                int nr[3]; v4u w[3][2];
#pragma unroll
                for (int r = 0; r < 3; ++r) { const int n = n0 + r * NGW; nr[r] = n < nl ? n : nl;
#pragma unroll
                    for (int j = 0; j < 2; ++j) w[r][j] = *(const v4u*)(W8p + (size_t)nr[r] * DM + 32 * lane + 16 * j); }
                float d[3][3];
#pragma unroll
                for (int r = 0; r < 3; ++r) { d[r][0] = 0.f; d[r][1] = 0.f; d[r][2] = 0.f; }
#pragma unroll
                for (int j = 0; j < 2; ++j)
#pragma unroll
                    for (int q = 0; q < 4; ++q) {
#define P1_F8B(B) { const int k = 32 * lane + 16 * j + 4 * q + B; const float s0 = SH[k], s1 = SH[DM + k], s2 = SH[2 * DM + k]; \
                        _Pragma("unroll") for (int r = 0; r < 3; ++r) { const float wf = FFI_INT8 ? i8f(w[r][j][q], B) : __builtin_amdgcn_cvt_f32_fp8((int)w[r][j][q], B); d[r][0] += wf * s0; d[r][1] += wf * s1; d[r][2] += wf * s2; } }
                        P1_F8B(0) P1_F8B(1) P1_F8B(2) P1_F8B(3)
#undef P1_F8B
                    }
#pragma unroll
                for (int r = 0; r < 3; ++r) { constexpr float WSI = FFI_INT8 ? 1.f / I8_WSC : 1.f / W8I_SC; const float e0 = wave_sum(d[r][0]) * WSI, e1 = wave_sum(d[r][1]) * WSI, e2 = wave_sum(d[r][2]) * WSI;
                    if (lane == 0) { bo[nr[r]] = e0; bo[NFF2 + nr[r]] = e1; bo[2 * NFF2 + nr[r]] = e2; } }
            }
        }
        if (!w8 && gw < N) {
            const int nl = gw + ((N - 1 - gw) / NGW) * NGW;
            for (int n0 = gw; n0 <= nl; n0 += 3 * NGW) {
                int nr[3]; v4u w[3][4];
#pragma unroll
                for (int r = 0; r < 3; ++r) { const int n = n0 + r * NGW; nr[r] = n < nl ? n : nl;
#pragma unroll
                    for (int j = 0; j < 4; ++j) w[r][j] = *(const v4u*)(Wt + (size_t)nr[r] * DM + 8 * lane + 512 * j); }
                float d[3][3];
#pragma unroll
                for (int r = 0; r < 3; ++r) { d[r][0] = 0.f; d[r][1] = 0.f; d[r][2] = 0.f; }
#pragma unroll
                for (int j = 0; j < 4; ++j) { const int k = 8 * lane + 512 * j;
#pragma unroll
                    for (int q = 0; q < 8; ++q) { const float s0 = SH[k + q], s1 = SH[DM + k + q], s2 = SH[2 * DM + k + q];
#pragma unroll
                        for (int r = 0; r < 3; ++r) { const unsigned u = w[r][j][q >> 1]; const float wf = (q & 1) ? __uint_as_float(u & 0xffff0000u) : __uint_as_float(u << 16);
                            d[r][0] += wf * s0; d[r][1] += wf * s1; d[r][2] += wf * s2; } } }
#pragma unroll
                for (int r = 0; r < 3; ++r) { const float e0 = wave_sum(d[r][0]), e1 = wave_sum(d[r][1]), e2 = wave_sum(d[r][2]);
                    if (lane == 0) { bo[nr[r]] = e0; bo[NFF2 + nr[r]] = e1; bo[2 * NFF2 + nr[r]] = e2; } }
            }
        }
        __syncthreads();
    }
    {
        LAS float* G0 = (LAS float*)lds;
        for (int i = tid; i < 3 * DM; i += 512) { const int c = i / DM, k = i % DM; G0[i] = a.in[I_NG][k] * (1.f + MODV((size_t)(c * 2) * MODW + DM + k) + a.in[I_BADA][DM + k]); }
        __syncthreads();
        float* X = a.out; bf16* H = (bf16*)(ws + WS_H); unsigned long long* ssq0 = (unsigned long long*)(ws + WS_SSQ);
        if (gw < NTOK) {
            const int rl = gw + ((NTOK - 1 - gw) / NGW) * NGW;
            f32x4 nv[8];
#define P1_LOAD(rw) do { const int rw_ = (rw); const float* xin_ = rw_ < NCTX ? a.in[I_XP] + (size_t)rw_ * DM : a.in[I_XS] + (size_t)(rw_ - NCTX) * DM; \
                _Pragma("unroll") for (int j = 0; j < 8; ++j) nv[j] = ((const f32x4*)xin_ + lane)[64 * j]; } while (0)
            P1_LOAD(gw);
            for (int row = gw; row <= rl; row += NGW) {
                const int cond = row < NCTX ? 0 : 1 + ((row - NCTX) >> 12);
                f32x4 v[8]; float ss = 0.f;
#pragma unroll
                for (int j = 0; j < 8; ++j) { v[j] = nv[j]; ss += (v[j].x * v[j].x + v[j].y * v[j].y) + (v[j].z * v[j].z + v[j].w * v[j].w); }
                P1_LOAD(row + NGW < rl ? row + NGW : rl);
                ss = wave_sum(ss);
                v2u* o8 = (v2u*)(H + (size_t)row * DM) + lane;
                float am = 0.f;
#pragma unroll
                for (int j = 0; j < 8; ++j) { const int col = 4 * lane + 256 * j;
                    const f32x4 g = *(const LAS f32x4*)(G0 + cond * DM + col);
                    v[j] = v[j] * g; am = fmaxf(fmaxf(am, fmaxf(fabsf(v[j].x), fabsf(v[j].y))), fmaxf(fabsf(v[j].z), fabsf(v[j].w))); }
                am = fmaxf(wave_max(am), 1e-20f); const float qs0 = 127.f / am;
#pragma unroll
                for (int j = 0; j < 8; ++j) { const f32x4 h = v[j];
                    if (f8on(0)) ((unsigned*)((unsigned char*)H + (size_t)row * DM) + lane)[64 * j] = pki8(h.x * qs0, h.y * qs0, h.z * qs0, h.w * qs0);
                    else { v2u w; w.x = pk2(h.x, h.y); w.y = pk2(h.z, h.w); o8[64 * j] = w; } }
                if (lane == 0) { ssq0[row] = __float2ull_rn(ss * FXS); ((float*)(ws + WS_RS0))[row] = am * (1.f / 127.f); }
            }
#undef P1_LOAD
        }
    }
}

__device__ __forceinline__ void phase_prep(const Args& a, int l, int vcu, int G) {
    int tid_ = threadIdx.x; asm volatile("" : "+v"(tid_)); const int tid = tid_, lane = tid & 63, wave = tid >> 6;
    const bf16* Zb = (const bf16*)(a.ws + WS_Z);
    bf16* Qb = (bf16*)(a.ws + WS_Q); bf16* Kb = (bf16*)(a.ws + WS_K); bf16* Vb = (bf16*)(a.ws + WS_V);
    const int hf = lane >> 5, j = lane & 31, e1 = 64 * hf + j, e2 = e1 + 32;
    const float invf = exp2f(-(float)j * (13.287712379549449f / 32.f));
    const float qg1 = a.in[I_QG][l * 128 + e1], qg2 = a.in[I_QG][l * 128 + e2], kg1 = a.in[I_KG][l * 128 + e1], kg2 = a.in[I_KG][l * 128 + e2];
    unsigned nx1[10], nx2[10]; v2u nvv;
#define PREP_LOAD(r) do { const bf16* z_ = Zb + (size_t)(r) * ZBC; \
        _Pragma("unroll") for (int hd = 0; hd < 10; ++hd) { const int base = hd < 8 ? ZQ + hd * 128 : ZK + (hd - 8) * 128; nx1[hd] = z_[base + e1]; nx2[hd] = z_[base + e2]; } \
        nvv = *(const v2u*)(z_ + ZV + 4 * lane); } while (0)
    const int rstart = vcu * 8 + wave, rstep = G * 8;
    if (rstart < NTOK) PREP_LOAD(rstart);
    for (int row = rstart; row < NTOK; row += rstep) {
        const bool lat = row >= NCTX;
        float cx1[10], cx2[10];
#pragma unroll
        for (int hd = 0; hd < 10; ++hd) { cx1[hd] = bf2f(nx1[hd]); cx2[hd] = bf2f(nx2[hd]); }
        const v2u vr = nvv; const f32x4 v = {__uint_as_float(vr.x << 16), __uint_as_float(vr.x & 0xffff0000u), __uint_as_float(vr.y << 16), __uint_as_float(vr.y & 0xffff0000u)};
        if (row + rstep < NTOK) PREP_LOAD(row + rstep);
        float cs = 1.f, sn = 0.f;
        if (lat) { const int p = (row - NCTX) & 4095; const int pos = hf ? (p & 63) : (p >> 6); const float ang = (float)pos * invf; cs = cosf(ang); sn = sinf(ang); }
#pragma unroll
        for (int hd = 0; hd < 10; ++hd) {
            const float x1 = cx1[hd], x2 = cx2[hd];
            const float rstd = 1.0f / sqrtf(wave_sum(x1 * x1 + x2 * x2) * (1.f / 128.f) + EPS);
            float y1 = x1 * rstd * (hd < 8 ? qg1 : kg1), y2 = x2 * rstd * (hd < 8 ? qg2 : kg2);
            if (!lat && hd >= 8) { const int b = row >> 8, pos = row & 255; float* ck = a.out + OUT_CK + ((((size_t)b * 2 + l) * 2 + (hd - 8)) * 256 + pos) * 128; ck[e1] = y1; ck[e2] = y2; }
            if (lat) { const float r1 = y1 * cs - y2 * sn, r2 = y1 * sn + y2 * cs; y1 = r1; y2 = r2; }
            if (hd < 8) { bf16* q = Qb + (size_t)row * 1024 + hd * 128; q[e1] = f2bf(y1); q[e2] = f2bf(y2); }
            else { bf16* k = Kb + (size_t)row * 256 + (hd - 8) * 128; k[e1] = f2bf(y1); k[e2] = f2bf(y2); }
        }
        *((v2u*)(Vb + (size_t)row * 256) + lane) = vr;
        if (!lat) { const int b = row >> 8, pos = row & 255, kvh = lane >> 5; *(f32x4*)(a.out + OUT_CV + ((((size_t)b * 2 + l) * 2 + kvh) * 256 + pos) * 128 + ((4 * lane) & 127)) = v; }
    }
}

__device__ __forceinline__ void phase_hgrn_a(const Args& a, LAS unsigned char* lds, int l, int vcu, int G) {
    int tid_ = threadIdx.x; asm volatile("" : "+v"(tid_)); const int tid = tid_, lane = tid & 63, wave = tid >> 6, fr = lane & 15, fq = lane >> 4;
    const bf16* Zb = (const bf16*)(a.ws + WS_Z); const float* LF = (const float*)(a.ws + WS_LF);
    bf16* KP = (bf16*)(a.ws + WS_KP); bf16* VP = (bf16*)(a.ws + WS_VP); float* DEC = (float*)(a.ws + WS_DEC);
    LAS unsigned char* KT = lds;
    LAS unsigned char* VT = lds + 20480;
    LAS float* TOT = (LAS float*)(lds + 30720);
    const int d = tid & 127, h = (tid >> 7) & 1, dir = tid >> 8, pq = tid >> 7;
    unsigned nk[16], nv[8]; float nc[16];
#define HA_LOAD(it) do { const int gb_ = (it) >> 2, hd_ = (it) & 3, r0_ = gb_ * 32; const bf16* zk_ = Zb + (size_t)r0_ * ZBC + ZRF + dir * 512 + hd_ * 128 + d; const float* lf_ = LF + (size_t)r0_ * 1024 + dir * 512 + hd_ * 128 + d; \
        _Pragma("unroll") for (int j = 0; j < 16; ++j) { const int i = 16 * h + j, p = dir ? 31 - i : i; nk[j] = zk_[(size_t)p * ZBC]; nc[j] = lf_[(size_t)p * 1024]; } \
        _Pragma("unroll") for (int j = 0; j < 8; ++j) nv[j] = Zb[(size_t)(r0_ + 8 * pq + j) * ZBC + ZRI + hd_ * 128 + d]; } while (0)
    if (vcu < 2048) HA_LOAD(vcu);
    for (int item = vcu; item < 2048; item += G) {
        const int gb = item >> 2, head = item & 3;
        float kk[16], c[16]; float run = 0.f;
#pragma unroll
        for (int j = 0; j < 16; ++j) { kk[j] = bf2f(nk[j]); c[j] = nc[j]; }
        { v4u w; w.x = nv[0] | (nv[1] << 16); w.y = nv[2] | (nv[3] << 16); w.z = nv[4] | (nv[5] << 16); w.w = nv[6] | (nv[7] << 16); *(LAS v4u*)(VT + d * 80 + pq * 16) = w; }
#pragma unroll
        for (int j = 0; j < 16; ++j) { run += c[j]; c[j] = run; }
        TOT[(dir * 2 + h) * 128 + d] = run;
        LDS_BARRIER();
        const float other = TOT[(dir * 2 + (1 - h)) * 128 + d];
        const float base = h ? run : run + other;
#pragma unroll
        for (int j = 0; j < 16; j += 2) { const float va = kk[j] * __expf(base - c[j]), vb = kk[j + 1] * __expf(base - c[j + 1]);
            const int i = 16 * h + j, p = dir ? 30 - i : i;
            *(LAS unsigned*)(KT + (dir * 128 + d) * 80 + p * 2) = pk2(dir ? vb : va, dir ? va : vb); }
        if (h == 0) DEC[((size_t)(dir * 512 + gb) * 4 + head) * 128 + d] = __expf(run + other);
        if (item + G < 2048) HA_LOAD(item + G);
        LDS_BARRIER();
        if (gb < 256) {
            for (int q = tid; q < 1024; q += 512) { const int dr = q >> 9, rr = (q >> 2) & 127, c4 = q & 3;
                *(v4u*)(KP + ((size_t)((dr * 256 + gb) * 4 + head) * 128 + rr) * 32 + c4 * 8) = *(const LAS v4u*)(KT + (dr * 128 + rr) * 80 + c4 * 16); }
            { const int rr = tid >> 2, c4 = tid & 3; *(v4u*)(VP + ((size_t)(gb * 4 + head) * 128 + rr) * 32 + c4 * 8) = *(const LAS v4u*)(VT + rr * 80 + c4 * 16); }
        } else {
            bf16* U16 = (bf16*)(a.ws + WS_US);
            const bf16x8 vf = *(const LAS bf16x8*)(VT + (wave * 16 + fr) * 80 + fq * 16);
#pragma unroll
            for (int dr = 0; dr < 2; ++dr) {
                bf16* Ub = U16 + ((size_t)(dr * 512 + gb) * 4 + head) * 16384 + (wave * 16 + fr) * 128 + 8 * fq;
                f32x4 acc[4][2];
#pragma unroll
                for (int dp = 0; dp < 4; ++dp)
#pragma unroll
                    for (int j = 0; j < 2; ++j) {
                        const bf16x8 kf = *(const LAS bf16x8*)(KT + (dr * 128 + 32 * dp + 8 * (fr >> 2) + 4 * j + (fr & 3)) * 80 + fq * 16);
                        acc[dp][j] = (f32x4){0.f, 0.f, 0.f, 0.f};
                        acc[dp][j] = __builtin_amdgcn_mfma_f32_16x16x32_bf16(kf, vf, acc[dp][j], 0, 0, 0); }
                asm volatile("s_nop 7\n\ts_nop 7\n\ts_nop 7" : "+v"(acc[0][0]), "+v"(acc[0][1]), "+v"(acc[1][0]), "+v"(acc[1][1]), "+v"(acc[2][0]), "+v"(acc[2][1]), "+v"(acc[3][0]), "+v"(acc[3][1]));
#pragma unroll
                for (int dp = 0; dp < 4; ++dp) {
                    v4u w; w.x = pk2(acc[dp][0][0], acc[dp][0][1]); w.y = pk2(acc[dp][0][2], acc[dp][0][3]); w.z = pk2(acc[dp][1][0], acc[dp][1][1]); w.w = pk2(acc[dp][1][2], acc[dp][1][3]);
                    *(v4u*)(Ub + 32 * dp) = w; }
            }
        }
        LDS_BARRIER();
    }
}

__device__ __forceinline__ void phase_conv(const Args& a, LAS unsigned char* lds, int l, int vcu, int G) {
    int tid_ = threadIdx.x; asm volatile("" : "+v"(tid_)); const int tid = tid_, lane = tid & 63, wave = tid >> 6, ch = tid;
    const bf16* GL = (const bf16*)(a.ws + WS_GLU); bf16* MIX = (bf16*)(a.ws + WS_MIX);
    LAS float* OB = (LAS float*)lds;
    LAS float* STS = (LAS float*)(lds + 65536);
    float w[31];
#pragma unroll
    for (int j = 0; j < 31; ++j) w[j] = a.in[I_CW][(size_t)(l * 31 + j) * 512 + ch];
    const float bias = a.in[I_CB][l * 512 + ch], lg = a.in[I_CLG][l * 512 + ch], lbb = a.in[I_CLB][l * 512 + ch];
    for (int gb = vcu; gb < 512; gb += G) {
        const int row0 = gb * 32;
        int s0, T; if (row0 < NCTX) { s0 = row0 & ~255; T = 256; } else { s0 = NCTX + ((row0 - NCTX) & ~4095); T = 4096; }
        float h[62];
#pragma unroll
        for (int i = 0; i < 62; ++i) { const int r = row0 - 15 + i; h[i] = (r >= s0 && r < s0 + T) ? bf2f(GL[(size_t)r * 512 + ch]) : 0.f; }
        float o[32];
#pragma unroll
        for (int p = 0; p < 32; ++p) { float acc = bias;
#pragma unroll
            for (int j = 0; j < 31; ++j) acc += w[j] * h[p + j];
            o[p] = acc; OB[p * 512 + ch] = acc; }
        LDS_BARRIER();
#pragma unroll
        for (int t = 0; t < 4; ++t) { const int p = wave * 4 + t;
            const f32x4 x0 = *(const LAS f32x4*)(OB + p * 512 + lane * 8), x1 = *(const LAS f32x4*)(OB + p * 512 + lane * 8 + 4);
            const float s1 = wave_sum((x0.x + x0.y) + (x0.z + x0.w) + (x1.x + x1.y) + (x1.z + x1.w));
            const float s2 = wave_sum((x0.x * x0.x + x0.y * x0.y) + (x0.z * x0.z + x0.w * x0.w) + (x1.x * x1.x + x1.y * x1.y) + (x1.z * x1.z + x1.w * x1.w));
            const float mu = s1 * (1.f / 512.f), var = fmaxf(s2 * (1.f / 512.f) - mu * mu, 0.f);
            if (lane == 0) { STS[p * 2] = mu; STS[p * 2 + 1] = 1.0f / sqrtf(var + EPS); } }
        LDS_BARRIER();
#pragma unroll
        for (int p = 0; p < 32; ++p) { const float y = (o[p] - STS[p * 2]) * STS[p * 2 + 1] * lg + lbb;
            MIX[(size_t)(row0 + p) * DM + 1536 + ch] = f2bf(siluf(y)); }
        LDS_BARRIER();
    }
}

__device__ __forceinline__ void phase_attn(const Args& a, unsigned char* lds_generic, int l, int vcu, int G) {
    const bf16* Qb = (const bf16*)(a.ws + WS_Q); const bf16* Kb = (const bf16*)(a.ws + WS_K); const bf16* Vb = (const bf16*)(a.ws + WS_V);
    bf16* MIX = (bf16*)(a.ws + WS_MIX);
    for (int item = vcu; item < 512; item += G) {
        if (item < 256) {
            const int b = item >> 3, h = item & 7, kvh = h >> 2; const size_t r0 = (size_t)b * 256;
            att::KVSrc src; src.Kl = nullptr; src.Vl = nullptr; src.Kc = Kb + r0 * 256 + kvh * 128; src.Vc = Vb + r0 * 256 + kvh * 128; src.nloc = 0; src.kstart = 0; src.nrows = 1;
            att::attn_body(Qb + r0 * 1024 + h * 128, src, MIX + r0 * DM + h * 128, 4, a.in[I_SINK][l * 8 + h] * (1.0f / att::SCALE), 0, (char*)lds_generic);
        } else {
            const int it = item - 256, b2 = it >> 7, h = (it >> 4) & 7, qi = it & 15, kvh = h >> 2; const size_t rb = (size_t)NCTX + (size_t)b2 * 4096;
            att::KVSrc src; src.Kl = Kb + rb * 256 + kvh * 128; src.Vl = Vb + rb * 256 + kvh * 128;
            src.Kc = (const bf16*)(a.ws + WS_CK) + ((size_t)(b2 * 2 + l) * 512) * 256 + kvh * 128; src.Vc = (const bf16*)(a.ws + WS_CV) + ((size_t)(b2 * 2 + l) * 512) * 256 + kvh * 128;
            src.nloc = 8; src.kstart = 256 * qi - 128; src.nrows = 4096;
            att::attn_body(Qb + (rb + 256 * qi) * 1024 + h * 128, src, MIX + (rb + 256 * qi) * DM + h * 128, 16, a.in[I_SINK][l * 8 + h] * (1.0f / att::SCALE), 256 * qi, (char*)lds_generic);
        }
    }
}

__device__ __forceinline__ void phase_hgrn_b(const Args& a, LAS unsigned char* lds, int l, int vcu, int G) {
    int tid_ = threadIdx.x; asm volatile("" : "+v"(tid_)); const int tid = tid_, lane = tid & 63, wave = tid >> 6, fr = lane & 15, fq = lane >> 4;
    const bf16* __restrict__ U16 = (const bf16*)(a.ws + WS_US); const bf16* __restrict__ KP = (const bf16*)(a.ws + WS_KP); const bf16* __restrict__ VP = (const bf16*)(a.ws + WS_VP);
    const float* __restrict__ DEC = (const float*)(a.ws + WS_DEC);
    bf16* __restrict__ ST = (bf16*)(a.ws + WS_ST16);
    LAS float* TR = (LAS float*)lds;
    LAS unsigned char* LK = lds;
    LAS unsigned char* LV = lds + 40960;
    LAS float* LD = (LAS float*)(lds + 81920);
    for (int item = vcu; item < 256; item += G) {
        const int b = item >> 3, head = (item >> 1) & 3, dir = item & 1;
        f32x4 S[4][2];
#pragma unroll
        for (int dp = 0; dp < 4; ++dp) { S[dp][0] = (f32x4){0.f, 0.f, 0.f, 0.f}; S[dp][1] = (f32x4){0.f, 0.f, 0.f, 0.f}; }
#pragma unroll
        for (int half = 0; half < 2; ++half) {
            for (int q = tid; q < 2048; q += 512) { const int ci = q >> 9, rr = (q >> 2) & 127, c4 = q & 3, i = 4 * half + ci, gb = b * 8 + (dir ? 7 - i : i);
                *(LAS v4u*)(LK + (ci * 128 + rr) * 80 + c4 * 16) = *(const v4u*)(KP + ((size_t)((dir * 256 + gb) * 4 + head) * 128 + rr) * 32 + c4 * 8);
                *(LAS v4u*)(LV + (ci * 128 + rr) * 80 + c4 * 16) = *(const v4u*)(VP + ((size_t)(gb * 4 + head) * 128 + rr) * 32 + c4 * 8); }
            if (tid < 128) { const int ci = tid >> 5, c = tid & 31, i = 4 * half + ci, gb = b * 8 + (dir ? 7 - i : i);
                *(LAS f32x4*)(LD + ci * 128 + 4 * c) = *(const f32x4*)(DEC + ((size_t)(dir * 512 + gb) * 4 + head) * 128 + 4 * c); }
            LDS_BARRIER();
#pragma unroll
            for (int ci = 0; ci < 4; ++ci) { const int i = 4 * half + ci, gb = b * 8 + (dir ? 7 - i : i); const size_t cb = ((size_t)(dir * 512 + gb) * 4 + head);
                const bf16x8 vB = *(const LAS bf16x8*)(LV + (ci * 128 + wave * 16 + fr) * 80 + fq * 16);
                bf16* So = ST + cb * 16384 + (wave * 16 + fr) * 128 + 8 * fq;
#pragma unroll
                for (int dp = 0; dp < 4; ++dp) {
                    v4u w; w.x = pk2(S[dp][0][0], S[dp][0][1]); w.y = pk2(S[dp][0][2], S[dp][0][3]); w.z = pk2(S[dp][1][0], S[dp][1][1]); w.w = pk2(S[dp][1][2], S[dp][1][3]);
                    *(v4u*)(So + 32 * dp) = w;
#pragma unroll
                    for (int j = 0; j < 2; ++j) {
                        const bf16x8 kA = *(const LAS bf16x8*)(LK + (ci * 128 + 32 * dp + 8 * (fr >> 2) + 4 * j + (fr & 3)) * 80 + fq * 16);
                        const f32x4 dc = *(const LAS f32x4*)(LD + ci * 128 + 32 * dp + 8 * fq + 4 * j);
                        S[dp][j] = __builtin_amdgcn_mfma_f32_16x16x32_bf16(kA, vB, S[dp][j] * dc, 0, 0, 0); } } }
            LDS_BARRIER();
        }
#pragma unroll
        for (int dp = 0; dp < 4; ++dp)
#pragma unroll
            for (int j = 0; j < 2; ++j)
#pragma unroll
                for (int i = 0; i < 4; ++i) TR[(wave * 16 + fr) * 129 + 32 * dp + 8 * fq + 4 * j + i] = S[dp][j][i];
        LDS_BARRIER();
        float* O = a.out + OUT_ST + ((((size_t)b * 2 + l) * 2 + dir) * 4 + head) * 16384;
#pragma unroll
        for (int j = 0; j < 8; ++j) { const int idx = tid + 512 * j, dd = idx >> 5, e4 = (idx & 31) * 4;
            f32x4 v; v.x = TR[e4 * 129 + dd]; v.y = TR[(e4 + 1) * 129 + dd]; v.z = TR[(e4 + 2) * 129 + dd]; v.w = TR[(e4 + 3) * 129 + dd];
            *(f32x4*)(O + dd * 128 + e4) = v; }
        LDS_BARRIER();
    }
    for (int item = vcu; item < 256; item += G) {
        const int combo = item >> 4, part = item & 15, b2 = combo >> 3, dir = (combo >> 2) & 1, head = combo & 3;
        const int flat = part * 1024 + tid * 2, e = flat >> 7, d0 = flat & 127;
        const float* Sin = a.in[I_ST] + ((((size_t)b2 * 2 + l) * 2 + dir) * 4 + head) * 16384;
        f32x2 S; S.x = Sin[d0 * 128 + e]; S.y = Sin[(d0 + 1) * 128 + e];
        const int gb0 = 256 + b2 * 128;
#pragma unroll 16
        for (int i = 0; i < 128; ++i) { const int cc = dir ? 127 - i : i, gb = gb0 + cc; const size_t cb = ((size_t)(dir * 512 + gb) * 4 + head);
            const unsigned ur = *(const unsigned*)(U16 + cb * 16384 + flat); const f32x2 u = {__uint_as_float(ur << 16), __uint_as_float(ur & 0xffff0000u)}, dd = *(const f32x2*)(DEC + cb * 128 + d0);
            *(unsigned*)(ST + cb * 16384 + flat) = pk2(S.x, S.y);
            S = S * dd + u; }
    }
}

__device__ __forceinline__ void phase_hgrn_c(const Args& a, LAS unsigned char* lds, int l, int vcu, int G) {
    int tid_ = threadIdx.x; asm volatile("" : "+v"(tid_)); const int tid = tid_, lane = tid & 63, wave = tid >> 6, fr = lane & 15, fq = lane >> 4;
    const bf16* Zb = (const bf16*)(a.ws + WS_Z); const float* LF = (const float*)(a.ws + WS_LF); const bf16* ST = (const bf16*)(a.ws + WS_ST16); bf16* MIX = (bf16*)(a.ws + WS_MIX);
    constexpr int QP = 272;
    constexpr int O_QX = 0, O_KX = 17408, O_QI = 34816, O_VT = 52224, O_AM = 62464, O_TOT = 67584, O_RED = 69632;
    LAS unsigned char* QX = lds + O_QX;
    LAS unsigned char* KX = lds + O_KX;
    LAS unsigned char* QI = lds + O_QI;
    LAS unsigned char* VT = lds + O_VT;
    LAS unsigned char* AM = lds + O_AM;
    LAS float* TOT = (LAS float*)(lds + O_TOT);
    LAS float* RED = (LAS float*)(lds + O_RED);
    const int d = tid & 127, h = (tid >> 7) & 1, dir = tid >> 8, pq = tid >> 7;
    unsigned nk[16], nq[16], nv[8]; float nc[16];
#define HC_LOAD(it) do { const int gb_ = (it) >> 2, hd_ = (it) & 3, r0_ = gb_ * 32; const bf16* zk_ = Zb + (size_t)r0_ * ZBC + ZRF + dir * 512 + hd_ * 128 + d; const bf16* zq_ = Zb + (size_t)r0_ * ZBC + ZRQ + hd_ * 128 + d; \
        const float* lf_ = LF + (size_t)r0_ * 1024 + dir * 512 + hd_ * 128 + d; \
        _Pragma("unroll") for (int j = 0; j < 16; ++j) { const int i = 16 * h + j, p = dir ? 31 - i : i; nk[j] = zk_[(size_t)p * ZBC]; nc[j] = lf_[(size_t)p * 1024]; nq[j] = zq_[(size_t)p * ZBC]; } \
        _Pragma("unroll") for (int j = 0; j < 8; ++j) nv[j] = Zb[(size_t)(r0_ + 8 * pq + j) * ZBC + ZRI + hd_ * 128 + d]; } while (0)
    unsigned nrg[8];
#define HC_LOADG(it) do { const int gb_ = (it) >> 2, hd_ = (it) & 3, r0_ = gb_ * 32; \
        _Pragma("unroll") for (int mt = 0; mt < 2; ++mt) _Pragma("unroll") for (int i = 0; i < 4; ++i) nrg[mt * 4 + i] = Zb[(size_t)(r0_ + mt * 16 + 4 * fq + i) * ZBC + ZRG + hd_ * 128 + wave * 16 + fr]; } while (0)
    if (vcu < 2048) HC_LOAD(vcu);
    for (int item = vcu; item < 2048; item += G) {
        const int gb = item >> 2, head = item & 3, row0 = gb * 32;
        bf16x8 sB[2][4];
#pragma unroll
        for (int dr = 0; dr < 2; ++dr)
#pragma unroll
            for (int kt = 0; kt < 4; ++kt) sB[dr][kt] = *(const bf16x8*)(ST + ((size_t)(dr * 512 + gb) * 4 + head) * 16384 + (wave * 16 + fr) * 128 + (4 * kt + fq) * 8);
        float kk[16], c[16], qq[16]; float run = 0.f;
#pragma unroll
        for (int j = 0; j < 16; ++j) { kk[j] = bf2f(nk[j]); c[j] = nc[j]; qq[j] = bf2f(nq[j]); }
        { v4u w; w.x = nv[0] | (nv[1] << 16); w.y = nv[2] | (nv[3] << 16); w.z = nv[4] | (nv[5] << 16); w.w = nv[6] | (nv[7] << 16); *(LAS v4u*)(VT + d * 80 + pq * 16) = w; }
        HC_LOADG(item); const float gn = a.in[I_RG][(size_t)(l * 4 + head) * 128 + wave * 16 + fr];
#pragma unroll
        for (int j = 0; j < 16; ++j) { run += c[j]; c[j] = run; }
        TOT[(dir * 2 + h) * 128 + d] = run;
        LDS_BARRIER();
        const float other = TOT[(dir * 2 + (1 - h)) * 128 + d];
        const float xo = h ? 0.f : -run;
        const float io = h ? other : 0.f;
#pragma unroll
        for (int j = 0; j < 16; ++j) { const int i = 16 * h + j, p = dir ? 31 - i : i; const int off = (dir * 32 + p) * QP + d * 2;
            const float ex = __expf(c[j] + xo);
            *(LAS bf16*)(QX + off) = f2bf(qq[j] * ex);
            *(LAS bf16*)(KX + off) = f2bf(kk[j] * __builtin_amdgcn_rcpf(ex));
            *(LAS bf16*)(QI + off) = f2bf(qq[j] * __expf(c[j] + io)); }
        LDS_BARRIER();
        if (item + G < 2048) HC_LOAD(item + G);
        {
            const int dr = wave >> 2, mt = (wave >> 1) & 1, nt = wave & 1;
            f32x4 acc = {0.f, 0.f, 0.f, 0.f};
#pragma unroll
            for (int kt = 0; kt < 4; ++kt) {
                const bf16x8 af = *(const LAS bf16x8*)(QX + (dr * 32 + mt * 16 + fr) * QP + kt * 64 + fq * 16);
                const bf16x8 bfv = *(const LAS bf16x8*)(KX + (dr * 32 + nt * 16 + fr) * QP + kt * 64 + fq * 16);
                acc = __builtin_amdgcn_mfma_f32_16x16x32_bf16(af, bfv, acc, 0, 0, 0); }
#pragma unroll
            for (int i = 0; i < 4; ++i) { const int p = mt * 16 + 4 * fq + i, pp = nt * 16 + fr; const bool keep = dr ? (pp >= p) : (pp <= p);
                *(LAS bf16*)(AM + (dr * 32 + p) * 80 + pp * 2) = f2bf(keep ? acc[i] : 0.f); }
        }
        LDS_BARRIER();
        f32x4 o[2];
#pragma unroll
        for (int mt = 0; mt < 2; ++mt) { o[mt] = (f32x4){0.f, 0.f, 0.f, 0.f};
#pragma unroll
            for (int dr = 0; dr < 2; ++dr) {
#pragma unroll
                for (int kt = 0; kt < 4; ++kt) {
                    const bf16x8 af = *(const LAS bf16x8*)(QI + (dr * 32 + mt * 16 + fr) * QP + kt * 64 + fq * 16);
                    o[mt] = __builtin_amdgcn_mfma_f32_16x16x32_bf16(af, sB[dr][kt], o[mt], 0, 0, 0); }
                const bf16x8 af = *(const LAS bf16x8*)(AM + (dr * 32 + mt * 16 + fr) * 80 + fq * 16);
                const bf16x8 bfv = *(const LAS bf16x8*)(VT + (wave * 16 + fr) * 80 + fq * 16);
                o[mt] = __builtin_amdgcn_mfma_f32_16x16x32_bf16(af, bfv, o[mt], 0, 0, 0);
            } }
#pragma unroll
        for (int mt = 0; mt < 2; ++mt)
#pragma unroll
            for (int i = 0; i < 4; ++i) { float ss = row_sum16(o[mt][i] * o[mt][i]);
                if (fr == 0) RED[wave * 32 + mt * 16 + 4 * fq + i] = ss; }
        LDS_BARRIER();
        const int e = wave * 16 + fr;
#pragma unroll
        for (int mt = 0; mt < 2; ++mt)
#pragma unroll
            for (int i = 0; i < 4; ++i) { const int p = mt * 16 + 4 * fq + i; float ss = 0.f;
#pragma unroll
                for (int wv = 0; wv < 8; ++wv) ss += RED[wv * 32 + p];
                const float rstd = 1.0f / sqrtf(ss * (1.f / 128.f) + EPS);
                const float rg = bf2f(nrg[mt * 4 + i]);
                MIX[(size_t)(row0 + p) * DM + 1024 + head * 128 + e] = f2bf(o[mt][i] * rstd * gn * siluf(rg)); }
        LDS_BARRIER();
    }
}


constexpr int N_PHASES = 20;
#if MK_N_LAUNCHES == 1
#define IN(k) true
#else
#define IN(k) (lo <= (k) && (k) < hi)
#endif
#if PROBE_AMP_MASK || PROBE_AMP_BAR
#define SPIN(dur) do { const unsigned long long s_ = __builtin_amdgcn_s_memrealtime(), d_ = (dur); while (__builtin_amdgcn_s_memrealtime() - s_ < d_) __builtin_amdgcn_s_sleep(1); } while (0)
#define SEAM(k) do { if ((k) + 1 < N_PHASES && IN(k) && IN((k) + 1)) { const unsigned long long ta_ = __builtin_amdgcn_s_memrealtime(); xcd_barrier(bar); const unsigned long long te_ = __builtin_amdgcn_s_memrealtime(); \
        if ((PROBE_AMP_MASK >> (k)) & 1) SPIN(te_ - t_ph); if (PROBE_AMP_BAR) SPIN(te_ - ta_); t_ph = __builtin_amdgcn_s_memrealtime(); } } while (0)
#else
#define SEAM(k) do { if ((k) + 1 < N_PHASES && IN(k) && IN((k) + 1)) xcd_barrier(bar); } while (0)
#endif

template <int L>
__device__ __forceinline__ void layer_phases(const Args& args, LAS unsigned char* lds, unsigned char* lds_raw, const XcdBarrier& bar, int vcu, int G, int bx, int lo, int hi, unsigned long long& t_ph) {
    constexpr int l = L;
    unsigned char* ws = args.ws; float* X = args.out;
        const int pb = 2 + 9 * l;
        const float* bada = args.in[I_BADA] + (size_t)l * MODW;
        constexpr bool F8A = f8on(2 * l), F8B = f8on(2 * l + 1), F8N = l == 0 && f8on(2), F8AO = f8out(2 * l), F8BO = f8out(2 * l + 1), I8A = FFI_INT8 && F8A, I8B = FFI_INT8 && F8B, I8N = FFI_INT8 && F8N;
        if (IN(pb + 0)) {
            pg8::Gemm g{(const bf16*)(ws + WS_H), F8A ? (const bf16*)(ws + WS_W8 + (size_t)(2 * l) * W8_STRIDE) : (const bf16*)(ws + WS_WFI) + (size_t)(l * 2 + 0) * NFF2 * DM, NTOK, NFF2, F8A ? DM / 2 : DM}; pg8::StaticOrder S; S.init(NTOK, NFF2, G, bx);
            pg8::EpiSwiGLUT<F8AO, I8A> E{ws, 3 * l, I8A ? 1.0f / I8_WSC : (F8A ? 1.0f / W8I_SC : 1.0f)};
            pg8::gemm_phase<pg8::EpiSwiGLUT<F8AO, I8A>, pg8::StaticOrder, true, true, F8A && !I8A, I8A>(lds, g, S, E);
            SEAM(pb + 0);
        }
        if (IN(pb + 1)) {
            pg8::Gemm g{(const bf16*)(ws + WS_Z), F8AO ? (const bf16*)(ws + WS_W8 + (size_t)(2 * l) * W8_STRIDE + W8O_OFF) : (const bf16*)(ws + WS_WFO) + (size_t)(l * 2 + 0) * DM * DFF, NTOK, DM, F8AO ? DFF / 2 : DFF}; pg8::StaticOrder S; S.init(NTOK, DM, G, bx);
            pg8::EpiResidNorm E{ws, X, bada + 2 * DM, l * MODW + 2 * DM, 3 * l + 1, F8AO ? 0.5f / W8O_SC : 0.5f, l == 0 ? args.in[I_XP] : nullptr, l == 0 ? args.in[I_XS] : nullptr};
            pg8::gemm_phase<pg8::EpiResidNorm, pg8::StaticOrder, true, true, F8AO>(lds, g, S, E);
            SEAM(pb + 1);
        }
        if (IN(pb + 2)) {
            pg8::Gemm g{(const bf16*)(ws + WS_H), (const bf16*)(ws + WS_WIN) + (size_t)l * INC * DM, NTOK, INC, DM}; pg8::StaticOrder S; S.init(NTOK, INC, G, bx);
            pg8::EpiWin E{ws, l, 3 * l + 1};
            pg8::gemm_phase<pg8::EpiWin, pg8::StaticOrder, true, true>(lds, g, S, E);
            SEAM(pb + 2);
        }
        if (IN(pb + 3)) { phase_prep(args, l, vcu, G); phase_hgrn_a(args, lds, l, vcu, G); phase_conv(args, lds, l, vcu, G); SEAM(pb + 3); }
        if (IN(pb + 4)) { phase_attn(args, lds_raw, l, vcu, G); phase_hgrn_b(args, lds, l, vcu, G); SEAM(pb + 4); }
        if (IN(pb + 5)) { phase_hgrn_c(args, lds, l, vcu, G); SEAM(pb + 5); }
        if (IN(pb + 6)) {
            pg8::Gemm g{(const bf16*)(ws + WS_MIX), (const bf16*)(ws + WS_WOUT) + (size_t)l * DM * DM, NTOK, DM, DM}; pg8::StaticOrder S; S.init(NTOK, DM, G, bx);
            pg8::EpiResidNormT<F8B, I8B> E{ws, X, bada + 5 * DM, l * MODW + 5 * DM, 3 * l + 2, 1.0f, nullptr, nullptr};
            pg8::gemm_phase<pg8::EpiResidNormT<F8B, I8B>, pg8::StaticOrder, true, true>(lds, g, S, E);
            SEAM(pb + 6);
        }
        if (IN(pb + 7)) {
            pg8::Gemm g{(const bf16*)(ws + WS_H), F8B ? (const bf16*)(ws + WS_W8 + (size_t)(2 * l + 1) * W8_STRIDE) : (const bf16*)(ws + WS_WFI) + (size_t)(l * 2 + 1) * NFF2 * DM, NTOK, NFF2, F8B ? DM / 2 : DM}; pg8::StaticOrder S; S.init(NTOK, NFF2, G, bx);
            pg8::EpiSwiGLUT<F8BO, I8B> E{ws, 3 * l + 2, I8B ? 1.0f / I8_WSC : (F8B ? 1.0f / W8I_SC : 1.0f)};
            pg8::gemm_phase<pg8::EpiSwiGLUT<F8BO, I8B>, pg8::StaticOrder, true, true, F8B && !I8B, I8B>(lds, g, S, E);
            SEAM(pb + 7);
        }
        if (IN(pb + 8)) {
            pg8::Gemm g{(const bf16*)(ws + WS_Z), F8BO ? (const bf16*)(ws + WS_W8 + (size_t)(2 * l + 1) * W8_STRIDE + W8O_OFF) : (const bf16*)(ws + WS_WFO) + (size_t)(l * 2 + 1) * DM * DFF, NTOK, DM, F8BO ? DFF / 2 : DFF}; pg8::StaticOrder S; S.init(NTOK, DM, G, bx);
            pg8::EpiResidNormT<F8N, I8N> E{ws, X, bada + 8 * DM, l * MODW + 8 * DM, l == 0 ? 3 : -1, F8BO ? 0.5f / W8O_SC : 0.5f, nullptr, nullptr};
            pg8::gemm_phase<pg8::EpiResidNormT<F8N, I8N>, pg8::StaticOrder, true, true, F8BO>(lds, g, S, E);
            SEAM(pb + 8);
        }
}

__global__ void __launch_bounds__(512, 2) mega_fwd(Args args) {
    extern __shared__ __attribute__((aligned(16))) unsigned char lds_raw[];
    LAS unsigned char* lds = (LAS unsigned char*)lds_raw;
    const int tid = threadIdx.x;
    const int G = gridDim.x; const int bx = blockIdx.x; const int vcu = (G % 8 == 0) ? (bx % 8) * (G / 8) + bx / 8 : bx;
    for (int u = tid; u < (LDS_BYTES - LDSCTL_OFF) / 4; u += 512) ((LAS unsigned*)(lds + LDSCTL_OFF))[u] = 0u;
    __syncthreads();
    const int lo = args.ph_lo, hi = args.ph_hi; unsigned long long t_ph = 0;
#if PROBE_AMP_MASK || PROBE_AMP_BAR
    t_ph = __builtin_amdgcn_s_memrealtime();
#endif
    XcdBarrier bar; bar.bar = (unsigned*)(args.ws + WS_CTL) + CW_BAR; bar.x = 0; bar.st = nullptr;
    if (MK_N_LAUNCHES == 1 || hi - lo > 1) bar = xcd_barrier_post((unsigned*)(args.ws + WS_CTL) + CW_BAR, (volatile LAS unsigned*)(lds + LDSCTL_OFF + 64));
    unsigned char* ws = args.ws;
    float* X = args.out;

    if (IN(0)) { phase_p0(args, lds, vcu, G); SEAM(0); }
    if (IN(1)) { phase_p1(args, lds, vcu, G); SEAM(1); }

    layer_phases<0>(args, lds, lds_raw, bar, vcu, G, bx, lo, hi, t_ph);
    layer_phases<1>(args, lds, lds_raw, bar, vcu, G, bx, lo, hi, t_ph);
    (void)lo; (void)hi; (void)t_ph;
#undef IN
#undef SEAM
}

extern "C" void kernel_launch(void* const* d_in, const int* in_sizes, int n_in, void* d_out, int out_size, void* d_ws, size_t ws_size, hipStream_t stream) {
    static int grid = 0;
    if (grid == 0) {
        if (n_in != 23 || (size_t)out_size != OUT_TOTAL || ws_size < WS_TOP) { fprintf(stderr, "kernel_launch: shape mismatch: n_in %d out %d ws %zu (need >= %zu); nothing launched\n", n_in, out_size, ws_size, (size_t)WS_TOP); grid = -1; return; }
        int dev = 0, cus = 0, per_cu = 0;
        if (hipGetDevice(&dev) != hipSuccess || hipDeviceGetAttribute(&cus, hipDeviceAttributeMultiprocessorCount, dev) != hipSuccess) { grid = -1; return; }
        if (hipFuncSetAttribute((const void*)mega_fwd, hipFuncAttributeMaxDynamicSharedMemorySize, LDS_BYTES) != hipSuccess) { fprintf(stderr, "kernel_launch: hipFuncSetAttribute failed\n"); grid = -1; return; }
        if (hipOccupancyMaxActiveBlocksPerMultiprocessor(&per_cu, (const void*)mega_fwd, 512, LDS_BYTES) != hipSuccess || per_cu < 1) { fprintf(stderr, "kernel_launch: occupancy query says %d\n", per_cu); }
        (void)hipGetLastError();
        grid = cus;
    }
    if (grid < 0) return;
    static_assert(WS_CTL == WS_END && WS_W8 == WS_CTL + CTL_ZERO_BYTES, "the zeroed regions must be contiguous");
    (void)hipMemsetAsync((char*)d_ws + WS_MODI, 0, WS_CTL + CTL_ZERO_BYTES - WS_MODI, stream);
    Args a{};
    for (int i = 0; i < 23; ++i) a.in[i] = (const float*)d_in[i];
    a.out = (float*)d_out; a.ws = (unsigned char*)d_ws;
#if MK_N_LAUNCHES == 1
    a.ph_lo = 0; a.ph_hi = N_PHASES;
    hipLaunchKernelGGL(mega_fwd, dim3(grid), dim3(512), LDS_BYTES, stream, a);
#else
    for (int p = 0; p < N_PHASES; ++p) { a.ph_lo = p; a.ph_hi = p + 1; hipLaunchKernelGGL(mega_fwd, dim3(grid), dim3(512), LDS_BYTES, stream, a); }
#endif
}
```
